# Optimizing an MI355X kernel written in HIP

```python
import jax
import jax.numpy as jnp
from jax import lax
import numpy as np


D_MODEL = 2048
BATCH = 8
SEQ = 2048
DEPTH = 2

HEAD_DIM = 64
GM_HEADS = 8
GM_WIDTH = GM_HEADS * HEAD_DIM
CHUNK = 128
RW_HEADS = 8
RW_WIDTH = RW_HEADS * HEAD_DIM
DECAY_LORA = 64
AAA_LORA = 64
GATE_LORA = 128
SB_HEADS = 16
SB_WIDTH = SB_HEADS * HEAD_DIM
Q_BLOCK = 128
N_BRANCH = 3
D_FF = 5632
N_EXPERTS = 8
TOP_K = 2
D_FF_EXPERT = D_FF // TOP_K
N_DENSE = (DEPTH + 1) // 2
N_MOE = DEPTH // 2
RMS_EPS = 1e-6
LN_EPS = 1e-5
RW_GN_EPS = 64e-5

GM_COLS = 2 * GM_WIDTH
RW_COLS = 3 * RW_WIDTH + DECAY_LORA + AAA_LORA + GATE_LORA
SB_COLS = 3 * SB_WIDTH
GATE_COLS = N_BRANCH * D_MODEL
GM_OFF = 0
RW_OFF = GM_OFF + GM_COLS
SB_OFF = RW_OFF + RW_COLS
GATE_OFF = SB_OFF + SB_COLS
N_IN = GATE_OFF + GATE_COLS
RW_SPLITS = [RW_WIDTH, 2 * RW_WIDTH, 3 * RW_WIDTH, 3 * RW_WIDTH + DECAY_LORA, 3 * RW_WIDTH + DECAY_LORA + AAA_LORA]

F32 = jnp.float32

kernel_name = "hybrid_gmlp_rwkv7_stickbreak_moe_block"


def rmsnorm(x, g):
    xf = x.astype(F32)
    y = xf * lax.rsqrt(jnp.mean(xf * xf, axis=-1, keepdims=True) + RMS_EPS)
    return (y * g.astype(F32)).astype(x.dtype)


def layernorm(x, g, b, eps):
    xf = x.astype(F32)
    mu = jnp.mean(xf, axis=-1, keepdims=True)
    var = jnp.mean(jnp.square(xf - mu), axis=-1, keepdims=True)
    return ((xf - mu) * lax.rsqrt(var + eps) * g.astype(F32) + b.astype(F32)).astype(x.dtype)


def swiglu(h, w1, w3, w2):
    return (jax.nn.silu(h @ w1) * (h @ w3)) @ w2


def chunked_spatial_gating(u, v, ln_g, ln_b, w_s, b_s):
    B, T, _ = u.shape
    n_chunks = T // CHUNK
    u = jax.nn.gelu(u)
    v = layernorm(jax.nn.gelu(v), ln_g, ln_b, LN_EPS)
    causal = jnp.tril(jnp.ones((CHUNK, CHUNK), dtype=bool))
    w = jnp.where(causal, w_s, jnp.zeros_like(w_s))
    vc = v.reshape(B, n_chunks, CHUNK, GM_HEADS, HEAD_DIM)
    mixed = jnp.einsum('hts,bcshd->bcthd', w, vc) + b_s.T[None, None, :, :, None]
    return u * mixed.reshape(B, T, GM_WIDTH)


def rwkv7_time_mix(p, mu, w0, w2, a0, a2, g2, k_k, k_a, r_k, ln_g, ln_b):
    B, T, _ = p.shape
    p_prev = jnp.pad(p, ((0, 0), (1, 0), (0, 0)))[:, :-1]
    p = p + (p_prev - p) * mu
    r, k, v, wl, al, gl = jnp.split(p, RW_SPLITS, axis=-1)
    d = (w0 + jnp.tanh(wl) @ w2).astype(F32)
    log_w = -jnp.exp(-jax.nn.softplus(-d) - 0.5)
    a = jax.nn.sigmoid(a0 + al @ a2)
    g = jax.nn.sigmoid(gl) @ g2

    def heads(t):
        return t.reshape(B, T, RW_HEADS, HEAD_DIM).astype(F32)

    r, k, v, a, decay = heads(r), heads(k), heads(v), heads(a), heads(jnp.exp(log_w))
    kk = k * k_k.reshape(RW_HEADS, HEAD_DIM).astype(F32)
    kk = kk / jnp.maximum(jnp.sqrt(jnp.sum(kk * kk, axis=-1, keepdims=True)), 1e-12)
    k = k * (1.0 + (a - 1.0) * k_a.reshape(RW_HEADS, HEAD_DIM).astype(F32))

    def step(S, inp):
        r_t, k_t, v_t, kk_t, a_t, w_t = inp
        sa = jnp.einsum('bhvk,bhk->bhv', S, -kk_t)
        S = (S * w_t[:, :, None, :]
             + sa[..., None] * (kk_t * a_t)[:, :, None, :]
             + v_t[..., None] * k_t[:, :, None, :])
        y_t = jnp.einsum('bhvk,bhk->bhv', S, r_t)
        return S, y_t

    def seq_first(t):
        return jnp.moveaxis(t, 1, 0)

    S0 = jnp.zeros((B, RW_HEADS, HEAD_DIM, HEAD_DIM), F32)
    _, y = lax.scan(step, S0, (seq_first(r), seq_first(k), seq_first(v),
                               seq_first(kk), seq_first(a), seq_first(decay)))
    y = jnp.moveaxis(y, 0, 1)
    m = jnp.mean(y, axis=-1, keepdims=True)
    var = jnp.mean(jnp.square(y - m), axis=-1, keepdims=True)
    y = ((y - m) * lax.rsqrt(var + RW_GN_EPS)).reshape(B, T, RW_WIDTH) * ln_g.astype(F32) + ln_b.astype(F32)
    bonus = jnp.sum(r * k * r_k.astype(F32), axis=-1, keepdims=True) * v
    y = (y + bonus.reshape(B, T, RW_WIDTH)) * g.astype(F32)
    return y.astype(p.dtype)


def stick_breaking_attention(q, k, v):
    B, T, H, Dh = q.shape
    scale = Dh ** -0.5
    outs = []
    for i in range(T // Q_BLOCK):
        q0, q1 = i * Q_BLOCK, (i + 1) * Q_BLOCK
        qb, kb, vb = q[:, q0:q1], k[:, :q1], v[:, :q1]
        z = jnp.einsum('bthd,bshd->bhts', qb, kb, preferred_element_type=F32) * scale
        t_pos = q0 + jnp.arange(Q_BLOCK)[:, None]
        s_pos = jnp.arange(q1)[None, :]
        causal = s_pos < t_pos
        log_not = jnp.where(causal, jax.nn.log_sigmoid(-z), 0.0)
        after = lax.cumsum(log_not, axis=3, reverse=True) - log_not
        att = jnp.where(causal, jnp.exp(jax.nn.log_sigmoid(z) + after), 0.0)
        outs.append(jnp.einsum('bhts,bshd->bthd', att.astype(v.dtype), vb))
    return jnp.concatenate(outs, axis=1)


def moe_swiglu(h, router_w, router_b, w1, w3, w2):
    B, T, Dm = h.shape
    hf = h.reshape(B * T, Dm)
    logits = (hf @ router_w).astype(F32) + router_b.astype(F32)
    top_val, top_idx = lax.top_k(logits, TOP_K)
    top_p = jax.nn.softmax(top_val, axis=-1)
    combine = jnp.sum(jax.nn.one_hot(top_idx, N_EXPERTS, dtype=F32) * top_p[..., None], axis=1)
    out = jnp.zeros_like(hf)
    for e in range(N_EXPERTS):
        out = out + combine[:, e:e + 1].astype(h.dtype) * swiglu(hf, w1[e], w3[e], w2[e])
    return out.reshape(B, T, Dm)


def setup_inputs(seed: int = 0) -> dict:
    key = jax.random.key(seed)
    keys = jax.random.split(key, 40)
    counter = [0]

    def nxt():
        kk = keys[counter[0]]
        counter[0] += 1
        return kk

    def nrm(shape, scale):
        return scale * jax.random.normal(nxt(), shape, F32)

    L = DEPTH
    return {
        "x": nrm((BATCH, SEQ, D_MODEL), 1.0),
        "norm_mix": 1.0 + nrm((L, D_MODEL), 0.02),
        "w_in": nrm((L, D_MODEL, N_IN), D_MODEL ** -0.5),
        "gate_b": nrm((L, N_BRANCH, D_MODEL), 0.1),
        "gm_ln_g": 1.0 + nrm((L, GM_WIDTH), 0.02),
        "gm_ln_b": nrm((L, GM_WIDTH), 0.02),
        "gm_ws": nrm((L, GM_HEADS, CHUNK, CHUNK), CHUNK ** -0.5),
        "gm_bs": 1.0 + nrm((L, GM_HEADS, CHUNK), 0.02),
        "rw_mu": jax.random.uniform(nxt(), (L, RW_COLS), F32),
        "rw_w0": jax.random.uniform(nxt(), (L, RW_WIDTH), F32, -6.0, 1.0),
        "rw_w2": nrm((L, DECAY_LORA, RW_WIDTH), 0.5 * DECAY_LORA ** -0.5),
        "rw_a0": nrm((L, RW_WIDTH), 0.1),
        "rw_a2": nrm((L, AAA_LORA, RW_WIDTH), 0.5 * AAA_LORA ** -0.5),
        "rw_g2": nrm((L, GATE_LORA, RW_WIDTH), GATE_LORA ** -0.5),
        "rw_kk": 0.85 + nrm((L, RW_WIDTH), 0.05),
        "rw_ka": 1.0 + nrm((L, RW_WIDTH), 0.05),
        "rw_rk": nrm((L, RW_HEADS, HEAD_DIM), 0.1),
        "rw_ln_g": 1.0 + nrm((L, RW_WIDTH), 0.02),
        "rw_ln_b": nrm((L, RW_WIDTH), 0.02),
        "p_gm": nrm((L, GM_WIDTH, D_MODEL), GM_WIDTH ** -0.5),
        "p_rw": nrm((L, RW_WIDTH, D_MODEL), RW_WIDTH ** -0.5),
        "p_sb": nrm((L, SB_WIDTH, D_MODEL), SB_WIDTH ** -0.5),
        "w_o": nrm((L, D_MODEL, D_MODEL), D_MODEL ** -0.5),
        "norm_ffn": 1.0 + nrm((L, D_MODEL), 0.02),
        "ffn_w1": nrm((N_DENSE, D_MODEL, D_FF), D_MODEL ** -0.5),
        "ffn_w3": nrm((N_DENSE, D_MODEL, D_FF), D_MODEL ** -0.5),
        "ffn_w2": nrm((N_DENSE, D_FF, D_MODEL), D_FF ** -0.5),
        "router_w": nrm((N_MOE, D_MODEL, N_EXPERTS), D_MODEL ** -0.5),
        "router_b": nrm((N_MOE, N_EXPERTS), 0.01),
        "moe_w1": nrm((N_MOE, N_EXPERTS, D_MODEL, D_FF_EXPERT), D_MODEL ** -0.5),
        "moe_w3": nrm((N_MOE, N_EXPERTS, D_MODEL, D_FF_EXPERT), D_MODEL ** -0.5),
        "moe_w2": nrm((N_MOE, N_EXPERTS, D_FF_EXPERT, D_MODEL), D_FF_EXPERT ** -0.5),
        "norm_out": 1.0 + nrm((D_MODEL,), 0.02),
    }


def reference(x, norm_mix, w_in, gate_b, gm_ln_g, gm_ln_b, gm_ws, gm_bs, rw_mu, rw_w0, rw_w2,
              rw_a0, rw_a2, rw_g2, rw_kk, rw_ka, rw_rk, rw_ln_g, rw_ln_b, p_gm, p_rw, p_sb, w_o,
              norm_ffn, ffn_w1, ffn_w3, ffn_w2, router_w, router_b, moe_w1, moe_w3, moe_w2, norm_out):
    B, T, _ = x.shape
    h = x
    for l in range(DEPTH):
        n = rmsnorm(h, norm_mix[l])
        proj = n @ w_in[l]
        y_gm = chunked_spatial_gating(proj[..., GM_OFF:GM_OFF + GM_WIDTH],
                                      proj[..., GM_OFF + GM_WIDTH:RW_OFF],
                                      gm_ln_g[l], gm_ln_b[l], gm_ws[l], gm_bs[l])
        y_rw = rwkv7_time_mix(proj[..., RW_OFF:SB_OFF], rw_mu[l], rw_w0[l], rw_w2[l], rw_a0[l],
                              rw_a2[l], rw_g2[l], rw_kk[l], rw_ka[l], rw_rk[l], rw_ln_g[l], rw_ln_b[l])
        sbp = proj[..., SB_OFF:GATE_OFF].reshape(B, T, 3, SB_HEADS, HEAD_DIM)
        y_sb = stick_breaking_attention(sbp[:, :, 0], sbp[:, :, 1], sbp[:, :, 2]).reshape(B, T, SB_WIDTH)
        gates = jax.nn.sigmoid(proj[..., GATE_OFF:].reshape(B, T, N_BRANCH, D_MODEL) + gate_b[l])
        merged = (gates[:, :, 0] * (y_gm @ p_gm[l])
                  + gates[:, :, 1] * (y_rw @ p_rw[l])
                  + gates[:, :, 2] * (y_sb @ p_sb[l]))
        h = h + merged @ w_o[l]
        n = rmsnorm(h, norm_ffn[l])
        j = l // 2
        if l % 2 == 0:
            h = h + swiglu(n, ffn_w1[j], ffn_w3[j], ffn_w2[j])
        else:
            h = h + moe_swiglu(n, router_w[j], router_b[j], moe_w1[j], moe_w3[j], moe_w2[j])
    return rmsnorm(h, norm_out)
```

```cpp
#include <hip/hip_runtime.h>
#include <cstdio>
#include <cstdint>
namespace pg8 {
#define PG8_LAS __attribute__((address_space(3)))
typedef unsigned short bf16_t;
typedef short bf16x8 __attribute__((ext_vector_type(8)));
typedef float f32x4 __attribute__((ext_vector_type(4)));
typedef unsigned u32x4 __attribute__((ext_vector_type(4)));
constexpr int BM = 256, BK = 64, HALF = 128, HTB = HALF * BK * 2  , STAGE_BYTES = 8 * HTB, NXCD = 8, WGM = 8;

__host__ __device__ __forceinline__ int lds_byte(int r, int c) { const int st = (r >> 4) * 2 + (c >> 5), rr = r & 15, cc = c & 31, ob = rr * 64 + cc * 2; return st * 1024 + (ob ^ (((ob >> 9) & 1) << 5)); }
__host__ __device__ __forceinline__ void stage_rc(int b, int& R, int& C) { const int st = b / 1024, sb = b % 1024, swz = sb ^ (((sb >> 9) & 1) << 5); R = (st >> 1) * 16 + swz / 64; C = (st & 1) * 32 + (swz % 64) / 2; }
__host__ __device__ __forceinline__ int perm32(int rho) { const int n = rho >> 4, i = rho & 15; return 8 * (i >> 2) + 4 * n + (i & 3); }

struct Unit { int pm, pn, aoff, boff; };
struct Gemm { const bf16_t* A; const bf16_t* Bt; int K, lda, ldb; };

struct StaticOrder {
    int nM, nN, nwg, G, c;
    __host__ __device__ void init(int M, int N, int G_, int c_) { nM = M / BM; nN = N / BM; nwg = nM * nN; G = G_; c = c_; }
    __host__ __device__ bool next(int i, Unit& u) const {
        const long L = (long)i * G + c; if (L >= nwg) return false;
        int wgid = (int)L; { const int q = nwg / NXCD, r = nwg % NXCD, xcd = wgid % NXCD, off = wgid / NXCD; wgid = (xcd < r ? xcd * (q + 1) : r * (q + 1) + (xcd - r) * q) + off; }
        const int nig = WGM * nN, gid = wgid / nig, fm = gid * WGM, gsz = (nM - fm) < WGM ? (nM - fm) : WGM;
        u.pm = fm + ((wgid % nig) % gsz); u.pn = (wgid % nig) / gsz; u.aoff = 0; u.boff = 0; return true;
    }
    __device__ __forceinline__ void a_ready(const Unit&) const {}
    __device__ __forceinline__ void done(const Unit&) const {}
};

__device__ __forceinline__ unsigned cvt_pk_bf16(float lo, float hi) { unsigned r; asm volatile("v_cvt_pk_bf16_f32 %0, %1, %2" : "=v"(r) : "v"(lo), "v"(hi)); return r; }
typedef float f32x2 __attribute__((ext_vector_type(2)));
__device__ __forceinline__ f32x2 gelu_pk(f32x2 v) {
    const f32x2 av = __builtin_elementwise_abs(v), d = av * 0.2316418882f + 1.0f;
    f32x2 t; t.x = __builtin_amdgcn_rcpf(d.x); t.y = __builtin_amdgcn_rcpf(d.y);
    f32x2 q = t * 0.5307027145f + (-0.7265760135f); q = q * t + 0.7107068705f; q = q * t + (-0.142248368f); q = q * t + 0.127414796f; q = q * t;
    const f32x2 s = (v * v) * (-0.72134752044f);
    f32x2 e; e.x = __builtin_amdgcn_exp2f(s.x); e.y = __builtin_amdgcn_exp2f(s.y);
    const f32x2 m = v * (q * e), r = v - m;
    f32x2 o; o.x = v.x < 0.f ? m.x : r.x; o.y = v.y < 0.f ? m.y : r.y; return o;
}

template <int ACT  > struct EpiBf16 {
    static constexpr bool PERM = true, AFTER_DRAIN = false; static_assert(ACT == 0 || ACT == 1, "EpiBf16: ACT is 0 (none) or 1 (gelu_pk)");
    bf16_t* O; int ldc; const float* bias; int split_cols; size_t split_stride; float scale0;
    __device__ __forceinline__ void operator()(const f32x4 (&acc)[2][2][4][2], const Unit& u, int wr, int wc, int fr, int fq) const {
        const int row0 = u.pm * BM + wr * 64 + fr; int colt = u.pn * BM; bf16_t* base = O;
        float sc = 1.f; if (split_cols) { const int t = colt / split_cols; base += (size_t)t * split_stride; colt -= t * split_cols; if (t == 0) sc = scale0; }
        const int col0 = colt + wc * 32 + 8 * fq, bcol0 = u.pn * BM + wc * 32 + 8 * fq;
        f32x4 bv[2][2];
#pragma unroll
        for (int bj = 0; bj < 2; ++bj)
#pragma unroll
            for (int n = 0; n < 2; ++n) bv[bj][n] = bias ? *(const f32x4*)(bias + bcol0 + bj * HALF + 4 * n) : (f32x4){0.f, 0.f, 0.f, 0.f};
#pragma unroll
        for (int ai = 0; ai < 2; ++ai)
#pragma unroll
            for (int m = 0; m < 4; ++m) { bf16_t* rowp = base + (size_t)(row0 + ai * HALF + m * 16) * ldc + col0;
#pragma unroll
                for (int bj = 0; bj < 2; ++bj) { f32x4 v0 = acc[ai][bj][m][0] + bv[bj][0], v1 = acc[ai][bj][m][1] + bv[bj][1];
                    if (ACT == 1) { f32x2 a = gelu_pk((f32x2){v0[0], v0[1]}), b = gelu_pk((f32x2){v0[2], v0[3]}), c = gelu_pk((f32x2){v1[0], v1[1]}), d = gelu_pk((f32x2){v1[2], v1[3]});
                        v0 = (f32x4){a.x, a.y, b.x, b.y}; v1 = (f32x4){c.x, c.y, d.x, d.y}; }
                    v0 = v0 * sc; v1 = v1 * sc; u32x4 w; w.x = cvt_pk_bf16(v0[0], v0[1]); w.y = cvt_pk_bf16(v0[2], v0[3]); w.z = cvt_pk_bf16(v1[0], v1[1]); w.w = cvt_pk_bf16(v1[2], v1[3]);
                    *(u32x4*)(rowp + bj * HALF) = w; } }
    }
};

template <class Epi, class Sched, bool ALIGN_EPI = false, bool SP2 = false>
__device__ __forceinline__ void gemm_phase(PG8_LAS unsigned char* lds, const Gemm g, const Sched& S, const Epi& E) {
    const int tid = threadIdx.x, wid = __builtin_amdgcn_readfirstlane(tid >> 6), lane = tid & 63, wr = wid >> 2, wc = wid & 3, fr = lane & 15, fq = lane >> 4;
    const int K = g.K, nt = K / BK;
    unsigned voffA[2], voffB[2];
#pragma unroll
    for (int i = 0; i < 2; ++i) { int R, C; stage_rc(tid * 16 + i * 8192, R, C); const int Rb = Epi::PERM ? ((R & ~31) + perm32(R & 31)) : R;
        voffA[i] = (unsigned)(R * g.lda + C) * 2u; voffB[i] = (unsigned)(Rb * g.ldb + C) * 2u; }
    const size_t kstep = (size_t)(BK * 2);
    const size_t hstepA = (size_t)HALF * g.lda * 2, hstepB = (size_t)HALF * g.ldb * 2;
    const size_t tstepA = 2 * hstepA, tstepB = 2 * hstepB;
    const unsigned ldsw = (unsigned)wid * 1024u;
    const int aoff = lds_byte(wr * 64 + fr, fq * 8), boff = lds_byte(wc * 32 + fr, fq * 8);
#define PG8_SA(b, h) (((b) * 2 + (h)) * HTB)
#define PG8_SB(b, h) ((4 + (b) * 2 + (h)) * HTB)
#define PG8_STAGE(bufoff, gbase, voff) do { _Pragma("unroll") for (int _i = 0; _i < 2; ++_i) \
        __builtin_amdgcn_global_load_lds((const unsigned*)((const char*)(gbase) + (voff)[_i]), (PG8_LAS unsigned*)(lds + (bufoff) + ldsw + _i * 8192), 16, 0, 0); } while (0)
#define PG8_LDA(dst, b, h) do { _Pragma("unroll") for (int m = 0; m < 4; ++m) _Pragma("unroll") for (int k = 0; k < 2; ++k) dst[m][k] = *(const PG8_LAS bf16x8*)(lds + PG8_SA(b, h) + aoff + m * 2048 + k * 1024); } while (0)
#define PG8_LDB(dst, b, h) do { _Pragma("unroll") for (int n = 0; n < 2; ++n) _Pragma("unroll") for (int k = 0; k < 2; ++k) dst[n][k] = *(const PG8_LAS bf16x8*)(lds + PG8_SB(b, h) + boff + n * 2048 + k * 1024); } while (0)
#define PG8_MMA(ai, bj, At, Bt) do { __builtin_amdgcn_s_setprio(1); _Pragma("unroll") for (int m = 0; m < 4; ++m) _Pragma("unroll") for (int n = 0; n < 2; ++n) _Pragma("unroll") for (int k = 0; k < 2; ++k) \
        acc[ai][bj][m][n] = __builtin_amdgcn_mfma_f32_16x16x32_bf16(Bt[n][k], At[m][k], acc[ai][bj][m][n], 0, 0, 0); __builtin_amdgcn_s_setprio(0); } while (0)
#define PG8_WAIT_V(n) asm volatile("s_waitcnt vmcnt(" #n ")" ::: "memory")
#define PG8_WAIT_L(n) asm volatile("s_waitcnt lgkmcnt(" #n ")" ::: "memory")
#define PG8_BAR __builtin_amdgcn_s_barrier()
#define PG8_SCHED __builtin_amdgcn_sched_barrier(0)
    Unit cur, nxt; int ui = 0;
    if (!S.next(0, cur)) return;
    f32x4 acc[2][2][4][2];
#pragma unroll
    for (int a = 0; a < 2; ++a)
#pragma unroll
        for (int b = 0; b < 2; ++b)
#pragma unroll
            for (int m = 0; m < 4; ++m)
#pragma unroll
                for (int n = 0; n < 2; ++n) acc[a][b][m][n] = (f32x4){0.f, 0.f, 0.f, 0.f};
    bf16x8 At[4][2], B0[2][2], B1[2][2];
    const char* cA = (const char*)g.A + (size_t)cur.pm * tstepA + (size_t)cur.aoff * 2; const char* cB = (const char*)g.Bt + (size_t)cur.pn * tstepB + (size_t)cur.boff * 2;
    S.a_ready(cur);
    if constexpr (SP2) {
        PG8_STAGE(PG8_SB(0, 0), cB, voffB); PG8_STAGE(PG8_SB(0, 1), cB + hstepB, voffB); PG8_STAGE(PG8_SA(0, 0), cA, voffA); PG8_STAGE(PG8_SA(0, 1), cA + hstepA, voffA);
        if (wr == 1) PG8_BAR;
        PG8_WAIT_V(2); PG8_BAR;
        PG8_STAGE(PG8_SB(1, 0), cB + kstep, voffB); PG8_STAGE(PG8_SA(1, 0), cA + kstep, voffA); PG8_STAGE(PG8_SB(1, 1), cB + hstepB + kstep, voffB);
        PG8_WAIT_V(6); PG8_BAR;
    } else {
        PG8_STAGE(PG8_SB(0, 0), cB, voffB); PG8_STAGE(PG8_SA(0, 0), cA, voffA); PG8_STAGE(PG8_SB(0, 1), cB + hstepB, voffB); PG8_STAGE(PG8_SA(0, 1), cA + hstepA, voffA);
        if (wr == 1) PG8_BAR;
        PG8_WAIT_V(4); PG8_BAR;
        PG8_STAGE(PG8_SB(1, 0), cB + kstep, voffB); PG8_STAGE(PG8_SA(1, 0), cA + kstep, voffA); PG8_STAGE(PG8_SB(1, 1), cB + hstepB + kstep, voffB);
        PG8_WAIT_V(6); PG8_BAR;
    }
    for (;;) {
        const bool has_next = S.next(ui + 1, nxt);
        const char* nA = has_next ? (const char*)g.A + (size_t)nxt.pm * tstepA + (size_t)nxt.aoff * 2 : cA; const char* nB = has_next ? (const char*)g.Bt + (size_t)nxt.pn * tstepB + (size_t)nxt.boff * 2 : cB;
        for (int t = 0; t < nt; t += 2) {
            const bool last = (t == nt - 2);
            const char* a1 = cA + (size_t)(t + 1) * kstep;
            const char* a2 = last ? nA : cA + (size_t)(t + 2) * kstep; const char* b2 = last ? nB : cB + (size_t)(t + 2) * kstep;
            const char* a3 = a2 + kstep; const char* b3 = b2 + kstep;
            if (last && has_next) S.a_ready(nxt);
            if constexpr (SP2) {
            PG8_LDB(B0, 0, 0); PG8_LDB(B1, 0, 1); PG8_SCHED; PG8_LDA(At, 0, 0); PG8_STAGE(PG8_SA(1, 1), a1 + hstepA, voffA);
            PG8_WAIT_V(8); PG8_WAIT_L(0); PG8_BAR; PG8_MMA(0, 0, At, B0); PG8_MMA(0, 1, At, B1); PG8_BAR; PG8_SCHED;
            PG8_LDA(At, 0, 1); PG8_STAGE(PG8_SB(0, 0), b2, voffB); PG8_STAGE(PG8_SB(0, 1), b2 + hstepB, voffB); PG8_STAGE(PG8_SA(0, 0), a2, voffA);
            PG8_WAIT_V(8); PG8_WAIT_L(0); PG8_BAR; PG8_MMA(1, 0, At, B0); PG8_MMA(1, 1, At, B1); PG8_BAR; PG8_SCHED;
            PG8_LDB(B0, 1, 0); PG8_LDB(B1, 1, 1); PG8_SCHED; PG8_LDA(At, 1, 0); PG8_STAGE(PG8_SA(0, 1), a2 + hstepA, voffA);
            PG8_WAIT_V(8); PG8_WAIT_L(0); PG8_BAR; PG8_MMA(0, 0, At, B0); PG8_MMA(0, 1, At, B1); PG8_BAR; PG8_SCHED;
            PG8_LDA(At, 1, 1); PG8_STAGE(PG8_SB(1, 0), b3, voffB); PG8_STAGE(PG8_SB(1, 1), b3 + hstepB, voffB); PG8_STAGE(PG8_SA(1, 0), a3, voffA);
            PG8_WAIT_V(8); PG8_WAIT_L(0); PG8_BAR; PG8_MMA(1, 0, At, B0); PG8_MMA(1, 1, At, B1); PG8_BAR; PG8_SCHED;
            } else {
            PG8_LDB(B0, 0, 0); PG8_SCHED; PG8_LDA(At, 0, 0); PG8_STAGE(PG8_SA(1, 1), a1 + hstepA, voffA);
            PG8_WAIT_L(8); PG8_BAR; PG8_WAIT_L(0); PG8_MMA(0, 0, At, B0); PG8_BAR; PG8_SCHED;
            PG8_LDB(B1, 0, 1); PG8_STAGE(PG8_SB(0, 0), b2, voffB);
            PG8_BAR; PG8_WAIT_L(0); PG8_MMA(0, 1, At, B1); PG8_BAR;
            PG8_LDA(At, 0, 1); PG8_STAGE(PG8_SA(0, 0), a2, voffA);
            PG8_BAR; PG8_WAIT_L(0); PG8_MMA(1, 0, At, B0); PG8_BAR; PG8_SCHED;
            PG8_STAGE(PG8_SB(0, 1), b2 + hstepB, voffB);
            PG8_WAIT_V(6); PG8_BAR; PG8_MMA(1, 1, At, B1); PG8_BAR;
            PG8_LDB(B0, 1, 0); PG8_SCHED; PG8_LDA(At, 1, 0); PG8_STAGE(PG8_SA(0, 1), a2 + hstepA, voffA);
            PG8_WAIT_L(8); PG8_BAR; PG8_WAIT_L(0); PG8_MMA(0, 0, At, B0); PG8_BAR; PG8_SCHED;
            PG8_LDB(B1, 1, 1); PG8_STAGE(PG8_SB(1, 0), b3, voffB);
            PG8_BAR; PG8_WAIT_L(0); PG8_MMA(0, 1, At, B1); PG8_BAR;
            PG8_LDA(At, 1, 1); PG8_STAGE(PG8_SA(1, 0), a3, voffA);
            PG8_BAR; PG8_WAIT_L(0); PG8_MMA(1, 0, At, B0); PG8_BAR; PG8_SCHED;
            PG8_STAGE(PG8_SB(1, 1), b3 + hstepB, voffB);
            PG8_WAIT_V(6); PG8_BAR; PG8_MMA(1, 1, At, B1); PG8_BAR;
            }
        }
        if constexpr (ALIGN_EPI) { if (wr == 0) PG8_BAR; }
        if constexpr (!Epi::AFTER_DRAIN) { E(acc, cur, wr, wc, fr, fq); S.done(cur); }
        if (!has_next) break;
#pragma unroll
        for (int a = 0; a < 2; ++a)
#pragma unroll
            for (int b = 0; b < 2; ++b)
#pragma unroll
                for (int m = 0; m < 4; ++m)
#pragma unroll
                    for (int n = 0; n < 2; ++n) acc[a][b][m][n] = (f32x4){0.f, 0.f, 0.f, 0.f};
        cur = nxt; cA = nA; cB = nB; ++ui;
        if constexpr (ALIGN_EPI) { if (wr == 1) PG8_BAR; }
    }
    PG8_WAIT_V(0);
    if constexpr (!ALIGN_EPI) { if (wr == 0) PG8_BAR; }
    PG8_BAR;
    if constexpr (Epi::AFTER_DRAIN) { E.fused(acc, cur, wr, wc, fr, fq, lds, wid, lane); S.done(cur); }
#undef PG8_SA
#undef PG8_SB
#undef PG8_STAGE
#undef PG8_LDA
#undef PG8_LDB
#undef PG8_MMA
#undef PG8_WAIT_V
#undef PG8_WAIT_L
#undef PG8_BAR
#undef PG8_SCHED
}
}
namespace pg8 {
__device__ __forceinline__ float fsigmoid(float x) { return __builtin_amdgcn_rcpf(1.0f + __builtin_amdgcn_exp2f(-1.4426950408889634f * x)); }
__device__ __forceinline__ float gelu_tanh(float x) { const float y = 1.5957691216057308f * (x + 0.044715f * x * x * x); return x * fsigmoid(y); }
__device__ __forceinline__ float bf_lo(unsigned w) { return __uint_as_float(w << 16); }
__device__ __forceinline__ float bf_hi(unsigned w) { return __uint_as_float(w & 0xffff0000u); }
__device__ __forceinline__ u32x4 pack8(const f32x4 v0, const f32x4 v1) { u32x4 w; w.x = cvt_pk_bf16(v0[0], v0[1]); w.y = cvt_pk_bf16(v0[2], v0[3]); w.z = cvt_pk_bf16(v1[0], v1[1]); w.w = cvt_pk_bf16(v1[2], v1[3]); return w; }
__device__ __forceinline__ void unpack8(const u32x4 w, f32x4& v0, f32x4& v1) { v0 = (f32x4){bf_lo(w.x), bf_hi(w.x), bf_lo(w.y), bf_hi(w.y)}; v1 = (f32x4){bf_lo(w.z), bf_hi(w.z), bf_lo(w.w), bf_hi(w.w)}; }

struct EpiInProj {
    static constexpr bool PERM = true, AFTER_DRAIN = false;
    bf16_t* O; const float* gate_b;
    __device__ __forceinline__ void operator()(const f32x4 (&acc)[2][2][4][2], const Unit& u, int wr, int wc, int fr, int fq) const {
        asm volatile("" : "+v"(fr), "+v"(fq));
        const int row0 = u.pm * BM + wr * 64 + fr, col0 = u.pn * BM + wc * 32 + 8 * fq;
        const int mode = u.pn < 4 ? 1 : (u.pn >= 23 ? 2 : 0);
        f32x4 bv[2][2];
#pragma unroll
        for (int bj = 0; bj < 2; ++bj)
#pragma unroll
            for (int n = 0; n < 2; ++n) bv[bj][n] = (mode == 2) ? *(const f32x4*)(gate_b + (col0 - 5888) + bj * HALF + 4 * n) : (f32x4){0.f, 0.f, 0.f, 0.f};
#pragma unroll
        for (int ai = 0; ai < 2; ++ai)
#pragma unroll
            for (int m = 0; m < 4; ++m) { bf16_t* rowp = O + (size_t)(row0 + ai * HALF + m * 16) * 12032 + col0;
#pragma unroll
                for (int bj = 0; bj < 2; ++bj) { f32x4 v0 = acc[ai][bj][m][0] + bv[bj][0], v1 = acc[ai][bj][m][1] + bv[bj][1];
                    if (mode == 1) {
#pragma unroll
                        for (int e = 0; e < 4; ++e) { v0[e] = gelu_tanh(v0[e]); v1[e] = gelu_tanh(v1[e]); } }
                    else if (mode == 2) {
#pragma unroll
                        for (int e = 0; e < 4; ++e) { v0[e] = fsigmoid(v0[e]); v1[e] = fsigmoid(v1[e]); } }
                    *(u32x4*)(rowp + bj * HALF) = pack8(v0, v1); } }
    }
};

struct EpiLora {
    static constexpr bool PERM = true, AFTER_DRAIN = false;
    bf16_t* PROJ; const bf16_t* KK; const bf16_t* RSK; bf16_t* G; const float* w0; const float* a0; const float* ka;
    __device__ __forceinline__ void operator()(const f32x4 (&acc)[2][2][4][2], const Unit& u, int wr, int wc, int fr, int fq) const {
        asm volatile("" : "+v"(fr), "+v"(fq));
        const int row0 = u.pm * BM + wr * 64 + fr, ch0 = (u.pn & 1) * BM + wc * 32 + 8 * fq, kind = u.pn >> 1;
        if (kind == 0) {
#pragma unroll
            for (int bj = 0; bj < 2; ++bj) { const int ch = ch0 + bj * HALF; const f32x4 b0 = *(const f32x4*)(w0 + ch), b1 = *(const f32x4*)(w0 + ch + 4);
#pragma unroll
                for (int ai = 0; ai < 2; ++ai)
#pragma unroll
                    for (int m = 0; m < 4; ++m) { const size_t row = (size_t)(row0 + ai * HALF + m * 16);
                        f32x4 v0 = acc[ai][bj][m][0] + b0, v1 = acc[ai][bj][m][1] + b1;
#pragma unroll
                        for (int e = 0; e < 4; ++e) { v0[e] = -0.6065306597126334f * fsigmoid(v0[e]); v1[e] = -0.6065306597126334f * fsigmoid(v1[e]); }
                        *(u32x4*)(PROJ + row * 12032 + 3840 + ch) = pack8(v0, v1); } }
        } else if (kind == 1) {
            f32x4 b0[2], b1[2], c0[2], c1[2];
#pragma unroll
            for (int bj = 0; bj < 2; ++bj) { const int ch = ch0 + bj * HALF; b0[bj] = *(const f32x4*)(a0 + ch); b1[bj] = *(const f32x4*)(a0 + ch + 4); c0[bj] = *(const f32x4*)(ka + ch); c1[bj] = *(const f32x4*)(ka + ch + 4); }
#pragma unroll
            for (int ai = 0; ai < 2; ++ai)
#pragma unroll
                for (int m = 0; m < 4; ++m) { size_t row = (size_t)(row0 + ai * HALF + m * 16); asm volatile("" : "+v"(row));
                    const bf16_t* kr = RSK + row * 512 + ch0; const bf16_t* qr = KK + row * 512 + ch0; bf16_t* pr = PROJ + row * 12032 + ch0;
#pragma unroll
                    for (int bj = 0; bj < 2; ++bj) {
                        const u32x4 kw = *(const u32x4*)(kr + bj * HALF), qw = *(const u32x4*)(qr + bj * HALF);
                        f32x4 k0, k1, q0, q1; unpack8(kw, k0, k1); unpack8(qw, q0, q1);
                        f32x4 p0, p1;
#pragma unroll
                        for (int e = 0; e < 4; ++e) { const float a_0 = fsigmoid(acc[ai][bj][m][0][e] + b0[bj][e]), a_1 = fsigmoid(acc[ai][bj][m][1][e] + b1[bj][e]);
                            p0[e] = k0[e] * (1.0f + (a_0 - 1.0f) * c0[bj][e]); p1[e] = k1[e] * (1.0f + (a_1 - 1.0f) * c1[bj][e]); q0[e] *= a_0; q1[e] *= a_1; }
                        *(u32x4*)(pr + 4352 + bj * HALF) = pack8(q0, q1);
                        *(u32x4*)(pr + 4864 + bj * HALF) = pack8(p0, p1); }
                    asm volatile("" ::: "memory"); }
        } else {
#pragma unroll
            for (int bj = 0; bj < 2; ++bj) { const int ch = ch0 + bj * HALF;
#pragma unroll
                for (int ai = 0; ai < 2; ++ai)
#pragma unroll
                    for (int m = 0; m < 4; ++m) { const size_t row = (size_t)(row0 + ai * HALF + m * 16); *(u32x4*)(G + row * 512 + ch) = pack8(acc[ai][bj][m][0], acc[ai][bj][m][1]); } }
        }
    }
};

struct EpiMerge {
    static constexpr bool PERM = true, AFTER_DRAIN = false;
    const bf16_t* PROJ; bf16_t* MG;
    __device__ __forceinline__ void operator()(const f32x4 (&acc)[2][2][4][2], const Unit& u, int wr, int wc, int fr, int fq) const {
        asm volatile("" : "+v"(fr), "+v"(fq));
        const int row0 = u.pm * BM + wr * 64 + fr, col0 = u.pn * BM + wc * 32 + 8 * fq, ks = u.boff >> 9, gi = ks > 2 ? 2 : ks;
#pragma unroll
        for (int ai = 0; ai < 2; ++ai)
#pragma unroll
            for (int m = 0; m < 4; ++m) { const size_t row = (size_t)(row0 + ai * HALF + m * 16);
#pragma unroll
                for (int bj = 0; bj < 2; ++bj) { const int col = col0 + bj * HALF;
                    f32x4 g0, g1, p0 = (f32x4){0.f, 0.f, 0.f, 0.f}, p1 = p0;
                    unpack8(*(const u32x4*)(PROJ + row * 12032 + 5888 + gi * 2048 + col), g0, g1);
                    if (ks != 0) unpack8(*(const u32x4*)(MG + row * 2048 + col), p0, p1);
                    p0 = p0 + g0 * acc[ai][bj][m][0]; p1 = p1 + g1 * acc[ai][bj][m][1];
                    *(u32x4*)(MG + row * 2048 + col) = pack8(p0, p1); } }
    }
};

struct EpiResid {
    static constexpr bool PERM = false, AFTER_DRAIN = false;
    const float* hin; float* out;
    __device__ __forceinline__ void operator()(const f32x4 (&acc)[2][2][4][2], const Unit& u, int wr, int wc, int fr, int fq) const {
        asm volatile("" : "+v"(fr), "+v"(fq));
        const int row0 = u.pm * BM + wr * 64 + fr, col0 = u.pn * BM + wc * 32 + 4 * fq;
#pragma unroll
        for (int ai = 0; ai < 2; ++ai)
#pragma unroll
            for (int m = 0; m < 4; ++m) { const size_t off = (size_t)(row0 + ai * HALF + m * 16) * 2048 + col0;
#pragma unroll
                for (int bj = 0; bj < 2; ++bj)
#pragma unroll
                    for (int n = 0; n < 2; ++n) { const f32x4 bs = *(const f32x4*)(hin + off + bj * HALF + n * 16); *(f32x4*)(out + off + bj * HALF + n * 16) = bs + acc[ai][bj][m][n]; } }
    }
};

struct EpiSwiGLU {
    static constexpr bool PERM = true, AFTER_DRAIN = false;
    bf16_t* O; int ldc, nt;
    __device__ __forceinline__ void operator()(const f32x4 (&acc)[2][2][4][2], const Unit& u, int wr, int wc, int fr, int fq) const {
        asm volatile("" : "+v"(fr), "+v"(fq));
        const int row0 = u.pm * BM + wr * 64 + fr, col0 = (u.pn % nt) * HALF + wc * 32 + 8 * fq;
#pragma unroll
        for (int ai = 0; ai < 2; ++ai)
#pragma unroll
            for (int m = 0; m < 4; ++m) { bf16_t* rowp = O + (size_t)(row0 + ai * HALF + m * 16) * ldc + col0;
                f32x4 v0, v1;
#pragma unroll
                for (int e = 0; e < 4; ++e) { const float a_0 = acc[ai][0][m][0][e], a_1 = acc[ai][0][m][1][e];
                    v0[e] = a_0 * fsigmoid(a_0) * acc[ai][1][m][0][e]; v1[e] = a_1 * fsigmoid(a_1) * acc[ai][1][m][1][e]; }
                *(u32x4*)rowp = pack8(v0, v1); }
    }
};

struct EpiPlain {
    static constexpr bool PERM = true, AFTER_DRAIN = false;
    bf16_t* O; int ldc, nt;
    __device__ __forceinline__ void operator()(const f32x4 (&acc)[2][2][4][2], const Unit& u, int wr, int wc, int fr, int fq) const {
        asm volatile("" : "+v"(fr), "+v"(fq));
        const int row0 = u.pm * BM + wr * 64 + fr, col0 = (u.pn % nt) * BM + wc * 32 + 8 * fq;
#pragma unroll
        for (int ai = 0; ai < 2; ++ai)
#pragma unroll
            for (int m = 0; m < 4; ++m) { bf16_t* rowp = O + (size_t)(row0 + ai * HALF + m * 16) * ldc + col0;
#pragma unroll
                for (int bj = 0; bj < 2; ++bj) *(u32x4*)(rowp + bj * HALF) = pack8(acc[ai][bj][m][0], acc[ai][bj][m][1]); }
    }
};

struct MergeOrder {
    StaticOrder so;
    __device__ __forceinline__ bool next(int i, Unit& u) const {
        if (!so.next(i >> 2, u)) return false;
        const int ks = i & 3; u.boff = ks * 512; u.aoff = ks == 0 ? 0 : (ks == 1 ? 1024 : (ks == 2 ? 2816 : 3328)); return true;
    }
    __device__ __forceinline__ void a_ready(const Unit&) const {}
    __device__ __forceinline__ void done(const Unit&) const {}
};

struct MoeOrder {
    int ts[8]; int nrt, nt, G, c;
    __device__ __forceinline__ bool next(int i, Unit& u) const {
        const long L = (long)i * G + c; if (L >= (long)nrt * nt) return false;
        const int rt = (int)(L / nt), pnl = (int)(L % nt); int e = 0;
#pragma unroll
        for (int j = 1; j < 8; ++j) e += (rt >= ts[j]) ? 1 : 0;
        u.pm = rt; u.pn = e * nt + pnl; u.aoff = 0; u.boff = 0; return true;
    }
    __device__ __forceinline__ void a_ready(const Unit&) const {}
    __device__ __forceinline__ void done(const Unit&) const {}
};
}

#ifndef PG8_SP2
#define PG8_SP2 true
#endif
#ifndef PG8_ALIGN
#define PG8_ALIGN true
#endif
constexpr int NWAVES = 8;
constexpr int BATCH = 8, SEQ = 2048, DM = 2048, M = BATCH * SEQ;
constexpr int NIN = 12032, GM_OFF = 0, RW_OFF = 1024, SB_OFF = 2816, GATE_OFF = 5888;
constexpr int C_LW = 3840, C_KKA = 4352, C_KP = 4864;
constexpr int YRAW_BYTE = 3072;
constexpr int DFF = 5632, DFE = 2816, NEXP = 8;
constexpr int XG_ROWS = 2 * M + NEXP * 256;
constexpr int N_PHASES = 24;
constexpr size_t MiB = 1u << 20;
constexpr size_t WS_CTL = 0, WS_LORA = 1 * MiB, ZERO_BYTES = 3 * MiB;
constexpr size_t WS_TAB = 3 * MiB, WS_GMW = 4 * MiB;
constexpr size_t WS_WIN = 5 * MiB, WS_PC = 99 * MiB, WS_WO = 115 * MiB, WS_W13 = 131 * MiB, WS_W2 = 175 * MiB, WS_W13E = 197 * MiB, WS_W2E = 373 * MiB;
constexpr size_t WS_XN = 461 * MiB, WS_PROJ = 525 * MiB, WS_RWT = 901 * MiB, WS_END = 989 * MiB;
constexpr size_t WS_H = WS_PROJ;
constexpr size_t WS_XG = 525 * MiB, WS_HX = 661 * MiB, WS_Y2 = 848 * MiB;
static_assert(WS_Y2 + (size_t)XG_ROWS * DM * 2 <= WS_END && WS_HX + (size_t)XG_ROWS * DFE * 2 <= WS_Y2 && WS_XG + (size_t)XG_ROWS * DM * 2 <= WS_HX, "moe overlay");
static_assert(WS_PROJ + (size_t)M * NIN * 2 <= WS_RWT && WS_H + (size_t)M * DFF * 2 <= WS_RWT && WS_RWT + (size_t)M * (5 * 512 + 256) * 2 <= WS_END, "ws map");
constexpr size_t RWT_R = 0, RWT_K = (size_t)M * 512, RWT_V = 2 * (size_t)M * 512, RWT_KK = 3 * (size_t)M * 512, RWT_G = 4 * (size_t)M * 512, RWT_LA = 5 * (size_t)M * 512;
constexpr int CW_BAR = 4096, CW_CNT = 1024;
constexpr int LDS_BYTES = 147456, LDSCTL_OFF = LDS_BYTES - 1024;

#define GAS __attribute__((address_space(1)))
#define LAS __attribute__((address_space(3)))
typedef unsigned short bf16;
typedef unsigned v4u __attribute__((ext_vector_type(4)));
typedef unsigned v2u __attribute__((ext_vector_type(2)));
typedef float f32x4 __attribute__((ext_vector_type(4)));
typedef float f32x16 __attribute__((ext_vector_type(16)));
typedef short bf16x8 __attribute__((ext_vector_type(8)));
typedef GAS unsigned gu32;
#define RLX_AGENT __ATOMIC_RELAXED, __HIP_MEMORY_SCOPE_AGENT
#define LDS_WAIT() asm volatile("s_waitcnt lgkmcnt(0)" ::: "memory")
#define VM_WAIT() asm volatile("s_waitcnt vmcnt(0)" ::: "memory")
__device__ __forceinline__ unsigned f2bf(float f) { unsigned u = __builtin_bit_cast(unsigned, f); return (u + 0x7fffu + ((u >> 16) & 1u)) >> 16; }
__device__ __forceinline__ unsigned pk2(float lo, float hi) { return f2bf(lo) | (f2bf(hi) << 16); }
__device__ __forceinline__ float bfl(unsigned w) { return __uint_as_float(w << 16); }
__device__ __forceinline__ float bfh(unsigned w) { return __uint_as_float(w & 0xffff0000u); }
__device__ __forceinline__ float bf1(bf16 h) { return __uint_as_float((unsigned)h << 16); }
__device__ __forceinline__ float fsig(float x) { return __builtin_amdgcn_rcpf(1.0f + __builtin_amdgcn_exp2f(-1.4426950408889634f * x)); }
__device__ __forceinline__ void unpk8(const v4u w, float (&v)[8]) { v[0] = bfl(w.x); v[1] = bfh(w.x); v[2] = bfl(w.y); v[3] = bfh(w.y); v[4] = bfl(w.z); v[5] = bfh(w.z); v[6] = bfl(w.w); v[7] = bfh(w.w); }
__device__ __forceinline__ v4u pk8(const float (&v)[8]) { v4u w; w.x = pk2(v[0], v[1]); w.y = pk2(v[2], v[3]); w.z = pk2(v[4], v[5]); w.w = pk2(v[6], v[7]); return w; }

#define XB_TMO      128
#define XB_XCNT(j)  (256  + 64 * (j))
#define XB_XSUB(j)  (1280 + 64 * (j))
#define XB_XGEN(j)  (2304 + 64 * (j))
#define XB_TOP      3328
#define XB_TOPGEN   3392
#define XCD_BAR_WORDS 3456
#define XB_SPIN_CAP (1u << 18)
__device__ __forceinline__ unsigned xb_ld(unsigned* p)              { return __hip_atomic_load(p, __ATOMIC_RELAXED, __HIP_MEMORY_SCOPE_AGENT); }
__device__ __forceinline__ unsigned xb_add(unsigned* p, unsigned v) { return __hip_atomic_fetch_add(p, v, __ATOMIC_RELAXED, __HIP_MEMORY_SCOPE_AGENT); }
__device__ __forceinline__ unsigned xb_xcc_id() { return (unsigned)__builtin_amdgcn_s_getreg((3 << 11) | 20) & 0xFu; }
#define XB_SPIN(cond, bar) do { unsigned _sp = 0; while (cond) { __builtin_amdgcn_s_sleep(1); \
    if ((++_sp & 255u) == 0u) { if (xb_ld(&(bar)[XB_TMO])) break; if (_sp > XB_SPIN_CAP) { atomicAdd(&(bar)[XB_TMO], 1u); break; } } } } while (0)
struct XcdBarrier { unsigned* bar; unsigned x; volatile LAS unsigned* st; };
__device__ __forceinline__ XcdBarrier xcd_barrier_post(unsigned* bar, volatile LAS unsigned* st) {
    XcdBarrier b; b.bar = bar; b.x = xb_xcc_id(); b.st = st;
    if (threadIdx.x == 0) (void)xb_add(&bar[XB_XCNT(b.x)], 1u);
    return b;
}
__device__ __forceinline__ void xcd_barrier_complete(unsigned* bar, unsigned x, unsigned& nloc, unsigned& nx) {
    const unsigned G = gridDim.x * gridDim.y * gridDim.z;
    unsigned sum, cnt, mine, sp = 0u;
    for (;;) {
        sum = 0u; cnt = 0u; mine = 0u;
#pragma unroll
        for (unsigned j = 0; j < 16; ++j) { const unsigned c = xb_ld(&bar[XB_XCNT(j)]); sum += c; cnt += (c > 0u) ? 1u : 0u; mine = (j == x) ? c : mine; }
        if (sum == G) break;
        __builtin_amdgcn_s_sleep(1);
        if ((++sp & 255u) == 0u) { if (xb_ld(&bar[XB_TMO])) break; if (sp > XB_SPIN_CAP) { atomicAdd(&bar[XB_TMO], 1u); break; } }
    }
    nloc = mine > 0u ? mine : 1u; nx = cnt > 0u ? cnt : 1u;
}
__device__ __forceinline__ void xcd_barrier(const XcdBarrier& b) {
    asm volatile("s_waitcnt vmcnt(0)" ::: "memory");
    __syncthreads();
    if (threadIdx.x == 0) {
        unsigned* bar = b.bar;
        __builtin_amdgcn_s_waitcnt(0);
        unsigned nloc = b.st[0], nx = b.st[1];
        if (nloc == 0u) { xcd_barrier_complete(bar, b.x, nloc, nx); b.st[0] = nloc; b.st[1] = nx; }
        const unsigned old = xb_add(&bar[XB_XSUB(b.x)], 1u);
        const unsigned gen = old / nloc;
        if (old + 1u == (gen + 1u) * nloc) {
            __builtin_amdgcn_fence(__ATOMIC_RELEASE, "agent");
            asm volatile("s_waitcnt vmcnt(0)" ::: "memory");
            const unsigned og = xb_add(&bar[XB_TOP], 1u);
            const unsigned tg = og / nx;
            if (og + 1u == (tg + 1u) * nx) xb_add(&bar[XB_TOPGEN], 1u);
            else XB_SPIN(xb_ld(&bar[XB_TOPGEN]) == tg, bar);
            __builtin_amdgcn_fence(__ATOMIC_ACQUIRE, "agent");
            xb_add(&bar[XB_XGEN(b.x)], 1u);
            asm volatile("s_waitcnt vmcnt(0)" ::: "memory");
        } else {
            XB_SPIN(xb_ld(&bar[XB_XGEN(b.x)]) == gen, bar);
            __builtin_amdgcn_fence(__ATOMIC_ACQUIRE, "agent");
            asm volatile("s_waitcnt vmcnt(0)" ::: "memory");
        }
    }
    __syncthreads();
}

struct Frame {
    LAS unsigned char* lds;
    unsigned char* ws;
    const float* const* in;
    int tid, lane, wave, G, gw, ngw;
};
__device__ __forceinline__ float wave_sum(float v) {
#pragma unroll
    for (int o = 1; o < 64; o <<= 1) v += __shfl_xor(v, o);
    return v;
}
__device__ __forceinline__ float sum8(float v) { v += __shfl_xor(v, 1); v += __shfl_xor(v, 2); v += __shfl_xor(v, 4); return v; }

__device__ __forceinline__ void tr_item(const float* W, int N, bf16* WT, int ldo, int koff, int rowbase, int mode, float sc, LAS float* scr, int k0, int n0, int lane) {
    const int lq = lane & 15, lr = lane >> 4;
#pragma unroll 4
    for (int i = 0; i < 16; ++i) { const int kk = 4 * i + lr; const f32x4 v = *(const GAS f32x4*)(W + (size_t)(k0 + kk) * N + n0 + 4 * lq);
        LAS float* s = scr + kk * 65 + 4 * lq; s[0] = v.x * sc; s[1] = v.y * sc; s[2] = v.z * sc; s[3] = v.w * sc; }
    LDS_WAIT(); asm volatile("" ::: "memory");
    const int c = lane & 7, ns = lane >> 3;
#pragma unroll
    for (int j = 0; j < 8; ++j) { const int n = n0 + ns + 8 * j; const int row = rowbase + (mode ? ((n >> 7) * 256 + (n & 127) + (mode == 2 ? 128 : 0)) : n);
        const LAS float* s = scr + (8 * c) * 65 + ns + 8 * j;
        v4u o; o.x = pk2(s[0 * 65], s[1 * 65]); o.y = pk2(s[2 * 65], s[3 * 65]); o.z = pk2(s[4 * 65], s[5 * 65]); o.w = pk2(s[6 * 65], s[7 * 65]);
        *(GAS v4u*)(WT + (size_t)row * ldo + koff + k0 + 8 * c) = o; }
    LDS_WAIT(); asm volatile("" ::: "memory");
}

__device__ __forceinline__ void rms_row_to_bf16(const float* xrow, const float* gain, bf16* orow, int lane) {
    const GAS f32x4* xr = (const GAS f32x4*)xrow + lane; const GAS f32x4* gr = (const GAS f32x4*)gain + lane;
    f32x4 v[8]; float s = 0.f;
#pragma unroll
    for (int j = 0; j < 8; ++j) { v[j] = xr[64 * j]; s += (v[j].x * v[j].x + v[j].y * v[j].y) + (v[j].z * v[j].z + v[j].w * v[j].w); }
    const float rstd = 1.0f / sqrtf(wave_sum(s) * (1.f / DM) + 1e-6f);
    GAS v2u* o8 = (GAS v2u*)orow + lane;
#pragma unroll
    for (int j = 0; j < 8; ++j) { const f32x4 g = gr[64 * j]; v2u o; o.x = pk2(v[j].x * rstd * g.x, v[j].y * rstd * g.y); o.y = pk2(v[j].z * rstd * g.z, v[j].w * rstd * g.w); o8[64 * j] = o; }
}

struct In { const float* p[33]; };
__device__ __forceinline__ void p0_prologue(Frame& F, const In& I) {
    LAS float* scr = (LAS float*)(F.lds + F.wave * 16640);
    unsigned char* ws = F.ws;
    int rot = 0;
    for (int j = 0; j < 43; ++j) {
        const float* W; int Kd, N, ldo, koff = 0, rowbase = 0, mode = 0, slo = 0, shi = 0; bf16* WT;
        if (j < 2)       { const int l = j;      W = I.p[2] + (size_t)l * 2048 * NIN;   Kd = 2048; N = NIN;  WT = (bf16*)(ws + WS_WIN) + (size_t)l * NIN * 2048; ldo = 2048; slo = SB_OFF; shi = SB_OFF + 1024; }
        else if (j < 4)  { const int l = j - 2;  W = I.p[19] + (size_t)l * 512 * 2048;  Kd = 512;  N = 2048; WT = (bf16*)(ws + WS_PC) + (size_t)l * 2048 * 2048;  ldo = 2048; koff = 0; }
        else if (j < 6)  { const int l = j - 4;  W = I.p[20] + (size_t)l * 512 * 2048;  Kd = 512;  N = 2048; WT = (bf16*)(ws + WS_PC) + (size_t)l * 2048 * 2048;  ldo = 2048; koff = 512; }
        else if (j < 8)  { const int l = j - 6;  W = I.p[21] + (size_t)l * 1024 * 2048; Kd = 1024; N = 2048; WT = (bf16*)(ws + WS_PC) + (size_t)l * 2048 * 2048;  ldo = 2048; koff = 1024; }
        else if (j < 10) { const int l = j - 8;  W = I.p[22] + (size_t)l * 2048 * 2048; Kd = 2048; N = 2048; WT = (bf16*)(ws + WS_WO) + (size_t)l * 2048 * 2048;  ldo = 2048; }
        else if (j == 10) { W = I.p[24]; Kd = 2048; N = DFF; WT = (bf16*)(ws + WS_W13); ldo = 2048; mode = 1; }
        else if (j == 11) { W = I.p[25]; Kd = 2048; N = DFF; WT = (bf16*)(ws + WS_W13); ldo = 2048; mode = 2; }
        else if (j == 12) { W = I.p[26]; Kd = DFF; N = 2048; WT = (bf16*)(ws + WS_W2); ldo = DFF; }
        else if (j < 21) { const int e = j - 13; W = I.p[29] + (size_t)e * 2048 * DFE; Kd = 2048; N = DFE; WT = (bf16*)(ws + WS_W13E); ldo = 2048; rowbase = e * 2 * DFE; mode = 1; }
        else if (j < 29) { const int e = j - 21; W = I.p[30] + (size_t)e * 2048 * DFE; Kd = 2048; N = DFE; WT = (bf16*)(ws + WS_W13E); ldo = 2048; rowbase = e * 2 * DFE; mode = 2; }
        else if (j < 37) { const int e = j - 29; W = I.p[31] + (size_t)e * DFE * 2048; Kd = DFE; N = 2048; WT = (bf16*)(ws + WS_W2E); ldo = DFE; rowbase = e * 2048; }
        else if (j < 39) { const int l = j - 37; W = I.p[10] + (size_t)l * 64 * 512;  Kd = 64;  N = 512; WT = (bf16*)(ws + WS_LORA) + (size_t)l * 1536 * 256; ldo = 256; koff = 0;   rowbase = 0; }
        else if (j < 41) { const int l = j - 39; W = I.p[12] + (size_t)l * 64 * 512;  Kd = 64;  N = 512; WT = (bf16*)(ws + WS_LORA) + (size_t)l * 1536 * 256; ldo = 256; koff = 64;  rowbase = 512; }
        else             { const int l = j - 41; W = I.p[13] + (size_t)l * 128 * 512; Kd = 128; N = 512; WT = (bf16*)(ws + WS_LORA) + (size_t)l * 1536 * 256; ldo = 256; koff = 128; rowbase = 1024; }
        const int nnb = N / 64, nitems = (Kd / 64) * nnb;
        int start = F.gw - rot; if (start < 0) start += F.ngw;
        for (int it = start; it < nitems; it += F.ngw) { const int kb = it / nnb, nb = it - kb * nnb, n0 = 64 * nb;
            tr_item(W, N, WT, ldo, koff, rowbase, mode, (n0 >= slo && n0 < shi) ? 0.125f : 1.0f, scr, 64 * kb, n0, F.lane); }
        rot = (rot + nitems) % F.ngw;
    }
    { const float* gw = I.p[6]; bf16* o = (bf16*)(ws + WS_GMW);
      for (int g = blockIdx.x * 512 + F.tid; g < 2 * 8 * 128 * 128 / 8; g += F.G * 512) { const int s0 = (g & 15) * 8, t = (g >> 4) & 127;
          const f32x4 a = *(const GAS f32x4*)(gw + (size_t)g * 8), b = *(const GAS f32x4*)(gw + (size_t)g * 8 + 4);
          float v[8] = {a.x, a.y, a.z, a.w, b.x, b.y, b.z, b.w};
#pragma unroll
          for (int e = 0; e < 8; ++e) if (s0 + e > t) v[e] = 0.f;
          *(GAS v4u*)(o + (size_t)g * 8) = pk8(v); } }
    for (int m = F.gw; m < M; m += F.ngw) rms_row_to_bf16(I.p[0] + (size_t)m * DM, I.p[1], (bf16*)(ws + WS_XN) + (size_t)m * DM, F.lane);
}

__device__ __forceinline__ void rw_elem_row(Frame& F, const In& I, int l, int m) {
    bf16* PROJ = (bf16*)(F.ws + WS_PROJ); bf16* RWT = (bf16*)(F.ws + WS_RWT);
    const bool has_prev = (m % SEQ) != 0;
    const bf16* cur = PROJ + (size_t)m * NIN + RW_OFF; const bf16* prv = cur - NIN;
    const float* mu = I.p[8] + l * 1792; const float* kkw = I.p[14] + l * 512;
#pragma unroll
    for (int i = 0; i < 4; ++i) {
        const int c = F.lane + 64 * i;
        if (c < 224) {
            float x[8], p[8];
            unpk8(*(const GAS v4u*)(cur + 8 * c), x);
            if (has_prev) unpk8(*(const GAS v4u*)(prv + 8 * c), p); else {
#pragma unroll
                for (int e = 0; e < 8; ++e) p[e] = 0.f; }
            const f32x4 m0 = *(const GAS f32x4*)(mu + 8 * c), m1 = *(const GAS f32x4*)(mu + 8 * c + 4);
            const float mm[8] = {m0.x, m0.y, m0.z, m0.w, m1.x, m1.y, m1.z, m1.w};
#pragma unroll
            for (int e = 0; e < 8; ++e) x[e] = x[e] + (p[e] - x[e]) * mm[e];
            if (i == 0) { *(GAS v4u*)(RWT + RWT_R + (size_t)m * 512 + 8 * c) = pk8(x); }
            else if (i == 1) { const int ch = 8 * (c - 64);
                *(GAS v4u*)(RWT + RWT_K + (size_t)m * 512 + ch) = pk8(x);
                const f32x4 k0 = *(const GAS f32x4*)(kkw + ch), k1 = *(const GAS f32x4*)(kkw + ch + 4);
                const float kw[8] = {k0.x, k0.y, k0.z, k0.w, k1.x, k1.y, k1.z, k1.w};
                float q[8], ss = 0.f;
#pragma unroll
                for (int e = 0; e < 8; ++e) { q[e] = x[e] * kw[e]; ss += q[e] * q[e]; }
                ss = sum8(ss);
                const float inv = 1.0f / fmaxf(sqrtf(ss), 1e-12f);
#pragma unroll
                for (int e = 0; e < 8; ++e) q[e] *= inv;
                *(GAS v4u*)(RWT + RWT_KK + (size_t)m * 512 + ch) = pk8(q); }
            else if (i == 2) { *(GAS v4u*)(RWT + RWT_V + (size_t)m * 512 + 8 * (c - 128)) = pk8(x); }
            else { const int cc = c - 192;
#pragma unroll
                for (int e = 0; e < 8; ++e) { if (cc < 8) x[e] = 1.0f - 2.0f * __builtin_amdgcn_rcpf(1.0f + __builtin_amdgcn_exp2f(2.885390081777927f * x[e])); else if (cc >= 16) x[e] = fsig(x[e]); }
                *(GAS v4u*)(RWT + RWT_LA + (size_t)m * 256 + 8 * cc) = pk8(x); }
        }
    }
}
__device__ __forceinline__ void gm_ln_row(Frame& F, const In& I, int l, int m) {
    bf16* vp = (bf16*)(F.ws + WS_PROJ) + (size_t)m * NIN + 512 + 8 * F.lane;
    float x[8]; unpk8(*(const GAS v4u*)vp, x);
    float s = 0.f;
#pragma unroll
    for (int e = 0; e < 8; ++e) s += x[e];
    const float mean = wave_sum(s) * (1.f / 512.f); float q = 0.f;
#pragma unroll
    for (int e = 0; e < 8; ++e) { x[e] -= mean; q += x[e] * x[e]; }
    const float rstd = 1.0f / sqrtf(wave_sum(q) * (1.f / 512.f) + 1e-5f);
    const float* g = I.p[4] + l * 512 + 8 * F.lane; const float* b = I.p[5] + l * 512 + 8 * F.lane;
    const f32x4 g0 = *(const GAS f32x4*)g, g1 = *(const GAS f32x4*)(g + 4), b0 = *(const GAS f32x4*)b, b1 = *(const GAS f32x4*)(b + 4);
    const float gg[8] = {g0.x, g0.y, g0.z, g0.w, g1.x, g1.y, g1.z, g1.w}, bb[8] = {b0.x, b0.y, b0.z, b0.w, b1.x, b1.y, b1.z, b1.w};
#pragma unroll
    for (int e = 0; e < 8; ++e) x[e] = x[e] * rstd * gg[e] + bb[e];
    *(GAS v4u*)vp = pk8(x);
}
#define MFMA32(a, b, c) __builtin_amdgcn_mfma_f32_32x32x16_bf16((a), (b), (c), 0, 0, 0)
__device__ __forceinline__ int crow(int r, int hi) { return (r & 3) + 8 * (r >> 2) + 4 * hi; }
__device__ __forceinline__ void sb_attn_unit(bf16* PROJ, int b, int h, int qt, int lane) {
    const int r32 = lane & 31, hi = lane >> 5;
    const size_t rowb = (size_t)b * SEQ;
    const bf16* Qp = PROJ + (rowb + qt * 32 + r32) * NIN + SB_OFF + h * 64 + hi * 8;
    bf16x8 qf[4];
#pragma unroll
    for (int ds = 0; ds < 4; ++ds) qf[ds] = *(const GAS bf16x8*)(Qp + ds * 16);
    f32x16 o0, o1;
#pragma unroll
    for (int r = 0; r < 16; ++r) { o0[r] = 0.f; o1[r] = 0.f; }
    float R = 0.f;
    const int tq = qt * 32 + r32;
    for (int kt = qt; kt >= 0; --kt) {
        const bf16* Kp = PROJ + (rowb + kt * 32 + r32) * NIN + SB_OFF + 1024 + h * 64 + hi * 8;
        bf16x8 kf[4];
#pragma unroll
        for (int ds = 0; ds < 4; ++ds) kf[ds] = *(const GAS bf16x8*)(Kp + ds * 16);
        const bf16* Vp = PROJ + (rowb + kt * 32) * NIN + SB_OFF + 2048 + h * 64 + r32;
        bf16x8 vf[2][2];
#pragma unroll
        for (int j = 0; j < 2; ++j)
#pragma unroll
            for (int dt = 0; dt < 2; ++dt)
#pragma unroll
                for (int e = 0; e < 8; ++e) vf[j][dt][e] = (short)*(const GAS bf16*)(Vp + (size_t)crow(8 * j + e, hi) * NIN + dt * 32);
        f32x16 st;
#pragma unroll
        for (int r = 0; r < 16; ++r) st[r] = 0.f;
#pragma unroll
        for (int ds = 0; ds < 4; ++ds) st = MFMA32(kf[ds], qf[ds], st);
        float sp[16]; const bool diag = (kt == qt);
#pragma unroll
        for (int r = 0; r < 16; ++r) { const float z = st[r]; const int s = kt * 32 + crow(r, hi);
            float v = (z > 20.f) ? z : 0.6931471805599453f * __builtin_amdgcn_logf(1.0f + __builtin_amdgcn_exp2f(1.4426950408889634f * z));
            if (diag && s >= tq) v = 0.f;
            sp[r] = v; }
        float rs[4], prs[4];
#pragma unroll
        for (int g = 0; g < 4; ++g) { rs[g] = (sp[4 * g] + sp[4 * g + 1]) + (sp[4 * g + 2] + sp[4 * g + 3]); prs[g] = __shfl_xor(rs[g], 32); }
        float carry = R; float att[16];
#pragma unroll
        for (int g = 3; g >= 0; --g) { float c = carry + (hi == 0 ? prs[g] : 0.f);
#pragma unroll
            for (int i = 3; i >= 0; --i) { const int r = 4 * g + i; c += sp[r]; const int s = kt * 32 + crow(r, hi);
                float a = __builtin_amdgcn_exp2f(1.4426950408889634f * (st[r] - c));
                if (diag && s >= tq) a = 0.f;
                att[r] = a; }
            carry += rs[g] + prs[g]; }
        R = carry;
        bf16x8 pa[2];
#pragma unroll
        for (int j = 0; j < 2; ++j) { v4u w; w.x = pk2(att[8 * j], att[8 * j + 1]); w.y = pk2(att[8 * j + 2], att[8 * j + 3]); w.z = pk2(att[8 * j + 4], att[8 * j + 5]); w.w = pk2(att[8 * j + 6], att[8 * j + 7]); pa[j] = __builtin_bit_cast(bf16x8, w); }
#pragma unroll
        for (int j = 0; j < 2; ++j) { o0 = MFMA32(pa[j], vf[j][0], o0); o1 = MFMA32(pa[j], vf[j][1], o1); }
        if (__all(R > 110.f)) break;
    }
    bf16* Op = PROJ + (rowb + qt * 32) * NIN + SB_OFF + h * 64 + r32;
#pragma unroll
    for (int r = 0; r < 16; ++r) { const size_t ro = (size_t)crow(r, hi) * NIN; *(GAS bf16*)(Op + ro) = (bf16)f2bf(o0[r]); *(GAS bf16*)(Op + ro + 32) = (bf16)f2bf(o1[r]); }
}
__device__ __forceinline__ void c1_phase(Frame& F, const In& I, int l) {
    for (int m = F.gw; m < M; m += F.ngw) { rw_elem_row(F, I, l, m); gm_ln_row(F, I, l, m); }
    bf16* PROJ = (bf16*)(F.ws + WS_PROJ);
    for (int u = F.gw; u < BATCH * 16 * 64; u += F.ngw) { const int qt = 63 - (u >> 7), bh = u & 127; sb_attn_unit(PROJ, bh >> 4, bh & 15, qt, F.lane); }
}

template <int CTRL> __device__ __forceinline__ float dppf(float v) { return __builtin_bit_cast(float, __builtin_amdgcn_update_dpp(0, __builtin_bit_cast(int, v), CTRL, 0xf, 0xf, true)); }
__device__ __forceinline__ float rowsum16(float x) { x += dppf<0xB1>(x); x += dppf<0x4E>(x); x += dppf<0x141>(x); x += dppf<0x140>(x); return x; }
__device__ __forceinline__ void scan_phase(Frame& F) {
    constexpr int TC = 32, NC = SEQ / TC, VEC_B = TC * 5 * 64 * 4, VV_B = TC * 16 * 4, YO_B = TC * 16 * 4, BUF_B = VEC_B + VV_B + YO_B;
    const bf16* PROJ = (const bf16*)(F.ws + WS_PROJ); const bf16* RWT = (const bf16*)(F.ws + WS_RWT);
    const int lane = F.lane;
    for (int u = blockIdx.x; u < BATCH * 8 * 4; u += F.G) {
        const int rb = u & 3, bh = u >> 2, h = bh & 7, b = bh >> 3;
        const size_t m0 = (size_t)b * SEQ;
        if (F.wave >= 4) {
            const int lw = F.wave - 4, st8 = lane >> 3, ch = h * 64 + 8 * (lane & 7), stv = lane >> 1, chv = h * 64 + rb * 16 + 8 * (lane & 1);
            v4u rg[5], rv = (v4u){0u, 0u, 0u, 0u};
#define SCAN_LOAD(c) do { const size_t mr = m0 + (size_t)(c) * TC + 8 * lw + st8; \
                rg[0] = *(const GAS v4u*)(RWT + RWT_KK + mr * 512 + ch); rg[1] = *(const GAS v4u*)(PROJ + mr * NIN + C_KKA + ch); rg[2] = *(const GAS v4u*)(PROJ + mr * NIN + C_KP + ch); \
                rg[3] = *(const GAS v4u*)(PROJ + mr * NIN + C_LW + ch); rg[4] = *(const GAS v4u*)(RWT + RWT_R + mr * 512 + ch); \
                if (lane < 16) rv = *(const GAS v4u*)(RWT + RWT_V + (m0 + (size_t)(c) * TC + 8 * lw + stv) * 512 + chv); } while (0)
#define SCAN_STORE(c) do { LAS unsigned char* bb = F.lds + ((c) & 1) * BUF_B; \
                _Pragma("unroll") for (int a = 0; a < 5; ++a) { float x[8]; unpk8(rg[a], x); \
                    if (a == 3) { _Pragma("unroll") for (int e = 0; e < 8; ++e) x[e] = __builtin_amdgcn_exp2f(1.4426950408889634f * x[e]); } \
                    LAS f32x4* d = (LAS f32x4*)(bb + (((8 * lw + st8) * 5 + a) * 64 + 8 * (lane & 7)) * 4); d[0] = (f32x4){x[0], x[1], x[2], x[3]}; d[1] = (f32x4){x[4], x[5], x[6], x[7]}; } \
                if (lane < 16) { float x[8]; unpk8(rv, x); LAS f32x4* d = (LAS f32x4*)(bb + VEC_B + ((8 * lw + stv) * 16 + 8 * (lane & 1)) * 4); d[0] = (f32x4){x[0], x[1], x[2], x[3]}; d[1] = (f32x4){x[4], x[5], x[6], x[7]}; } } while (0)
#define SCAN_FLUSH(c) do { const LAS float* yo = (const LAS float*)(F.lds + ((c) & 1) * BUF_B + VEC_B + VV_B); const int idx = lw * 128 + lane * 2, t = idx >> 4, ri = idx & 15; \
                const float y0 = yo[idx], y1 = yo[idx + 1]; \
                float* dst = (float*)((unsigned char*)F.ws + WS_PROJ + (m0 + (size_t)(c) * TC + t) * (size_t)(NIN * 2) + YRAW_BYTE) + h * 64 + rb * 16 + ri; \
                typedef float f32x2s __attribute__((ext_vector_type(2))); *(GAS f32x2s*)dst = (f32x2s){y0, y1}; } while (0)
            SCAN_LOAD(0); SCAN_STORE(0); SCAN_LOAD(1);
            LDS_WAIT(); __syncthreads();
            for (int c = 0; c < NC; ++c) {
                if (c + 1 < NC) SCAN_STORE(c + 1);
                if (c + 2 < NC) SCAN_LOAD(c + 2);
                if (c > 0) SCAN_FLUSH(c - 1);
                LDS_WAIT(); __syncthreads();
            }
            SCAN_FLUSH(NC - 1);
            __syncthreads();
#undef SCAN_LOAD
#undef SCAN_STORE
#undef SCAN_FLUSH
        } else {
            const int cw = F.wave, rl = lane >> 4, kq = lane & 15, row = 4 * cw + rl;
            float S0 = 0.f, S1 = 0.f, S2 = 0.f, S3 = 0.f;
            __syncthreads();
            for (int c = 0; c < NC; ++c) {
                const LAS unsigned char* bb = F.lds + (c & 1) * BUF_B;
                const LAS float* vvp = (const LAS float*)(bb + VEC_B) + row;
                LAS float* yo = (LAS float*)(bb + VEC_B + VV_B) + row;
#pragma unroll 4
                for (int t = 0; t < TC; ++t) {
                    const LAS f32x4* vp = (const LAS f32x4*)(bb + t * 1280) + kq;
                    const f32x4 kk = vp[0], kka = vp[16], kp = vp[32], w = vp[48], r = vp[64]; const float vv = vvp[t * 16];
                    float p = (S0 * kk.x + S1 * kk.y) + (S2 * kk.z + S3 * kk.w);
                    p = rowsum16(p);
                    const float sa = -p;
                    S0 = S0 * w.x + sa * kka.x + vv * kp.x; S1 = S1 * w.y + sa * kka.y + vv * kp.y; S2 = S2 * w.z + sa * kka.z + vv * kp.z; S3 = S3 * w.w + sa * kka.w + vv * kp.w;
                    float y = (S0 * r.x + S1 * r.y) + (S2 * r.z + S3 * r.w);
                    y = rowsum16(y);
                    if (kq == 0) yo[t * 16] = y;
                }
                LDS_WAIT(); __syncthreads();
            }
            __syncthreads();
        }
    }
}

__device__ __forceinline__ void rw_post_row(Frame& F, const In& I, int l, int m) {
    bf16* PROJ = (bf16*)(F.ws + WS_PROJ); const bf16* RWT = (const bf16*)(F.ws + WS_RWT);
    const int ch = 8 * F.lane;
    const float* yr = (const float*)((const unsigned char*)F.ws + WS_PROJ + (size_t)m * (NIN * 2) + YRAW_BYTE) + ch;
    const f32x4 y0 = *(const GAS f32x4*)yr, y1 = *(const GAS f32x4*)(yr + 4);
    float y[8] = {y0.x, y0.y, y0.z, y0.w, y1.x, y1.y, y1.z, y1.w};
    float r[8], kp[8], v[8], g[8];
    unpk8(*(const GAS v4u*)(RWT + RWT_R + (size_t)m * 512 + ch), r); unpk8(*(const GAS v4u*)(PROJ + (size_t)m * NIN + C_KP + ch), kp);
    unpk8(*(const GAS v4u*)(RWT + RWT_V + (size_t)m * 512 + ch), v); unpk8(*(const GAS v4u*)(RWT + RWT_G + (size_t)m * 512 + ch), g);
    const float* rk = I.p[16] + l * 512 + ch; const float* lg = I.p[17] + l * 512 + ch; const float* lb = I.p[18] + l * 512 + ch;
    const f32x4 a0 = *(const GAS f32x4*)rk, a1 = *(const GAS f32x4*)(rk + 4), b0 = *(const GAS f32x4*)lg, b1 = *(const GAS f32x4*)(lg + 4), c0 = *(const GAS f32x4*)lb, c1 = *(const GAS f32x4*)(lb + 4);
    const float rkk[8] = {a0.x, a0.y, a0.z, a0.w, a1.x, a1.y, a1.z, a1.w}, lgg[8] = {b0.x, b0.y, b0.z, b0.w, b1.x, b1.y, b1.z, b1.w}, lbb[8] = {c0.x, c0.y, c0.z, c0.w, c1.x, c1.y, c1.z, c1.w};
    float s = 0.f, bs = 0.f;
#pragma unroll
    for (int e = 0; e < 8; ++e) { s += y[e]; bs += r[e] * kp[e] * rkk[e]; }
    const float mean = sum8(s) * (1.f / 64.f); bs = sum8(bs);
    float q = 0.f;
#pragma unroll
    for (int e = 0; e < 8; ++e) { y[e] -= mean; q += y[e] * y[e]; }
    const float rstd = 1.0f / sqrtf(sum8(q) * (1.f / 64.f) + 64e-5f);
    float o[8];
#pragma unroll
    for (int e = 0; e < 8; ++e) o[e] = (y[e] * rstd * lgg[e] + lbb[e] + bs * v[e]) * g[e];
    *(GAS v4u*)(PROJ + (size_t)m * NIN + RW_OFF + ch) = pk8(o);
}
__device__ __forceinline__ void gmlp_unit(Frame& F, const In& I, int l, int b, int c, int h) {
    bf16* PROJ = (bf16*)(F.ws + WS_PROJ); const bf16* GW = (const bf16*)(F.ws + WS_GMW) + ((size_t)l * 8 + h) * 128 * 128;
    const int lane = F.lane, r32 = lane & 31, hi = lane >> 5;
    const size_t mrow0 = (size_t)b * SEQ + (size_t)c * 128;
    f32x16 acc[4][2];
#pragma unroll
    for (int i = 0; i < 4; ++i)
#pragma unroll
        for (int j = 0; j < 2; ++j)
#pragma unroll
            for (int r = 0; r < 16; ++r) acc[i][j][r] = 0.f;
    const bf16* Vp = PROJ + mrow0 * NIN + 512 + h * 64 + r32;
#pragma unroll
    for (int ks = 0; ks < 8; ++ks) {
        bf16x8 bf0, bf1_;
        const bf16* Vk = Vp + (size_t)(16 * ks + 8 * hi) * NIN; asm volatile("" : "+v"(Vk));
#pragma unroll
        for (int e = 0; e < 8; ++e) { const size_t ro = (size_t)e * NIN; bf0[e] = (short)*(const GAS bf16*)(Vk + ro); bf1_[e] = (short)*(const GAS bf16*)(Vk + ro + 32); }
#pragma unroll
        for (int i = 0; i < 4; ++i) if (ks <= 2 * i + 1) {
            const bf16x8 a = *(const GAS bf16x8*)(GW + (size_t)(32 * i + r32) * 128 + 16 * ks + 8 * hi);
            acc[i][0] = MFMA32(a, bf0, acc[i][0]); acc[i][1] = MFMA32(a, bf1_, acc[i][1]); }
        asm volatile("" ::: "memory");
    }
    const float* bs = I.p[7] + ((size_t)l * 8 + h) * 128;
#pragma unroll
    for (int i = 0; i < 4; ++i) {
        bf16* Ui = PROJ + (mrow0 + 32 * i + 4 * hi) * NIN + h * 64 + r32; asm volatile("" : "+v"(Ui));
        const float* bsi = bs + 32 * i + 4 * hi; asm volatile("" : "+v"(bsi));
#pragma unroll
        for (int r = 0; r < 16; ++r) { const int tl = (r & 3) + 8 * (r >> 2); const float bsv = bsi[tl];
            bf16* up = Ui + (size_t)tl * NIN;
            const float u0 = bf1(*(const GAS bf16*)up), u1 = bf1(*(const GAS bf16*)(up + 32));
            *(GAS bf16*)up = (bf16)f2bf(u0 * (acc[i][0][r] + bsv)); *(GAS bf16*)(up + 32) = (bf16)f2bf(u1 * (acc[i][1][r] + bsv));
            if ((r & 3) == 3) asm volatile("" ::: "memory"); }
    }
}
__device__ __forceinline__ void c4_phase(Frame& F, const In& I, int l) {
    for (int m = F.gw; m < M; m += F.ngw) rw_post_row(F, I, l, m);
    for (int u = F.gw; u < BATCH * 16 * 8; u += F.ngw) gmlp_unit(F, I, l, u >> 7, (u >> 3) & 15, u & 7);
}

__device__ __forceinline__ void router_row(Frame& F, const In& I, int m, const float* hbuf) {
    const int lane = F.lane;
    const GAS f32x4* xr = (const GAS f32x4*)(hbuf + (size_t)m * DM) + lane; const GAS f32x4* gr = (const GAS f32x4*)(I.p[23] + DM) + lane;
    const float* rw = I.p[27];
    float lg[8]; float s = 0.f;
#pragma unroll
    for (int e = 0; e < 8; ++e) lg[e] = 0.f;
    GAS v2u* o8 = (GAS v2u*)((bf16*)(F.ws + WS_XN) + (size_t)m * DM) + lane;
    f32x4 xv[8];
#pragma unroll
    for (int j = 0; j < 8; ++j) { const f32x4 x = xr[64 * j]; s += (x.x * x.x + x.y * x.y) + (x.z * x.z + x.w * x.w); xv[j] = x; }
    const float rstd = 1.0f / sqrtf(wave_sum(s) * (1.f / DM) + 1e-6f);
#pragma unroll
    for (int j = 0; j < 8; ++j) { const f32x4 g = gr[64 * j]; const float n[4] = {xv[j].x * rstd * g.x, xv[j].y * rstd * g.y, xv[j].z * rstd * g.z, xv[j].w * rstd * g.w};
        v2u o; o.x = pk2(n[0], n[1]); o.y = pk2(n[2], n[3]); o8[64 * j] = o;
        const int c0 = 4 * (lane + 64 * j);
#pragma unroll
        for (int q = 0; q < 4; ++q) { const f32x4 w0 = *(const GAS f32x4*)(rw + (size_t)(c0 + q) * 8), w1 = *(const GAS f32x4*)(rw + (size_t)(c0 + q) * 8 + 4);
            lg[0] += n[q] * w0.x; lg[1] += n[q] * w0.y; lg[2] += n[q] * w0.z; lg[3] += n[q] * w0.w; lg[4] += n[q] * w1.x; lg[5] += n[q] * w1.y; lg[6] += n[q] * w1.z; lg[7] += n[q] * w1.w; } }
#pragma unroll
    for (int e = 0; e < 8; ++e) lg[e] = wave_sum(lg[e]) + I.p[28][e];
    int e0 = 0; float v0 = lg[0];
#pragma unroll
    for (int e = 1; e < 8; ++e) if (lg[e] > v0) { v0 = lg[e]; e0 = e; }
    int e1 = -1; float v1 = -3.0e38f;
#pragma unroll
    for (int e = 0; e < 8; ++e) if (e != e0 && lg[e] > v1) { v1 = lg[e]; e1 = e; }
    const float p1 = 1.0f / (1.0f + __expf(v0 - v1)), p0 = 1.0f - p1;
    if (lane == 0) {
        unsigned* cnt = (unsigned*)(F.ws + WS_CTL) + CW_CNT;
        const unsigned s0 = __hip_atomic_fetch_add(cnt + e0, 1u, RLX_AGENT), s1 = __hip_atomic_fetch_add(cnt + e1, 1u, RLX_AGENT);
        int* tab = (int*)(F.ws + WS_TAB) + (size_t)m * 8;
        tab[0] = e0; tab[1] = e1; tab[2] = (int)s0; tab[3] = (int)s1; ((float*)tab)[4] = p0; ((float*)tab)[5] = p1;
    }
}
__device__ __forceinline__ void moe_offsets(Frame& F, int (&off)[8], int (&ts)[8], int& nrt) {
    const unsigned* cnt = (const unsigned*)(F.ws + WS_CTL) + CW_CNT; int acc = 0;
#pragma unroll
    for (int e = 0; e < 8; ++e) { const int c = (int)__builtin_amdgcn_readfirstlane((int)__hip_atomic_load(cnt + e, RLX_AGENT)); ts[e] = acc; off[e] = acc * 256; acc += (c + 255) >> 8; }
    nrt = acc;
}
__device__ __forceinline__ void gather_phase(Frame& F) {
    const unsigned* cnt = (const unsigned*)(F.ws + WS_CTL) + CW_CNT;
    const int cj = (F.lane < 8) ? (int)__hip_atomic_load(cnt + (F.lane & 7), RLX_AGENT) : 0;
    const int tiles = (cj + 255) >> 8; int incl = tiles;
#pragma unroll
    for (int d = 1; d < 8; d <<= 1) { const int t = __shfl_up(incl, d); if (F.lane >= d) incl += t; }
    const int offv = (incl - tiles) * 256;
    const bf16* XN = (const bf16*)(F.ws + WS_XN); bf16* XG = (bf16*)(F.ws + WS_XG);
    for (int m = F.gw; m < M; m += F.ngw) {
        int* tab = (int*)(F.ws + WS_TAB) + (size_t)m * 8;
        const int e0 = tab[0], e1 = tab[1], s0 = __shfl(offv, e0) + tab[2], s1 = __shfl(offv, e1) + tab[3];
        const GAS v4u* src = (const GAS v4u*)(XN + (size_t)m * DM) + F.lane; GAS v4u* d0 = (GAS v4u*)(XG + (size_t)s0 * DM) + F.lane; GAS v4u* d1 = (GAS v4u*)(XG + (size_t)s1 * DM) + F.lane;
#pragma unroll
        for (int j = 0; j < 4; ++j) { const v4u x = src[64 * j]; d0[64 * j] = x; d1[64 * j] = x; }
        if (F.lane == 0) { tab[6] = s0; tab[7] = s1; }
    }
}
__device__ __forceinline__ void final_row(Frame& F, const In& I, int m, float* hbuf) {
    const int lane = F.lane;
    const int* tab = (const int*)(F.ws + WS_TAB) + (size_t)m * 8;
    const float p0 = ((const float*)tab)[4], p1 = ((const float*)tab)[5]; const int s0 = tab[6], s1 = tab[7];
    const bf16* Y2 = (const bf16*)(F.ws + WS_Y2);
    GAS f32x4* xr = (GAS f32x4*)(hbuf + (size_t)m * DM) + lane; const GAS f32x4* gr = (const GAS f32x4*)I.p[32] + lane;
    const GAS v2u* ya = (const GAS v2u*)(Y2 + (size_t)s0 * DM) + lane; const GAS v2u* yb = (const GAS v2u*)(Y2 + (size_t)s1 * DM) + lane;
    f32x4 v[8]; float s = 0.f;
#pragma unroll
    for (int j = 0; j < 8; ++j) { f32x4 x = xr[64 * j]; const v2u a = ya[64 * j], b = yb[64 * j];
        x.x += p0 * bfl(a.x) + p1 * bfl(b.x); x.y += p0 * bfh(a.x) + p1 * bfh(b.x); x.z += p0 * bfl(a.y) + p1 * bfl(b.y); x.w += p0 * bfh(a.y) + p1 * bfh(b.y);
        v[j] = x; s += (x.x * x.x + x.y * x.y) + (x.z * x.z + x.w * x.w); }
    const float rstd = 1.0f / sqrtf(wave_sum(s) * (1.f / DM) + 1e-6f);
#pragma unroll
    for (int j = 0; j < 8; ++j) { const f32x4 g = gr[64 * j]; xr[64 * j] = (f32x4){v[j].x * rstd * g.x, v[j].y * rstd * g.y, v[j].z * rstd * g.z, v[j].w * rstd * g.w}; }
}

#ifndef PH_MASK
#define PH_MASK 0xFFFFFF
#endif
#define PK(kind) (((PH_MASK) >> (kind)) & 1)
#define IN(k) (lo <= (k) && (k) < hi)
#define SEAM(k) do { if (IN(k) && IN((k) + 1)) xcd_barrier(bar); } while (0)
template <int l> __device__ __forceinline__ void layer_body(Frame& F, const In& I, unsigned char* ws, float* hout, const XcdBarrier& bar, int lo, int hi) {
    LAS unsigned char* ring = F.lds;
    bf16* const XN = (bf16*)(ws + WS_XN); bf16* const PROJ = (bf16*)(ws + WS_PROJ); bf16* const RWT = (bf16*)(ws + WS_RWT);
        const int base = 1 + 11 * l;
        const float* hin = (l == 0) ? I.p[0] : (const float*)hout;
        if (PK(1) && IN(base + 0)) {
            pg8::Gemm g{XN, (const bf16*)(ws + WS_WIN) + (size_t)l * NIN * 2048, 2048, 2048, 2048}; pg8::StaticOrder S; S.init(M, NIN, F.G, (int)blockIdx.x);
            pg8::EpiInProj E{PROJ, I.p[3] + l * 3 * DM};
            pg8::gemm_phase<pg8::EpiInProj, pg8::StaticOrder, PG8_ALIGN, PG8_SP2>(ring, g, S, E);
        } SEAM(base + 0);
        if (PK(2) && IN(base + 1)) { c1_phase(F, I, l); } SEAM(base + 1);
        if (PK(3) && IN(base + 2)) {
            int kl = 256; asm volatile("" : "+s"(kl));
            pg8::Gemm g{RWT + RWT_LA, (const bf16*)(ws + WS_LORA) + (size_t)l * 1536 * 256, kl, 256, 256}; pg8::StaticOrder S; S.init(M, 1536, F.G, (int)blockIdx.x);
            pg8::EpiLora E{PROJ, RWT + RWT_KK, RWT + RWT_K, RWT + RWT_G, I.p[9] + l * 512, I.p[11] + l * 512, I.p[15] + l * 512};
            pg8::gemm_phase<pg8::EpiLora, pg8::StaticOrder, PG8_ALIGN, PG8_SP2>(ring, g, S, E);
        } SEAM(base + 2);
        if (PK(4) && IN(base + 3)) { scan_phase(F); } SEAM(base + 3);
        if (PK(5) && IN(base + 4)) { c4_phase(F, I, l); } SEAM(base + 4);
        if (PK(6) && IN(base + 5)) {
            pg8::Gemm g{PROJ, (const bf16*)(ws + WS_PC) + (size_t)l * 2048 * 2048, 512, NIN, 2048}; pg8::MergeOrder S; S.so.init(M, DM, F.G, (int)blockIdx.x);
            pg8::EpiMerge E{PROJ, XN};
            pg8::gemm_phase<pg8::EpiMerge, pg8::MergeOrder, PG8_ALIGN, PG8_SP2>(ring, g, S, E);
        } SEAM(base + 5);
        if (PK(7) && IN(base + 6)) {
            pg8::Gemm g{XN, (const bf16*)(ws + WS_WO) + (size_t)l * 2048 * 2048, 2048, 2048, 2048}; pg8::StaticOrder S; S.init(M, DM, F.G, (int)blockIdx.x);
            pg8::EpiResid E{hin, hout};
            pg8::gemm_phase<pg8::EpiResid, pg8::StaticOrder, PG8_ALIGN, PG8_SP2>(ring, g, S, E);
        } SEAM(base + 6);
        if (l == 0) {
            if (PK(8) && IN(base + 7)) { for (int m = F.gw; m < M; m += F.ngw) rms_row_to_bf16(hout + (size_t)m * DM, I.p[23], XN + (size_t)m * DM, F.lane); } SEAM(base + 7);
            if (PK(9) && IN(base + 8)) {
                pg8::Gemm g{XN, (const bf16*)(ws + WS_W13), 2048, 2048, 2048}; pg8::StaticOrder S; S.init(M, 2 * DFF, F.G, (int)blockIdx.x);
                pg8::EpiSwiGLU E{(bf16*)(ws + WS_H), DFF, 2 * DFF / 256};
                pg8::gemm_phase<pg8::EpiSwiGLU, pg8::StaticOrder, PG8_ALIGN, PG8_SP2>(ring, g, S, E);
            } SEAM(base + 8);
            if (PK(10) && IN(base + 9)) {
                pg8::Gemm g{(const bf16*)(ws + WS_H), (const bf16*)(ws + WS_W2), DFF, DFF, DFF}; pg8::StaticOrder S; S.init(M, DM, F.G, (int)blockIdx.x);
                pg8::EpiResid E{hout, hout};
                pg8::gemm_phase<pg8::EpiResid, pg8::StaticOrder, PG8_ALIGN, PG8_SP2>(ring, g, S, E);
            } SEAM(base + 9);
            if (PK(8) && IN(base + 10)) { for (int m = F.gw; m < M; m += F.ngw) rms_row_to_bf16(hout + (size_t)m * DM, I.p[1] + DM, XN + (size_t)m * DM, F.lane); } SEAM(base + 10);
        } else {
            if (PK(11) && IN(base + 7)) { for (int m = F.gw; m < M; m += F.ngw) router_row(F, I, m, hout); } SEAM(base + 7);
            if (PK(12) && IN(base + 8)) { gather_phase(F); } SEAM(base + 8);
            if (PK(13) && IN(base + 9)) {
                pg8::MoeOrder S; int off[8]; moe_offsets(F, off, S.ts, S.nrt); S.nt = 2 * DFE / 256; S.G = F.G; S.c = (int)blockIdx.x;
                pg8::Gemm g{(const bf16*)(ws + WS_XG), (const bf16*)(ws + WS_W13E), 2048, 2048, 2048};
                pg8::EpiSwiGLU E{(bf16*)(ws + WS_HX), DFE, 2 * DFE / 256};
                pg8::gemm_phase<pg8::EpiSwiGLU, pg8::MoeOrder, PG8_ALIGN, PG8_SP2>(ring, g, S, E);
            } SEAM(base + 9);
            if (PK(14) && IN(base + 10)) {
                pg8::MoeOrder S; int off[8]; moe_offsets(F, off, S.ts, S.nrt); S.nt = DM / 256; S.G = F.G; S.c = (int)blockIdx.x;
                pg8::Gemm g{(const bf16*)(ws + WS_HX), (const bf16*)(ws + WS_W2E), DFE, DFE, DFE};
                pg8::EpiPlain E{(bf16*)(ws + WS_Y2), DM, DM / 256};
                pg8::gemm_phase<pg8::EpiPlain, pg8::MoeOrder, PG8_ALIGN, PG8_SP2>(ring, g, S, E);
            } SEAM(base + 10);
            if (PK(15) && IN(base + 11)) { for (int m = F.gw; m < M; m += F.ngw) final_row(F, I, m, hout); }
        }
    }
struct Args { In in; float* out; unsigned char* ws; int ph_lo, ph_hi; };
__global__ void __launch_bounds__(NWAVES * 64, 2) trunk_fwd(Args args) {
    extern __shared__ __attribute__((aligned(16))) unsigned char lds_raw[];
    Frame F;
    F.lds = (LAS unsigned char*)lds_raw; F.ws = args.ws; F.in = nullptr;
    F.tid = threadIdx.x; F.lane = F.tid & 63; F.wave = __builtin_amdgcn_readfirstlane(F.tid >> 6);
    F.G = gridDim.x; F.gw = blockIdx.x * NWAVES + F.wave; F.ngw = F.G * NWAVES;
    const In& I = args.in;
    unsigned char* ws = args.ws;
    for (int u = F.tid; u < (LDS_BYTES - LDSCTL_OFF) / 4; u += NWAVES * 64) ((LAS unsigned*)(F.lds + LDSCTL_OFF))[u] = 0u;
    __syncthreads();
    const int lo = args.ph_lo, hi = args.ph_hi;
    XcdBarrier bar; bar.bar = (unsigned*)(ws + WS_CTL) + CW_BAR; bar.x = 0; bar.st = nullptr;
    if (hi - lo > 1) bar = xcd_barrier_post((unsigned*)(ws + WS_CTL) + CW_BAR, (volatile LAS unsigned*)(F.lds + LDSCTL_OFF) + 8);
    LAS unsigned char* ring = F.lds;
    bf16* const XN = (bf16*)(ws + WS_XN); bf16* const PROJ = (bf16*)(ws + WS_PROJ); bf16* const RWT = (bf16*)(ws + WS_RWT);
    float* const hout = args.out;

    if (PK(0) && IN(0)) { p0_prologue(F, I); } SEAM(0);

    layer_body<0>(F, I, ws, hout, bar, lo, hi);
    layer_body<1>(F, I, ws, hout, bar, lo, hi);
#undef IN
#undef SEAM
}

#ifndef MK_SPLIT
#define MK_SPLIT 0
#endif
extern "C" void kernel_launch(void* const* d_in, const int* in_sizes, int n_in, void* d_out, int out_size, void* d_ws, size_t ws_size, hipStream_t stream) {
    static int grid = 0;
    if (grid == 0) {
        if (n_in != 33 || in_sizes[0] != M * DM || out_size != M * DM || ws_size < WS_END) { fprintf(stderr, "kernel_launch: unexpected shapes (n_in %d, ws %zu); nothing launched\n", n_in, ws_size); grid = -1; return; }
        int dev = 0, cus = 0, per_cu = 0;
        if (hipGetDevice(&dev) != hipSuccess || hipDeviceGetAttribute(&cus, hipDeviceAttributeMultiprocessorCount, dev) != hipSuccess) { grid = -1; return; }
        if (hipFuncSetAttribute((const void*)trunk_fwd, hipFuncAttributeMaxDynamicSharedMemorySize, LDS_BYTES) != hipSuccess) { fprintf(stderr, "kernel_launch: hipFuncSetAttribute failed\n"); grid = -1; return; }
        if (hipOccupancyMaxActiveBlocksPerMultiprocessor(&per_cu, (const void*)trunk_fwd, NWAVES * 64, LDS_BYTES) != hipSuccess || per_cu < 1) { fprintf(stderr, "kernel_launch: occupancy query says %d\n", per_cu); }
        (void)hipGetLastError();
        grid = cus;
    }
    if (grid < 0) return;
    if (hipMemsetAsync((char*)d_ws, 0, ZERO_BYTES, stream) != hipSuccess) return;
    Args a{};
    for (int i = 0; i < 33; ++i) a.in.p[i] = (const float*)d_in[i];
    a.out = (float*)d_out; a.ws = (unsigned char*)d_ws;
#if MK_SPLIT
    for (int p = 0; p < N_PHASES; ++p) { a.ph_lo = p; a.ph_hi = p + 1; hipLaunchKernelGGL(trunk_fwd, dim3(grid), dim3(NWAVES * 64), LDS_BYTES, stream, a); }
#else
    a.ph_lo = 0; a.ph_hi = N_PHASES;
    hipLaunchKernelGGL(trunk_fwd, dim3(grid), dim3(NWAVES * 64), LDS_BYTES, stream, a);
#endif
    const hipError_t le = hipPeekAtLastError();
    if (le != hipSuccess) fprintf(stderr, "kernel_launch: launch failed: %s\n", hipGetErrorName(le));
}
```

```cpp
#include <hip/hip_runtime.h>
#include <cstdio>
#include <cstdint>
namespace pg8 {
#define PG8_LAS __attribute__((address_space(3)))
typedef unsigned short bf16_t;
typedef short bf16x8 __attribute__((ext_vector_type(8)));
typedef float f32x4 __attribute__((ext_vector_type(4)));
typedef unsigned u32x4 __attribute__((ext_vector_type(4)));
constexpr int BM = 256, BK = 64, HALF = 128, HTB = HALF * BK * 2  , STAGE_BYTES = 8 * HTB, NXCD = 8, WGM = 8;

__host__ __device__ __forceinline__ int lds_byte(int r, int c) { const int st = (r >> 4) * 2 + (c >> 5), rr = r & 15, cc = c & 31, ob = rr * 64 + cc * 2; return st * 1024 + (ob ^ (((ob >> 9) & 1) << 5)); }
__host__ __device__ __forceinline__ void stage_rc(int b, int& R, int& C) { const int st = b / 1024, sb = b % 1024, swz = sb ^ (((sb >> 9) & 1) << 5); R = (st >> 1) * 16 + swz / 64; C = (st & 1) * 32 + (swz % 64) / 2; }
__host__ __device__ __forceinline__ int perm32(int rho) { const int n = rho >> 4, i = rho & 15; return 8 * (i >> 2) + 4 * n + (i & 3); }

struct Unit { int pm, pn, aoff, boff; };
struct Gemm { const bf16_t* A; const bf16_t* Bt; int K, lda, ldb; };

struct StaticOrder {
    int nM, nN, nwg, G, c;
    __host__ __device__ void init(int M, int N, int G_, int c_) { nM = M / BM; nN = N / BM; nwg = nM * nN; G = G_; c = c_; }
    __host__ __device__ bool next(int i, Unit& u) const {
        const long L = (long)i * G + c; if (L >= nwg) return false;
        int wgid = (int)L; { const int q = nwg / NXCD, r = nwg % NXCD, xcd = wgid % NXCD, off = wgid / NXCD; wgid = (xcd < r ? xcd * (q + 1) : r * (q + 1) + (xcd - r) * q) + off; }
        const int nig = WGM * nN, gid = wgid / nig, fm = gid * WGM, gsz = (nM - fm) < WGM ? (nM - fm) : WGM;
        u.pm = fm + ((wgid % nig) % gsz); u.pn = (wgid % nig) / gsz; u.aoff = 0; u.boff = 0; return true;
    }
    __device__ __forceinline__ void a_ready(const Unit&) const {}
    __device__ __forceinline__ void done(const Unit&) const {}
};

__device__ __forceinline__ unsigned cvt_pk_bf16(float lo, float hi) { unsigned r; asm volatile("v_cvt_pk_bf16_f32 %0, %1, %2" : "=v"(r) : "v"(lo), "v"(hi)); return r; }
typedef float f32x2 __attribute__((ext_vector_type(2)));
__device__ __forceinline__ f32x2 gelu_pk(f32x2 v) {
    const f32x2 av = __builtin_elementwise_abs(v), d = av * 0.2316418882f + 1.0f;
    f32x2 t; t.x = __builtin_amdgcn_rcpf(d.x); t.y = __builtin_amdgcn_rcpf(d.y);
    f32x2 q = t * 0.5307027145f + (-0.7265760135f); q = q * t + 0.7107068705f; q = q * t + (-0.142248368f); q = q * t + 0.127414796f; q = q * t;
    const f32x2 s = (v * v) * (-0.72134752044f);
    f32x2 e; e.x = __builtin_amdgcn_exp2f(s.x); e.y = __builtin_amdgcn_exp2f(s.y);
    const f32x2 m = v * (q * e), r = v - m;
    f32x2 o; o.x = v.x < 0.f ? m.x : r.x; o.y = v.y < 0.f ? m.y : r.y; return o;
}

template <int ACT  > struct EpiBf16 {
    static constexpr bool PERM = true, AFTER_DRAIN = false; static_assert(ACT == 0 || ACT == 1, "EpiBf16: ACT is 0 (none) or 1 (gelu_pk)");
    bf16_t* O; int ldc; const float* bias; int split_cols; size_t split_stride; float scale0;
    __device__ __forceinline__ void operator()(const f32x4 (&acc)[2][2][4][2], const Unit& u, int wr, int wc, int fr, int fq) const {
        const int row0 = u.pm * BM + wr * 64 + fr; int colt = u.pn * BM; bf16_t* base = O;
        float sc = 1.f; if (split_cols) { const int t = colt / split_cols; base += (size_t)t * split_stride; colt -= t * split_cols; if (t == 0) sc = scale0; }
        const int col0 = colt + wc * 32 + 8 * fq, bcol0 = u.pn * BM + wc * 32 + 8 * fq;
        f32x4 bv[2][2];
#pragma unroll
        for (int bj = 0; bj < 2; ++bj)
#pragma unroll
            for (int n = 0; n < 2; ++n) bv[bj][n] = bias ? *(const f32x4*)(bias + bcol0 + bj * HALF + 4 * n) : (f32x4){0.f, 0.f, 0.f, 0.f};
#pragma unroll
        for (int ai = 0; ai < 2; ++ai)
#pragma unroll
            for (int m = 0; m < 4; ++m) { bf16_t* rowp = base + (size_t)(row0 + ai * HALF + m * 16) * ldc + col0;
#pragma unroll
                for (int bj = 0; bj < 2; ++bj) { f32x4 v0 = acc[ai][bj][m][0] + bv[bj][0], v1 = acc[ai][bj][m][1] + bv[bj][1];
                    if (ACT == 1) { f32x2 a = gelu_pk((f32x2){v0[0], v0[1]}), b = gelu_pk((f32x2){v0[2], v0[3]}), c = gelu_pk((f32x2){v1[0], v1[1]}), d = gelu_pk((f32x2){v1[2], v1[3]});
                        v0 = (f32x4){a.x, a.y, b.x, b.y}; v1 = (f32x4){c.x, c.y, d.x, d.y}; }
                    v0 = v0 * sc; v1 = v1 * sc; u32x4 w; w.x = cvt_pk_bf16(v0[0], v0[1]); w.y = cvt_pk_bf16(v0[2], v0[3]); w.z = cvt_pk_bf16(v1[0], v1[1]); w.w = cvt_pk_bf16(v1[2], v1[3]);
                    *(u32x4*)(rowp + bj * HALF) = w; } }
    }
};

template <class Epi, class Sched, bool ALIGN_EPI = false, bool SP2 = false>
__device__ __forceinline__ void gemm_phase(PG8_LAS unsigned char* lds, const Gemm g, const Sched& S, const Epi& E) {
    const int tid = threadIdx.x, wid = __builtin_amdgcn_readfirstlane(tid >> 6), lane = tid & 63, wr = wid >> 2, wc = wid & 3, fr = lane & 15, fq = lane >> 4;
    const int K = g.K, nt = K / BK;
    unsigned voffA[2], voffB[2];
#pragma unroll
    for (int i = 0; i < 2; ++i) { int R, C; stage_rc(tid * 16 + i * 8192, R, C); const int Rb = Epi::PERM ? ((R & ~31) + perm32(R & 31)) : R;
        voffA[i] = (unsigned)(R * g.lda + C) * 2u; voffB[i] = (unsigned)(Rb * g.ldb + C) * 2u; }
    const size_t kstep = (size_t)(BK * 2);
    const size_t hstepA = (size_t)HALF * g.lda * 2, hstepB = (size_t)HALF * g.ldb * 2;
    const size_t tstepA = 2 * hstepA, tstepB = 2 * hstepB;
    const unsigned ldsw = (unsigned)wid * 1024u;
    const int aoff = lds_byte(wr * 64 + fr, fq * 8), boff = lds_byte(wc * 32 + fr, fq * 8);
#define PG8_SA(b, h) (((b) * 2 + (h)) * HTB)
#define PG8_SB(b, h) ((4 + (b) * 2 + (h)) * HTB)
#define PG8_STAGE(bufoff, gbase, voff) do { _Pragma("unroll") for (int _i = 0; _i < 2; ++_i) \
        __builtin_amdgcn_global_load_lds((const unsigned*)((const char*)(gbase) + (voff)[_i]), (PG8_LAS unsigned*)(lds + (bufoff) + ldsw + _i * 8192), 16, 0, 0); } while (0)
#define PG8_LDA(dst, b, h) do { _Pragma("unroll") for (int m = 0; m < 4; ++m) _Pragma("unroll") for (int k = 0; k < 2; ++k) dst[m][k] = *(const PG8_LAS bf16x8*)(lds + PG8_SA(b, h) + aoff + m * 2048 + k * 1024); } while (0)
#define PG8_LDB(dst, b, h) do { _Pragma("unroll") for (int n = 0; n < 2; ++n) _Pragma("unroll") for (int k = 0; k < 2; ++k) dst[n][k] = *(const PG8_LAS bf16x8*)(lds + PG8_SB(b, h) + boff + n * 2048 + k * 1024); } while (0)
#define PG8_MMA(ai, bj, At, Bt) do { __builtin_amdgcn_s_setprio(1); _Pragma("unroll") for (int m = 0; m < 4; ++m) _Pragma("unroll") for (int n = 0; n < 2; ++n) _Pragma("unroll") for (int k = 0; k < 2; ++k) \
        acc[ai][bj][m][n] = __builtin_amdgcn_mfma_f32_16x16x32_bf16(Bt[n][k], At[m][k], acc[ai][bj][m][n], 0, 0, 0); __builtin_amdgcn_s_setprio(0); } while (0)
#define PG8_WAIT_V(n) asm volatile("s_waitcnt vmcnt(" #n ")" ::: "memory")
#define PG8_WAIT_L(n) asm volatile("s_waitcnt lgkmcnt(" #n ")" ::: "memory")
#define PG8_BAR __builtin_amdgcn_s_barrier()
#define PG8_SCHED __builtin_amdgcn_sched_barrier(0)
    Unit cur, nxt; int ui = 0;
    if (!S.next(0, cur)) return;
    f32x4 acc[2][2][4][2];
#pragma unroll
    for (int a = 0; a < 2; ++a)
#pragma unroll
        for (int b = 0; b < 2; ++b)
#pragma unroll
            for (int m = 0; m < 4; ++m)
#pragma unroll
                for (int n = 0; n < 2; ++n) acc[a][b][m][n] = (f32x4){0.f, 0.f, 0.f, 0.f};
    bf16x8 At[4][2], B0[2][2], B1[2][2];
    const char* cA = (const char*)g.A + (size_t)cur.pm * tstepA + (size_t)cur.aoff * 2; const char* cB = (const char*)g.Bt + (size_t)cur.pn * tstepB + (size_t)cur.boff * 2;
    S.a_ready(cur);
    if constexpr (SP2) {
        PG8_STAGE(PG8_SB(0, 0), cB, voffB); PG8_STAGE(PG8_SB(0, 1), cB + hstepB, voffB); PG8_STAGE(PG8_SA(0, 0), cA, voffA); PG8_STAGE(PG8_SA(0, 1), cA + hstepA, voffA);
        if (wr == 1) PG8_BAR;
        PG8_WAIT_V(2); PG8_BAR;
        PG8_STAGE(PG8_SB(1, 0), cB + kstep, voffB); PG8_STAGE(PG8_SA(1, 0), cA + kstep, voffA); PG8_STAGE(PG8_SB(1, 1), cB + hstepB + kstep, voffB);
        PG8_WAIT_V(6); PG8_BAR;
    } else {
        PG8_STAGE(PG8_SB(0, 0), cB, voffB); PG8_STAGE(PG8_SA(0, 0), cA, voffA); PG8_STAGE(PG8_SB(0, 1), cB + hstepB, voffB); PG8_STAGE(PG8_SA(0, 1), cA + hstepA, voffA);
        if (wr == 1) PG8_BAR;
        PG8_WAIT_V(4); PG8_BAR;
        PG8_STAGE(PG8_SB(1, 0), cB + kstep, voffB); PG8_STAGE(PG8_SA(1, 0), cA + kstep, voffA); PG8_STAGE(PG8_SB(1, 1), cB + hstepB + kstep, voffB);
        PG8_WAIT_V(6); PG8_BAR;
    }
    for (;;) {
        const bool has_next = S.next(ui + 1, nxt);
        const char* nA = has_next ? (const char*)g.A + (size_t)nxt.pm * tstepA + (size_t)nxt.aoff * 2 : cA; const char* nB = has_next ? (const char*)g.Bt + (size_t)nxt.pn * tstepB + (size_t)nxt.boff * 2 : cB;
        for (int t = 0; t < nt; t += 2) {
            const bool last = (t == nt - 2);
            const char* a1 = cA + (size_t)(t + 1) * kstep;
            const char* a2 = last ? nA : cA + (size_t)(t + 2) * kstep; const char* b2 = last ? nB : cB + (size_t)(t + 2) * kstep;
            const char* a3 = a2 + kstep; const char* b3 = b2 + kstep;
            if (last && has_next) S.a_ready(nxt);
            if constexpr (SP2) {
            PG8_LDB(B0, 0, 0); PG8_LDB(B1, 0, 1); PG8_SCHED; PG8_LDA(At, 0, 0); PG8_STAGE(PG8_SA(1, 1), a1 + hstepA, voffA);
            PG8_WAIT_V(8); PG8_WAIT_L(0); PG8_BAR; PG8_MMA(0, 0, At, B0); PG8_MMA(0, 1, At, B1); PG8_BAR; PG8_SCHED;
            PG8_LDA(At, 0, 1); PG8_STAGE(PG8_SB(0, 0), b2, voffB); PG8_STAGE(PG8_SB(0, 1), b2 + hstepB, voffB); PG8_STAGE(PG8_SA(0, 0), a2, voffA);
            PG8_WAIT_V(8); PG8_WAIT_L(0); PG8_BAR; PG8_MMA(1, 0, At, B0); PG8_MMA(1, 1, At, B1); PG8_BAR; PG8_SCHED;
            PG8_LDB(B0, 1, 0); PG8_LDB(B1, 1, 1); PG8_SCHED; PG8_LDA(At, 1, 0); PG8_STAGE(PG8_SA(0, 1), a2 + hstepA, voffA);
            PG8_WAIT_V(8); PG8_WAIT_L(0); PG8_BAR; PG8_MMA(0, 0, At, B0); PG8_MMA(0, 1, At, B1); PG8_BAR; PG8_SCHED;
            PG8_LDA(At, 1, 1); PG8_STAGE(PG8_SB(1, 0), b3, voffB); PG8_STAGE(PG8_SB(1, 1), b3 + hstepB, voffB); PG8_STAGE(PG8_SA(1, 0), a3, voffA);
            PG8_WAIT_V(8); PG8_WAIT_L(0); PG8_BAR; PG8_MMA(1, 0, At, B0); PG8_MMA(1, 1, At, B1); PG8_BAR; PG8_SCHED;
            } else {
            PG8_LDB(B0, 0, 0); PG8_SCHED; PG8_LDA(At, 0, 0); PG8_STAGE(PG8_SA(1, 1), a1 + hstepA, voffA);
            PG8_WAIT_L(8); PG8_BAR; PG8_WAIT_L(0); PG8_MMA(0, 0, At, B0); PG8_BAR; PG8_SCHED;
            PG8_LDB(B1, 0, 1); PG8_STAGE(PG8_SB(0, 0), b2, voffB);
            PG8_BAR; PG8_WAIT_L(0); PG8_MMA(0, 1, At, B1); PG8_BAR;
            PG8_LDA(At, 0, 1); PG8_STAGE(PG8_SA(0, 0), a2, voffA);
            PG8_BAR; PG8_WAIT_L(0); PG8_MMA(1, 0, At, B0); PG8_BAR; PG8_SCHED;
            PG8_STAGE(PG8_SB(0, 1), b2 + hstepB, voffB);
            PG8_WAIT_V(6); PG8_BAR; PG8_MMA(1, 1, At, B1); PG8_BAR;
            PG8_LDB(B0, 1, 0); PG8_SCHED; PG8_LDA(At, 1, 0); PG8_STAGE(PG8_SA(0, 1), a2 + hstepA, voffA);
            PG8_WAIT_L(8); PG8_BAR; PG8_WAIT_L(0); PG8_MMA(0, 0, At, B0); PG8_BAR; PG8_SCHED;
            PG8_LDB(B1, 1, 1); PG8_STAGE(PG8_SB(1, 0), b3, voffB);
            PG8_BAR; PG8_WAIT_L(0); PG8_MMA(0, 1, At, B1); PG8_BAR;
            PG8_LDA(At, 1, 1); PG8_STAGE(PG8_SA(1, 0), a3, voffA);
            PG8_BAR; PG8_WAIT_L(0); PG8_MMA(1, 0, At, B0); PG8_BAR; PG8_SCHED;
            PG8_STAGE(PG8_SB(1, 1), b3 + hstepB, voffB);
            PG8_WAIT_V(6); PG8_BAR; PG8_MMA(1, 1, At, B1); PG8_BAR;
            }
        }
        if constexpr (ALIGN_EPI) { if (wr == 0) PG8_BAR; }
        if constexpr (!Epi::AFTER_DRAIN) { E(acc, cur, wr, wc, fr, fq); S.done(cur); }
        if (!has_next) break;
#pragma unroll
        for (int a = 0; a < 2; ++a)
#pragma unroll
            for (int b = 0; b < 2; ++b)
#pragma unroll
                for (int m = 0; m < 4; ++m)
#pragma unroll
                    for (int n = 0; n < 2; ++n) acc[a][b][m][n] = (f32x4){0.f, 0.f, 0.f, 0.f};
        cur = nxt; cA = nA; cB = nB; ++ui;
        if constexpr (ALIGN_EPI) { if (wr == 1) PG8_BAR; }
    }
    PG8_WAIT_V(0);
    if constexpr (!ALIGN_EPI) { if (wr == 0) PG8_BAR; }
    PG8_BAR;
    if constexpr (Epi::AFTER_DRAIN) { E.fused(acc, cur, wr, wc, fr, fq, lds, wid, lane); S.done(cur); }
#undef PG8_SA
#undef PG8_SB
#undef PG8_STAGE
#undef PG8_LDA
#undef PG8_LDB
#undef PG8_MMA
#undef PG8_WAIT_V
#undef PG8_WAIT_L
#undef PG8_BAR
#undef PG8_SCHED
}
}
namespace pg8 {
__device__ __forceinline__ float fsigmoid(float x) { return __builtin_amdgcn_rcpf(1.0f + __builtin_amdgcn_exp2f(-1.4426950408889634f * x)); }
__device__ __forceinline__ float gelu_tanh(float x) { const float y = 1.5957691216057308f * (x + 0.044715f * x * x * x); return x * fsigmoid(y); }
__device__ __forceinline__ float bf_lo(unsigned w) { return __uint_as_float(w << 16); }
__device__ __forceinline__ float bf_hi(unsigned w) { return __uint_as_float(w & 0xffff0000u); }
__device__ __forceinline__ u32x4 pack8(const f32x4 v0, const f32x4 v1) { u32x4 w; w.x = cvt_pk_bf16(v0[0], v0[1]); w.y = cvt_pk_bf16(v0[2], v0[3]); w.z = cvt_pk_bf16(v1[0], v1[1]); w.w = cvt_pk_bf16(v1[2], v1[3]); return w; }
__device__ __forceinline__ void unpack8(const u32x4 w, f32x4& v0, f32x4& v1) { v0 = (f32x4){bf_lo(w.x), bf_hi(w.x), bf_lo(w.y), bf_hi(w.y)}; v1 = (f32x4){bf_lo(w.z), bf_hi(w.z), bf_lo(w.w), bf_hi(w.w)}; }

struct EpiInProj {
    static constexpr bool PERM = true, AFTER_DRAIN = false;
    bf16_t* O; const float* gate_b;
    __device__ __forceinline__ void operator()(const f32x4 (&acc)[2][2][4][2], const Unit& u, int wr, int wc, int fr, int fq) const {
        asm volatile("" : "+v"(fr), "+v"(fq));
        const int row0 = u.pm * BM + wr * 64 + fr, col0 = u.pn * BM + wc * 32 + 8 * fq;
        const int mode = u.pn < 4 ? 1 : (u.pn >= 23 ? 2 : 0);
        f32x4 bv[2][2];
#pragma unroll
        for (int bj = 0; bj < 2; ++bj)
#pragma unroll
            for (int n = 0; n < 2; ++n) bv[bj][n] = (mode == 2) ? *(const f32x4*)(gate_b + (col0 - 5888) + bj * HALF + 4 * n) : (f32x4){0.f, 0.f, 0.f, 0.f};
#pragma unroll
        for (int ai = 0; ai < 2; ++ai)
#pragma unroll
            for (int m = 0; m < 4; ++m) { bf16_t* rowp = O + (size_t)(row0 + ai * HALF + m * 16) * 12032 + col0;
#pragma unroll
                for (int bj = 0; bj < 2; ++bj) { f32x4 v0 = acc[ai][bj][m][0] + bv[bj][0], v1 = acc[ai][bj][m][1] + bv[bj][1];
                    if (mode == 1) {
#pragma unroll
                        for (int e = 0; e < 4; ++e) { v0[e] = gelu_tanh(v0[e]); v1[e] = gelu_tanh(v1[e]); } }
                    else if (mode == 2) {
#pragma unroll
                        for (int e = 0; e < 4; ++e) { v0[e] = fsigmoid(v0[e]); v1[e] = fsigmoid(v1[e]); } }
                    *(u32x4*)(rowp + bj * HALF) = pack8(v0, v1); } }
    }
};

struct EpiLora {
    static constexpr bool PERM = true, AFTER_DRAIN = false;
    bf16_t* PROJ; const bf16_t* KK; const bf16_t* RSK; bf16_t* G; const float* w0; const float* a0; const float* ka;
    __device__ __forceinline__ void operator()(const f32x4 (&acc)[2][2][4][2], const Unit& u, int wr, int wc, int fr, int fq) const {
        asm volatile("" : "+v"(fr), "+v"(fq));
        const int row0 = u.pm * BM + wr * 64 + fr, ch0 = (u.pn & 1) * BM + wc * 32 + 8 * fq, kind = u.pn >> 1;
        if (kind == 0) {
#pragma unroll
            for (int bj = 0; bj < 2; ++bj) { const int ch = ch0 + bj * HALF; const f32x4 b0 = *(const f32x4*)(w0 + ch), b1 = *(const f32x4*)(w0 + ch + 4);
#pragma unroll
                for (int ai = 0; ai < 2; ++ai)
#pragma unroll
                    for (int m = 0; m < 4; ++m) { const size_t row = (size_t)(row0 + ai * HALF + m * 16);
                        f32x4 v0 = acc[ai][bj][m][0] + b0, v1 = acc[ai][bj][m][1] + b1;
#pragma unroll
                        for (int e = 0; e < 4; ++e) { v0[e] = -0.6065306597126334f * fsigmoid(v0[e]); v1[e] = -0.6065306597126334f * fsigmoid(v1[e]); }
                        *(u32x4*)(PROJ + row * 12032 + 3840 + ch) = pack8(v0, v1); } }
        } else if (kind == 1) {
            f32x4 b0[2], b1[2], c0[2], c1[2];
#pragma unroll
            for (int bj = 0; bj < 2; ++bj) { const int ch = ch0 + bj * HALF; b0[bj] = *(const f32x4*)(a0 + ch); b1[bj] = *(const f32x4*)(a0 + ch + 4); c0[bj] = *(const f32x4*)(ka + ch); c1[bj] = *(const f32x4*)(ka + ch + 4); }
#pragma unroll
            for (int ai = 0; ai < 2; ++ai)
#pragma unroll
                for (int m = 0; m < 4; ++m) { size_t row = (size_t)(row0 + ai * HALF + m * 16); asm volatile("" : "+v"(row));
                    const bf16_t* kr = RSK + row * 512 + ch0; const bf16_t* qr = KK + row * 512 + ch0; bf16_t* pr = PROJ + row * 12032 + ch0;
#pragma unroll
                    for (int bj = 0; bj < 2; ++bj) {
                        const u32x4 kw = *(const u32x4*)(kr + bj * HALF), qw = *(const u32x4*)(qr + bj * HALF);
                        f32x4 k0, k1, q0, q1; unpack8(kw, k0, k1); unpack8(qw, q0, q1);
                        f32x4 p0, p1;
#pragma unroll
                        for (int e = 0; e < 4; ++e) { const float a_0 = fsigmoid(acc[ai][bj][m][0][e] + b0[bj][e]), a_1 = fsigmoid(acc[ai][bj][m][1][e] + b1[bj][e]);
                            p0[e] = k0[e] * (1.0f + (a_0 - 1.0f) * c0[bj][e]); p1[e] = k1[e] * (1.0f + (a_1 - 1.0f) * c1[bj][e]); q0[e] *= a_0; q1[e] *= a_1; }
                        *(u32x4*)(pr + 4352 + bj * HALF) = pack8(q0, q1);
                        *(u32x4*)(pr + 4864 + bj * HALF) = pack8(p0, p1); }
                    asm volatile("" ::: "memory"); }
        } else {
#pragma unroll
            for (int bj = 0; bj < 2; ++bj) { const int ch = ch0 + bj * HALF;
#pragma unroll
                for (int ai = 0; ai < 2; ++ai)
#pragma unroll
                    for (int m = 0; m < 4; ++m) { const size_t row = (size_t)(row0 + ai * HALF + m * 16); *(u32x4*)(G + row * 512 + ch) = pack8(acc[ai][bj][m][0], acc[ai][bj][m][1]); } }
        }
    }
};

struct EpiMerge {
    static constexpr bool PERM = true, AFTER_DRAIN = false;
    const bf16_t* PROJ; bf16_t* MG;
    __device__ __forceinline__ void operator()(const f32x4 (&acc)[2][2][4][2], const Unit& u, int wr, int wc, int fr, int fq) const {
        asm volatile("" : "+v"(fr), "+v"(fq));
        const int row0 = u.pm * BM + wr * 64 + fr, col0 = u.pn * BM + wc * 32 + 8 * fq, ks = u.boff >> 9, gi = ks > 2 ? 2 : ks;
#pragma unroll
        for (int ai = 0; ai < 2; ++ai)
#pragma unroll
            for (int m = 0; m < 4; ++m) { const size_t row = (size_t)(row0 + ai * HALF + m * 16);
#pragma unroll
                for (int bj = 0; bj < 2; ++bj) { const int col = col0 + bj * HALF;
                    f32x4 g0, g1, p0 = (f32x4){0.f, 0.f, 0.f, 0.f}, p1 = p0;
                    unpack8(*(const u32x4*)(PROJ + row * 12032 + 5888 + gi * 2048 + col), g0, g1);
                    if (ks != 0) unpack8(*(const u32x4*)(MG + row * 2048 + col), p0, p1);
                    p0 = p0 + g0 * acc[ai][bj][m][0]; p1 = p1 + g1 * acc[ai][bj][m][1];
                    *(u32x4*)(MG + row * 2048 + col) = pack8(p0, p1); } }
    }
};

struct EpiResid {
    static constexpr bool PERM = false, AFTER_DRAIN = false;
    const float* hin; float* out;
    __device__ __forceinline__ void operator()(const f32x4 (&acc)[2][2][4][2], const Unit& u, int wr, int wc, int fr, int fq) const {
        asm volatile("" : "+v"(fr), "+v"(fq));
        const int row0 = u.pm * BM + wr * 64 + fr, col0 = u.pn * BM + wc * 32 + 4 * fq;
#pragma unroll
        for (int ai = 0; ai < 2; ++ai)
#pragma unroll
            for (int m = 0; m < 4; ++m) { const size_t off = (size_t)(row0 + ai * HALF + m * 16) * 2048 + col0;
#pragma unroll
                for (int bj = 0; bj < 2; ++bj)
#pragma unroll
                    for (int n = 0; n < 2; ++n) { const f32x4 bs = *(const f32x4*)(hin + off + bj * HALF + n * 16); *(f32x4*)(out + off + bj * HALF + n * 16) = bs + acc[ai][bj][m][n]; } }
    }
};

struct EpiSwiGLU {
    static constexpr bool PERM = true, AFTER_DRAIN = false;
    bf16_t* O; int ldc, nt;
    __device__ __forceinline__ void operator()(const f32x4 (&acc)[2][2][4][2], const Unit& u, int wr, int wc, int fr, int fq) const {
        asm volatile("" : "+v"(fr), "+v"(fq));
        const int row0 = u.pm * BM + wr * 64 + fr, col0 = (u.pn % nt) * HALF + wc * 32 + 8 * fq;
#pragma unroll
        for (int ai = 0; ai < 2; ++ai)
#pragma unroll
            for (int m = 0; m < 4; ++m) { bf16_t* rowp = O + (size_t)(row0 + ai * HALF + m * 16) * ldc + col0;
                f32x4 v0, v1;
#pragma unroll
                for (int e = 0; e < 4; ++e) { const float a_0 = acc[ai][0][m][0][e], a_1 = acc[ai][0][m][1][e];
                    v0[e] = a_0 * fsigmoid(a_0) * acc[ai][1][m][0][e]; v1[e] = a_1 * fsigmoid(a_1) * acc[ai][1][m][1][e]; }
                *(u32x4*)rowp = pack8(v0, v1); }
    }
};

struct EpiPlain {
    static constexpr bool PERM = true, AFTER_DRAIN = false;
    bf16_t* O; int ldc, nt;
    __device__ __forceinline__ void operator()(const f32x4 (&acc)[2][2][4][2], const Unit& u, int wr, int wc, int fr, int fq) const {
        asm volatile("" : "+v"(fr), "+v"(fq));
        const int row0 = u.pm * BM + wr * 64 + fr, col0 = (u.pn % nt) * BM + wc * 32 + 8 * fq;
#pragma unroll
        for (int ai = 0; ai < 2; ++ai)
#pragma unroll
            for (int m = 0; m < 4; ++m) { bf16_t* rowp = O + (size_t)(row0 + ai * HALF + m * 16) * ldc + col0;
#pragma unroll
                for (int bj = 0; bj < 2; ++bj) *(u32x4*)(rowp + bj * HALF) = pack8(acc[ai][bj][m][0], acc[ai][bj][m][1]); }
    }
};

struct MergeOrder {
    StaticOrder so;
    __device__ __forceinline__ bool next(int i, Unit& u) const {
        if (!so.next(i >> 2, u)) return false;
        const int ks = i & 3; u.boff = ks * 512; u.aoff = ks == 0 ? 0 : (ks == 1 ? 1024 : (ks == 2 ? 2816 : 3328)); return true;
    }
    __device__ __forceinline__ void a_ready(const Unit&) const {}
    __device__ __forceinline__ void done(const Unit&) const {}
};

struct MoeOrder {
    int ts[8]; int nrt, nt, G, c;
    __device__ __forceinline__ bool next(int i, Unit& u) const {
        const long L = (long)i * G + c; if (L >= (long)nrt * nt) return false;
        const int rt = (int)(L / nt), pnl = (int)(L % nt); int e = 0;
#pragma unroll
        for (int j = 1; j < 8; ++j) e += (rt >= ts[j]) ? 1 : 0;
        u.pm = rt; u.pn = e * nt + pnl; u.aoff = 0; u.boff = 0; return true;
    }
    __device__ __forceinline__ void a_ready(const Unit&) const {}
    __device__ __forceinline__ void done(const Unit&) const {}
};
}

#ifndef PG8_SP2
#define PG8_SP2 true
#endif
#ifndef PG8_ALIGN
#define PG8_ALIGN true
#endif
constexpr int NWAVES = 8;
constexpr int BATCH = 8, SEQ = 2048, DM = 2048, M = BATCH * SEQ;
constexpr int NIN = 12032, GM_OFF = 0, RW_OFF = 1024, SB_OFF = 2816, GATE_OFF = 5888;
constexpr int C_LW = 3840, C_KKA = 4352, C_KP = 4864;
constexpr int YRAW_BYTE = 3072;
constexpr int DFF = 5632, DFE = 2816, NEXP = 8;
constexpr int XG_ROWS = 2 * M + NEXP * 256;
constexpr int N_PHASES = 24;
constexpr size_t MiB = 1u << 20;
constexpr size_t WS_CTL = 0, WS_LORA = 1 * MiB, ZERO_BYTES = 3 * MiB;
constexpr size_t WS_TAB = 3 * MiB, WS_GMW = 4 * MiB;
constexpr size_t WS_WIN = 5 * MiB, WS_PC = 99 * MiB, WS_WO = 115 * MiB, WS_W13 = 131 * MiB, WS_W2 = 175 * MiB, WS_W13E = 197 * MiB, WS_W2E = 373 * MiB;
constexpr size_t WS_XN = 461 * MiB, WS_PROJ = 525 * MiB, WS_RWT = 901 * MiB, WS_END = 989 * MiB;
constexpr size_t WS_H = WS_PROJ;
constexpr size_t WS_XG = 525 * MiB, WS_HX = 661 * MiB, WS_Y2 = 848 * MiB;
static_assert(WS_Y2 + (size_t)XG_ROWS * DM * 2 <= WS_END && WS_HX + (size_t)XG_ROWS * DFE * 2 <= WS_Y2 && WS_XG + (size_t)XG_ROWS * DM * 2 <= WS_HX, "moe overlay");
static_assert(WS_PROJ + (size_t)M * NIN * 2 <= WS_RWT && WS_H + (size_t)M * DFF * 2 <= WS_RWT && WS_RWT + (size_t)M * (5 * 512 + 256) * 2 <= WS_END, "ws map");
constexpr size_t RWT_R = 0, RWT_K = (size_t)M * 512, RWT_V = 2 * (size_t)M * 512, RWT_KK = 3 * (size_t)M * 512, RWT_G = 4 * (size_t)M * 512, RWT_LA = 5 * (size_t)M * 512;
constexpr int CW_BAR = 4096, CW_CNT = 1024;
constexpr int LDS_BYTES = 147456, LDSCTL_OFF = LDS_BYTES - 1024;

#define GAS __attribute__((address_space(1)))
#define LAS __attribute__((address_space(3)))
typedef unsigned short bf16;
typedef unsigned v4u __attribute__((ext_vector_type(4)));
typedef unsigned v2u __attribute__((ext_vector_type(2)));
typedef float f32x4 __attribute__((ext_vector_type(4)));
typedef float f32x16 __attribute__((ext_vector_type(16)));
typedef short bf16x8 __attribute__((ext_vector_type(8)));
typedef GAS unsigned gu32;
#define RLX_AGENT __ATOMIC_RELAXED, __HIP_MEMORY_SCOPE_AGENT
#define LDS_WAIT() asm volatile("s_waitcnt lgkmcnt(0)" ::: "memory")
#define VM_WAIT() asm volatile("s_waitcnt vmcnt(0)" ::: "memory")
__device__ __forceinline__ unsigned f2bf(float f) { unsigned u = __builtin_bit_cast(unsigned, f); return (u + 0x7fffu + ((u >> 16) & 1u)) >> 16; }
__device__ __forceinline__ unsigned pk2(float lo, float hi) { return f2bf(lo) | (f2bf(hi) << 16); }
__device__ __forceinline__ float bfl(unsigned w) { return __uint_as_float(w << 16); }
__device__ __forceinline__ float bfh(unsigned w) { return __uint_as_float(w & 0xffff0000u); }
__device__ __forceinline__ float bf1(bf16 h) { return __uint_as_float((unsigned)h << 16); }
__device__ __forceinline__ float fsig(float x) { return __builtin_amdgcn_rcpf(1.0f + __builtin_amdgcn_exp2f(-1.4426950408889634f * x)); }
__device__ __forceinline__ void unpk8(const v4u w, float (&v)[8]) { v[0] = bfl(w.x); v[1] = bfh(w.x); v[2] = bfl(w.y); v[3] = bfh(w.y); v[4] = bfl(w.z); v[5] = bfh(w.z); v[6] = bfl(w.w); v[7] = bfh(w.w); }
__device__ __forceinline__ v4u pk8(const float (&v)[8]) { v4u w; w.x = pk2(v[0], v[1]); w.y = pk2(v[2], v[3]); w.z = pk2(v[4], v[5]); w.w = pk2(v[6], v[7]); return w; }

#define XB_TMO      128
#define XB_XCNT(j)  (256  + 64 * (j))
#define XB_XSUB(j)  (1280 + 64 * (j))
#define XB_XGEN(j)  (2304 + 64 * (j))
#define XB_TOP      3328
#define XB_TOPGEN   3392
#define XCD_BAR_WORDS 3456
#define XB_SPIN_CAP (1u << 18)
__device__ __forceinline__ unsigned xb_ld(unsigned* p)              { return __hip_atomic_load(p, __ATOMIC_RELAXED, __HIP_MEMORY_SCOPE_AGENT); }
__device__ __forceinline__ unsigned xb_add(unsigned* p, unsigned v) { return __hip_atomic_fetch_add(p, v, __ATOMIC_RELAXED, __HIP_MEMORY_SCOPE_AGENT); }
__device__ __forceinline__ unsigned xb_xcc_id() { return (unsigned)__builtin_amdgcn_s_getreg((3 << 11) | 20) & 0xFu; }
#define XB_SPIN(cond, bar) do { unsigned _sp = 0; while (cond) { __builtin_amdgcn_s_sleep(1); \
    if ((++_sp & 255u) == 0u) { if (xb_ld(&(bar)[XB_TMO])) break; if (_sp > XB_SPIN_CAP) { atomicAdd(&(bar)[XB_TMO], 1u); break; } } } } while (0)
struct XcdBarrier { unsigned* bar; unsigned x; volatile LAS unsigned* st; };
__device__ __forceinline__ XcdBarrier xcd_barrier_post(unsigned* bar, volatile LAS unsigned* st) {
    XcdBarrier b; b.bar = bar; b.x = xb_xcc_id(); b.st = st;
    if (threadIdx.x == 0) (void)xb_add(&bar[XB_XCNT(b.x)], 1u);
    return b;
}
__device__ __forceinline__ void xcd_barrier_complete(unsigned* bar, unsigned x, unsigned& nloc, unsigned& nx) {
    const unsigned G = gridDim.x * gridDim.y * gridDim.z;
    unsigned sum, cnt, mine, sp = 0u;
    for (;;) {
        sum = 0u; cnt = 0u; mine = 0u;
#pragma unroll
        for (unsigned j = 0; j < 16; ++j) { const unsigned c = xb_ld(&bar[XB_XCNT(j)]); sum += c; cnt += (c > 0u) ? 1u : 0u; mine = (j == x) ? c : mine; }
        if (sum == G) break;
        __builtin_amdgcn_s_sleep(1);
        if ((++sp & 255u) == 0u) { if (xb_ld(&bar[XB_TMO])) break; if (sp > XB_SPIN_CAP) { atomicAdd(&bar[XB_TMO], 1u); break; } }
    }
    nloc = mine > 0u ? mine : 1u; nx = cnt > 0u ? cnt : 1u;
}
__device__ __forceinline__ void xcd_barrier(const XcdBarrier& b) {
    asm volatile("s_waitcnt vmcnt(0)" ::: "memory");
    __syncthreads();
    if (threadIdx.x == 0) {
        unsigned* bar = b.bar;
        __builtin_amdgcn_s_waitcnt(0);
        unsigned nloc = b.st[0], nx = b.st[1];
        if (nloc == 0u) { xcd_barrier_complete(bar, b.x, nloc, nx); b.st[0] = nloc; b.st[1] = nx; }
        const unsigned old = xb_add(&bar[XB_XSUB(b.x)], 1u);
        const unsigned gen = old / nloc;
        if (old + 1u == (gen + 1u) * nloc) {
            __builtin_amdgcn_fence(__ATOMIC_RELEASE, "agent");
            asm volatile("s_waitcnt vmcnt(0)" ::: "memory");
            const unsigned og = xb_add(&bar[XB_TOP], 1u);
            const unsigned tg = og / nx;
            if (og + 1u == (tg + 1u) * nx) xb_add(&bar[XB_TOPGEN], 1u);
            else XB_SPIN(xb_ld(&bar[XB_TOPGEN]) == tg, bar);
            __builtin_amdgcn_fence(__ATOMIC_ACQUIRE, "agent");
            xb_add(&bar[XB_XGEN(b.x)], 1u);
            asm volatile("s_waitcnt vmcnt(0)" ::: "memory");
        } else {
            XB_SPIN(xb_ld(&bar[XB_XGEN(b.x)]) == gen, bar);
            __builtin_amdgcn_fence(__ATOMIC_ACQUIRE, "agent");
            asm volatile("s_waitcnt vmcnt(0)" ::: "memory");
        }
    }
    __syncthreads();
}

struct Frame {
    LAS unsigned char* lds;
    unsigned char* ws;
    const float* const* in;
    int tid, lane, wave, G, gw, ngw;
};
__device__ __forceinline__ float wave_sum(float v) {
#pragma unroll
    for (int o = 1; o < 64; o <<= 1) v += __shfl_xor(v, o);
    return v;
}
__device__ __forceinline__ float sum8(float v) { v += __shfl_xor(v, 1); v += __shfl_xor(v, 2); v += __shfl_xor(v, 4); return v; }

__device__ __forceinline__ void tr_item(const float* W, int N, bf16* WT, int ldo, int koff, int rowbase, int mode, float sc, LAS float* scr, int k0, int n0, int lane) {
    const int lq = lane & 15, lr = lane >> 4;
#pragma unroll 4
    for (int i = 0; i < 16; ++i) { const int kk = 4 * i + lr; const f32x4 v = *(const GAS f32x4*)(W + (size_t)(k0 + kk) * N + n0 + 4 * lq);
        LAS float* s = scr + kk * 65 + 4 * lq; s[0] = v.x * sc; s[1] = v.y * sc; s[2] = v.z * sc; s[3] = v.w * sc; }
    LDS_WAIT(); asm volatile("" ::: "memory");
    const int c = lane & 7, ns = lane >> 3;
#pragma unroll
    for (int j = 0; j < 8; ++j) { const int n = n0 + ns + 8 * j; const int row = rowbase + (mode ? ((n >> 7) * 256 + (n & 127) + (mode == 2 ? 128 : 0)) : n);
        const LAS float* s = scr + (8 * c) * 65 + ns + 8 * j;
        v4u o; o.x = pk2(s[0 * 65], s[1 * 65]); o.y = pk2(s[2 * 65], s[3 * 65]); o.z = pk2(s[4 * 65], s[5 * 65]); o.w = pk2(s[6 * 65], s[7 * 65]);
        *(GAS v4u*)(WT + (size_t)row * ldo + koff + k0 + 8 * c) = o; }
    LDS_WAIT(); asm volatile("" ::: "memory");
}

__device__ __forceinline__ void rms_row_to_bf16(const float* xrow, const float* gain, bf16* orow, int lane) {
    const GAS f32x4* xr = (const GAS f32x4*)xrow + lane; const GAS f32x4* gr = (const GAS f32x4*)gain + lane;
    f32x4 v[8]; float s = 0.f;
#pragma unroll
    for (int j = 0; j < 8; ++j) { v[j] = xr[64 * j]; s += (v[j].x * v[j].x + v[j].y * v[j].y) + (v[j].z * v[j].z + v[j].w * v[j].w); }
    const float rstd = 1.0f / sqrtf(wave_sum(s) * (1.f / DM) + 1e-6f);
    GAS v2u* o8 = (GAS v2u*)orow + lane;
#pragma unroll
    for (int j = 0; j < 8; ++j) { const f32x4 g = gr[64 * j]; v2u o; o.x = pk2(v[j].x * rstd * g.x, v[j].y * rstd * g.y); o.y = pk2(v[j].z * rstd * g.z, v[j].w * rstd * g.w); o8[64 * j] = o; }
}

struct In { const float* p[33]; };
__device__ __forceinline__ void p0_prologue(Frame& F, const In& I) {
    LAS float* scr = (LAS float*)(F.lds + F.wave * 16640);
    unsigned char* ws = F.ws;
    int rot = 0;
    for (int j = 0; j < 43; ++j) {
        const float* W; int Kd, N, ldo, koff = 0, rowbase = 0, mode = 0, slo = 0, shi = 0; bf16* WT;
        if (j < 2)       { const int l = j;      W = I.p[2] + (size_t)l * 2048 * NIN;   Kd = 2048; N = NIN;  WT = (bf16*)(ws + WS_WIN) + (size_t)l * NIN * 2048; ldo = 2048; slo = SB_OFF; shi = SB_OFF + 1024; }
        else if (j < 4)  { const int l = j - 2;  W = I.p[19] + (size_t)l * 512 * 2048;  Kd = 512;  N = 2048; WT = (bf16*)(ws + WS_PC) + (size_t)l * 2048 * 2048;  ldo = 2048; koff = 0; }
        else if (j < 6)  { const int l = j - 4;  W = I.p[20] + (size_t)l * 512 * 2048;  Kd = 512;  N = 2048; WT = (bf16*)(ws + WS_PC) + (size_t)l * 2048 * 2048;  ldo = 2048; koff = 512; }
        else if (j < 8)  { const int l = j - 6;  W = I.p[21] + (size_t)l * 1024 * 2048; Kd = 1024; N = 2048; WT = (bf16*)(ws + WS_PC) + (size_t)l * 2048 * 2048;  ldo = 2048; koff = 1024; }
        else if (j < 10) { const int l = j - 8;  W = I.p[22] + (size_t)l * 2048 * 2048; Kd = 2048; N = 2048; WT = (bf16*)(ws + WS_WO) + (size_t)l * 2048 * 2048;  ldo = 2048; }
        else if (j == 10) { W = I.p[24]; Kd = 2048; N = DFF; WT = (bf16*)(ws + WS_W13); ldo = 2048; mode = 1; }
        else if (j == 11) { W = I.p[25]; Kd = 2048; N = DFF; WT = (bf16*)(ws + WS_W13); ldo = 2048; mode = 2; }
        else if (j == 12) { W = I.p[26]; Kd = DFF; N = 2048; WT = (bf16*)(ws + WS_W2); ldo = DFF; }
        else if (j < 21) { const int e = j - 13; W = I.p[29] + (size_t)e * 2048 * DFE; Kd = 2048; N = DFE; WT = (bf16*)(ws + WS_W13E); ldo = 2048; rowbase = e * 2 * DFE; mode = 1; }
        else if (j < 29) { const int e = j - 21; W = I.p[30] + (size_t)e * 2048 * DFE; Kd = 2048; N = DFE; WT = (bf16*)(ws + WS_W13E); ldo = 2048; rowbase = e * 2 * DFE; mode = 2; }
        else if (j < 37) { const int e = j - 29; W = I.p[31] + (size_t)e * DFE * 2048; Kd = DFE; N = 2048; WT = (bf16*)(ws + WS_W2E); ldo = DFE; rowbase = e * 2048; }
        else if (j < 39) { const int l = j - 37; W = I.p[10] + (size_t)l * 64 * 512;  Kd = 64;  N = 512; WT = (bf16*)(ws + WS_LORA) + (size_t)l * 1536 * 256; ldo = 256; koff = 0;   rowbase = 0; }
        else if (j < 41) { const int l = j - 39; W = I.p[12] + (size_t)l * 64 * 512;  Kd = 64;  N = 512; WT = (bf16*)(ws + WS_LORA) + (size_t)l * 1536 * 256; ldo = 256; koff = 64;  rowbase = 512; }
        else             { const int l = j - 41; W = I.p[13] + (size_t)l * 128 * 512; Kd = 128; N = 512; WT = (bf16*)(ws + WS_LORA) + (size_t)l * 1536 * 256; ldo = 256; koff = 128; rowbase = 1024; }
        const int nnb = N / 64, nitems = (Kd / 64) * nnb;
        int start = F.gw - rot; if (start < 0) start += F.ngw;
        for (int it = start; it < nitems; it += F.ngw) { const int kb = it / nnb, nb = it - kb * nnb, n0 = 64 * nb;
            tr_item(W, N, WT, ldo, koff, rowbase, mode, (n0 >= slo && n0 < shi) ? 0.125f : 1.0f, scr, 64 * kb, n0, F.lane); }
        rot = (rot + nitems) % F.ngw;
    }
    { const float* gw = I.p[6]; bf16* o = (bf16*)(ws + WS_GMW);
      for (int g = blockIdx.x * 512 + F.tid; g < 2 * 8 * 128 * 128 / 8; g += F.G * 512) { const int s0 = (g & 15) * 8, t = (g >> 4) & 127;
          const f32x4 a = *(const GAS f32x4*)(gw + (size_t)g * 8), b = *(const GAS f32x4*)(gw + (size_t)g * 8 + 4);
          float v[8] = {a.x, a.y, a.z, a.w, b.x, b.y, b.z, b.w};
#pragma unroll
          for (int e = 0; e < 8; ++e) if (s0 + e > t) v[e] = 0.f;
          *(GAS v4u*)(o + (size_t)g * 8) = pk8(v); } }
    for (int m = F.gw; m < M; m += F.ngw) rms_row_to_bf16(I.p[0] + (size_t)m * DM, I.p[1], (bf16*)(ws + WS_XN) + (size_t)m * DM, F.lane);
}

__device__ __forceinline__ void rw_elem_row(Frame& F, const In& I, int l, int m) {
    bf16* PROJ = (bf16*)(F.ws + WS_PROJ); bf16* RWT = (bf16*)(F.ws + WS_RWT);
    const bool has_prev = (m % SEQ) != 0;
    const bf16* cur = PROJ + (size_t)m * NIN + RW_OFF; const bf16* prv = cur - NIN;
    const float* mu = I.p[8] + l * 1792; const float* kkw = I.p[14] + l * 512;
#pragma unroll
    for (int i = 0; i < 4; ++i) {
        const int c = F.lane + 64 * i;
        if (c < 224) {
            float x[8], p[8];
            unpk8(*(const GAS v4u*)(cur + 8 * c), x);
            if (has_prev) unpk8(*(const GAS v4u*)(prv + 8 * c), p); else {
#pragma unroll
                for (int e = 0; e < 8; ++e) p[e] = 0.f; }
            const f32x4 m0 = *(const GAS f32x4*)(mu + 8 * c), m1 = *(const GAS f32x4*)(mu + 8 * c + 4);
            const float mm[8] = {m0.x, m0.y, m0.z, m0.w, m1.x, m1.y, m1.z, m1.w};
#pragma unroll
            for (int e = 0; e < 8; ++e) x[e] = x[e] + (p[e] - x[e]) * mm[e];
            if (i == 0) { *(GAS v4u*)(RWT + RWT_R + (size_t)m * 512 + 8 * c) = pk8(x); }
            else if (i == 1) { const int ch = 8 * (c - 64);
                *(GAS v4u*)(RWT + RWT_K + (size_t)m * 512 + ch) = pk8(x);
                const f32x4 k0 = *(const GAS f32x4*)(kkw + ch), k1 = *(const GAS f32x4*)(kkw + ch + 4);
                const float kw[8] = {k0.x, k0.y, k0.z, k0.w, k1.x, k1.y, k1.z, k1.w};
                float q[8], ss = 0.f;
#pragma unroll
                for (int e = 0; e < 8; ++e) { q[e] = x[e] * kw[e]; ss += q[e] * q[e]; }
                ss = sum8(ss);
                const float inv = 1.0f / fmaxf(sqrtf(ss), 1e-12f);
#pragma unroll
                for (int e = 0; e < 8; ++e) q[e] *= inv;
                *(GAS v4u*)(RWT + RWT_KK + (size_t)m * 512 + ch) = pk8(q); }
            else if (i == 2) { *(GAS v4u*)(RWT + RWT_V + (size_t)m * 512 + 8 * (c - 128)) = pk8(x); }
            else { const int cc = c - 192;
#pragma unroll
                for (int e = 0; e < 8; ++e) { if (cc < 8) x[e] = 1.0f - 2.0f * __builtin_amdgcn_rcpf(1.0f + __builtin_amdgcn_exp2f(2.885390081777927f * x[e])); else if (cc >= 16) x[e] = fsig(x[e]); }
                *(GAS v4u*)(RWT + RWT_LA + (size_t)m * 256 + 8 * cc) = pk8(x); }
        }
    }
}
__device__ __forceinline__ void gm_ln_row(Frame& F, const In& I, int l, int m) {
    bf16* vp = (bf16*)(F.ws + WS_PROJ) + (size_t)m * NIN + 512 + 8 * F.lane;
    float x[8]; unpk8(*(const GAS v4u*)vp, x);
    float s = 0.f;
#pragma unroll
    for (int e = 0; e < 8; ++e) s += x[e];
    const float mean = wave_sum(s) * (1.f / 512.f); float q = 0.f;
#pragma unroll
    for (int e = 0; e < 8; ++e) { x[e] -= mean; q += x[e] * x[e]; }
    const float rstd = 1.0f / sqrtf(wave_sum(q) * (1.f / 512.f) + 1e-5f);
    const float* g = I.p[4] + l * 512 + 8 * F.lane; const float* b = I.p[5] + l * 512 + 8 * F.lane;
    const f32x4 g0 = *(const GAS f32x4*)g, g1 = *(const GAS f32x4*)(g + 4), b0 = *(const GAS f32x4*)b, b1 = *(const GAS f32x4*)(b + 4);
    const float gg[8] = {g0.x, g0.y, g0.z, g0.w, g1.x, g1.y, g1.z, g1.w}, bb[8] = {b0.x, b0.y, b0.z, b0.w, b1.x, b1.y, b1.z, b1.w};
#pragma unroll
    for (int e = 0; e < 8; ++e) x[e] = x[e] * rstd * gg[e] + bb[e];
    *(GAS v4u*)vp = pk8(x);
}
#define MFMA32(a, b, c) __builtin_amdgcn_mfma_f32_32x32x16_bf16((a), (b), (c), 0, 0, 0)
__device__ __forceinline__ int crow(int r, int hi) { return (r & 3) + 8 * (r >> 2) + 4 * hi; }
__device__ __forceinline__ void sb_attn_unit(bf16* PROJ, int b, int h, int qt, int lane, int ocol = SB_OFF) {
    const int r32 = lane & 31, hi = lane >> 5;
    const size_t rowb = (size_t)b * SEQ;
    const bf16* Qp = PROJ + (rowb + qt * 32 + r32) * NIN + SB_OFF + h * 64 + hi * 8;
    bf16x8 qf[4];
#pragma unroll
    for (int ds = 0; ds < 4; ++ds) qf[ds] = *(const GAS bf16x8*)(Qp + ds * 16);
    f32x16 o0, o1;
#pragma unroll
    for (int r = 0; r < 16; ++r) { o0[r] = 0.f; o1[r] = 0.f; }
    float R = 0.f;
    const int tq = qt * 32 + r32;
    for (int kt = qt; kt >= 0; --kt) {
        const bf16* Kp = PROJ + (rowb + kt * 32 + r32) * NIN + SB_OFF + 1024 + h * 64 + hi * 8;
        bf16x8 kf[4];
#pragma unroll
        for (int ds = 0; ds < 4; ++ds) kf[ds] = *(const GAS bf16x8*)(Kp + ds * 16);
        const bf16* Vp = PROJ + (rowb + kt * 32) * NIN + SB_OFF + 2048 + h * 64 + r32;
        bf16x8 vf[2][2];
#pragma unroll
        for (int j = 0; j < 2; ++j)
#pragma unroll
            for (int dt = 0; dt < 2; ++dt)
#pragma unroll
                for (int e = 0; e < 8; ++e) vf[j][dt][e] = (short)*(const GAS bf16*)(Vp + (size_t)crow(8 * j + e, hi) * NIN + dt * 32);
        f32x16 st;
#pragma unroll
        for (int r = 0; r < 16; ++r) st[r] = 0.f;
#pragma unroll
        for (int ds = 0; ds < 4; ++ds) st = MFMA32(kf[ds], qf[ds], st);
        float sp[16]; const bool diag = (kt == qt);
#pragma unroll
        for (int r = 0; r < 16; ++r) { const float z = st[r]; const int s = kt * 32 + crow(r, hi);
            float v = (z > 20.f) ? z : 0.6931471805599453f * __builtin_amdgcn_logf(1.0f + __builtin_amdgcn_exp2f(1.4426950408889634f * z));
            if (diag && s >= tq) v = 0.f;
            sp[r] = v; }
        float rs[4], prs[4];
#pragma unroll
        for (int g = 0; g < 4; ++g) { rs[g] = (sp[4 * g] + sp[4 * g + 1]) + (sp[4 * g + 2] + sp[4 * g + 3]); prs[g] = __shfl_xor(rs[g], 32); }
        float carry = R; float att[16];
#pragma unroll
        for (int g = 3; g >= 0; --g) { float c = carry + (hi == 0 ? prs[g] : 0.f);
#pragma unroll
            for (int i = 3; i >= 0; --i) { const int r = 4 * g + i; c += sp[r]; const int s = kt * 32 + crow(r, hi);
                float a = __builtin_amdgcn_exp2f(1.4426950408889634f * (st[r] - c));
                if (diag && s >= tq) a = 0.f;
                att[r] = a; }
            carry += rs[g] + prs[g]; }
        R = carry;
        bf16x8 pa[2];
#pragma unroll
        for (int j = 0; j < 2; ++j) { v4u w; w.x = pk2(att[8 * j], att[8 * j + 1]); w.y = pk2(att[8 * j + 2], att[8 * j + 3]); w.z = pk2(att[8 * j + 4], att[8 * j + 5]); w.w = pk2(att[8 * j + 6], att[8 * j + 7]); pa[j] = __builtin_bit_cast(bf16x8, w); }
#pragma unroll
        for (int j = 0; j < 2; ++j) { o0 = MFMA32(pa[j], vf[j][0], o0); o1 = MFMA32(pa[j], vf[j][1], o1); }
        if (__all(R > 110.f)) break;
    }
    bf16* Op = PROJ + (rowb + qt * 32) * NIN + ocol + h * 64 + r32;
#pragma unroll
    for (int r = 0; r < 16; ++r) { const size_t ro = (size_t)crow(r, hi) * NIN; *(GAS bf16*)(Op + ro) = (bf16)f2bf(o0[r]); *(GAS bf16*)(Op + ro + 32) = (bf16)f2bf(o1[r]); }
}
__device__ __forceinline__ void c1_phase(Frame& F, const In& I, int l) {
    for (int m = F.gw; m < M; m += F.ngw) { rw_elem_row(F, I, l, m); gm_ln_row(F, I, l, m); }
    bf16* PROJ = (bf16*)(F.ws + WS_PROJ);
    for (int u = F.gw; u < BATCH * 16 * 64; u += F.ngw) { const int qt = 63 - (u >> 7), bh = u & 127; sb_attn_unit(PROJ, bh >> 4, bh & 15, qt, F.lane); }
}

__device__ __forceinline__ void attn_dummy_phase(Frame& F) {
    bf16* PROJ = (bf16*)(F.ws + WS_PROJ);
    for (int u = F.gw; u < BATCH * 16 * 64; u += F.ngw) { const int qt = 63 - (u >> 7), bh = u & 127; sb_attn_unit(PROJ, bh >> 4, bh & 15, qt, F.lane, 1536); }
}

template <int CTRL> __device__ __forceinline__ float dppf(float v) { return __builtin_bit_cast(float, __builtin_amdgcn_update_dpp(0, __builtin_bit_cast(int, v), CTRL, 0xf, 0xf, true)); }
__device__ __forceinline__ float rowsum16(float x) { x += dppf<0xB1>(x); x += dppf<0x4E>(x); x += dppf<0x141>(x); x += dppf<0x140>(x); return x; }
__device__ __forceinline__ void scan_phase(Frame& F) {
    typedef float f32x2 __attribute__((ext_vector_type(2)));
    constexpr int TC = 32, NC = SEQ / TC, VEC_B = TC * 5 * 64 * 4, VV_B = TC * 16 * 4, YP_B = TC * 16 * 4 * 4, BUF_B = VEC_B + VV_B + YP_B;
    const bf16* PROJ = (const bf16*)(F.ws + WS_PROJ); const bf16* RWT = (const bf16*)(F.ws + WS_RWT);
    const int lane = F.lane;
    for (int u = blockIdx.x; u < BATCH * 8 * 4; u += F.G) {
        const int rb = u & 3, bh = u >> 2, h = bh & 7, b = bh >> 3;
        const size_t m0 = (size_t)b * SEQ;
        if (F.wave >= 4) {
            const int lw = F.wave - 4, st8 = lane >> 3, ch = h * 64 + 8 * (lane & 7), stv = lane >> 1, chv = h * 64 + rb * 16 + 8 * (lane & 1);
            v4u rg[5], rv = (v4u){0u, 0u, 0u, 0u};
#define SCAN_LOAD(c) do { const size_t mr = m0 + (size_t)(c) * TC + 8 * lw + st8; \
                rg[0] = *(const GAS v4u*)(RWT + RWT_KK + mr * 512 + ch); rg[1] = *(const GAS v4u*)(PROJ + mr * NIN + C_KKA + ch); rg[2] = *(const GAS v4u*)(PROJ + mr * NIN + C_KP + ch); \
                rg[3] = *(const GAS v4u*)(PROJ + mr * NIN + C_LW + ch); rg[4] = *(const GAS v4u*)(RWT + RWT_R + mr * 512 + ch); \
                if (lane < 16) rv = *(const GAS v4u*)(RWT + RWT_V + (m0 + (size_t)(c) * TC + 8 * lw + stv) * 512 + chv); } while (0)
#define SCAN_STORE(c) do { LAS unsigned char* bb = F.lds + ((c) & 1) * BUF_B; \
                _Pragma("unroll") for (int a = 0; a < 5; ++a) { float x[8]; unpk8(rg[a], x); \
                    if (a == 3) { _Pragma("unroll") for (int e = 0; e < 8; ++e) x[e] = __builtin_amdgcn_exp2f(1.4426950408889634f * x[e]); } \
                    LAS f32x4* d = (LAS f32x4*)(bb + (((8 * lw + st8) * 5 + a) * 64 + 8 * (lane & 7)) * 4); d[0] = (f32x4){x[0], x[1], x[2], x[3]}; d[1] = (f32x4){x[4], x[5], x[6], x[7]}; } \
                if (lane < 16) { float x[8]; unpk8(rv, x); LAS f32x4* d = (LAS f32x4*)(bb + VEC_B + ((8 * lw + stv) * 16 + 8 * (lane & 1)) * 4); d[0] = (f32x4){x[0], x[1], x[2], x[3]}; d[1] = (f32x4){x[4], x[5], x[6], x[7]}; } } while (0)
#define SCAN_FLUSH(c) do { const LAS f32x4* yp = (const LAS f32x4*)(F.lds + ((c) & 1) * BUF_B + VEC_B + VV_B); const int idx = lw * 128 + lane * 2, t = idx >> 4, ri = idx & 15; \
                const f32x4 q0 = yp[idx], q1 = yp[idx + 1]; const float y0 = (q0.x + q0.y) + (q0.z + q0.w), y1 = (q1.x + q1.y) + (q1.z + q1.w); \
                float* dst = (float*)((unsigned char*)F.ws + WS_PROJ + (m0 + (size_t)(c) * TC + t) * (size_t)(NIN * 2) + YRAW_BYTE) + h * 64 + rb * 16 + ri; \
                *(GAS f32x2*)dst = (f32x2){y0, y1}; } while (0)
            SCAN_LOAD(0); SCAN_STORE(0); SCAN_LOAD(1);
            LDS_WAIT(); __syncthreads();
            for (int c = 0; c < NC; ++c) {
                if (c + 1 < NC) SCAN_STORE(c + 1);
                if (c + 2 < NC) SCAN_LOAD(c + 2);
                if (c > 0) SCAN_FLUSH(c - 1);
                LDS_WAIT(); __syncthreads();
            }
            SCAN_FLUSH(NC - 1);
            __syncthreads();
#undef SCAN_LOAD
#undef SCAN_STORE
#undef SCAN_FLUSH
        } else {
            const int cw = F.wave, rl = lane >> 4, kq = lane & 15, row = 4 * cw + rl;
            f32x2 Sa = (f32x2){0.f, 0.f}, Sb = Sa;
            __syncthreads();
            for (int c = 0; c < NC; ++c) {
                const LAS unsigned char* bb = F.lds + (c & 1) * BUF_B;
                const LAS f32x4* vp = (const LAS f32x4*)bb + kq;
                const LAS float* vvp = (const LAS float*)(bb + VEC_B) + row;
                LAS float* yp = (LAS float*)(bb + VEC_B + VV_B) + row * 4 + (kq >> 2);
                f32x4 kk = vp[0], kka = vp[16], kp = vp[32], w = vp[48], r = vp[64]; float vv = vvp[0];
#pragma unroll 2
                for (int t = 0; t < TC; ++t) {
                    const LAS f32x4* np = vp + (t + 1) * 80;
                    const f32x4 nkk = np[0], nkka = np[16], nkp = np[32], nw = np[48], nr = np[64]; const float nvv = vvp[(t + 1) * 16];
                    f32x2 P = Sa * (f32x2){kk.x, kk.y}; P = Sb * (f32x2){kk.z, kk.w} + P;
                    float p = P.x + P.y;
                    p = rowsum16(p);
                    const float sa = -p;
                    Sa = Sa * (f32x2){w.x, w.y} + (f32x2){kka.x, kka.y} * sa; Sb = Sb * (f32x2){w.z, w.w} + (f32x2){kka.z, kka.w} * sa;
                    Sa = (f32x2){kp.x, kp.y} * vv + Sa; Sb = (f32x2){kp.z, kp.w} * vv + Sb;
                    f32x2 Y = Sa * (f32x2){r.x, r.y}; Y = Sb * (f32x2){r.z, r.w} + Y;
                    float y = Y.x + Y.y;
                    y += dppf<0xB1>(y); y += dppf<0x4E>(y);
                    yp[t * 64] = y;
                    kk = nkk; kka = nkka; kp = nkp; w = nw; r = nr; vv = nvv;
                }
                LDS_WAIT(); __syncthreads();
            }
            __syncthreads();
        }
    }
}

__device__ __forceinline__ void rw_post_row(Frame& F, const In& I, int l, int m) {
    bf16* PROJ = (bf16*)(F.ws + WS_PROJ); const bf16* RWT = (const bf16*)(F.ws + WS_RWT);
    const int ch = 8 * F.lane;
    const float* yr = (const float*)((const unsigned char*)F.ws + WS_PROJ + (size_t)m * (NIN * 2) + YRAW_BYTE) + ch;
    const f32x4 y0 = *(const GAS f32x4*)yr, y1 = *(const GAS f32x4*)(yr + 4);
    float y[8] = {y0.x, y0.y, y0.z, y0.w, y1.x, y1.y, y1.z, y1.w};
    float r[8], kp[8], v[8], g[8];
    unpk8(*(const GAS v4u*)(RWT + RWT_R + (size_t)m * 512 + ch), r); unpk8(*(const GAS v4u*)(PROJ + (size_t)m * NIN + C_KP + ch), kp);
    unpk8(*(const GAS v4u*)(RWT + RWT_V + (size_t)m * 512 + ch), v); unpk8(*(const GAS v4u*)(RWT + RWT_G + (size_t)m * 512 + ch), g);
    const float* rk = I.p[16] + l * 512 + ch; const float* lg = I.p[17] + l * 512 + ch; const float* lb = I.p[18] + l * 512 + ch;
    const f32x4 a0 = *(const GAS f32x4*)rk, a1 = *(const GAS f32x4*)(rk + 4), b0 = *(const GAS f32x4*)lg, b1 = *(const GAS f32x4*)(lg + 4), c0 = *(const GAS f32x4*)lb, c1 = *(const GAS f32x4*)(lb + 4);
    const float rkk[8] = {a0.x, a0.y, a0.z, a0.w, a1.x, a1.y, a1.z, a1.w}, lgg[8] = {b0.x, b0.y, b0.z, b0.w, b1.x, b1.y, b1.z, b1.w}, lbb[8] = {c0.x, c0.y, c0.z, c0.w, c1.x, c1.y, c1.z, c1.w};
    float s = 0.f, bs = 0.f;
#pragma unroll
    for (int e = 0; e < 8; ++e) { s += y[e]; bs += r[e] * kp[e] * rkk[e]; }
    const float mean = sum8(s) * (1.f / 64.f); bs = sum8(bs);
    float q = 0.f;
#pragma unroll
    for (int e = 0; e < 8; ++e) { y[e] -= mean; q += y[e] * y[e]; }
    const float rstd = 1.0f / sqrtf(sum8(q) * (1.f / 64.f) + 64e-5f);
    float o[8];
#pragma unroll
    for (int e = 0; e < 8; ++e) o[e] = (y[e] * rstd * lgg[e] + lbb[e] + bs * v[e]) * g[e];
    *(GAS v4u*)(PROJ + (size_t)m * NIN + RW_OFF + ch) = pk8(o);
}
__device__ __forceinline__ void gmlp_unit(Frame& F, const In& I, int l, int b, int c, int h) {
    bf16* PROJ = (bf16*)(F.ws + WS_PROJ); const bf16* GW = (const bf16*)(F.ws + WS_GMW) + ((size_t)l * 8 + h) * 128 * 128;
    const int lane = F.lane, r32 = lane & 31, hi = lane >> 5;
    const size_t mrow0 = (size_t)b * SEQ + (size_t)c * 128;
    f32x16 acc[4][2];
#pragma unroll
    for (int i = 0; i < 4; ++i)
#pragma unroll
        for (int j = 0; j < 2; ++j)
#pragma unroll
            for (int r = 0; r < 16; ++r) acc[i][j][r] = 0.f;
    const bf16* Vp = PROJ + mrow0 * NIN + 512 + h * 64 + r32;
#pragma unroll
    for (int ks = 0; ks < 8; ++ks) {
        bf16x8 bf0, bf1_;
        const bf16* Vk = Vp + (size_t)(16 * ks + 8 * hi) * NIN; asm volatile("" : "+v"(Vk));
#pragma unroll
        for (int e = 0; e < 8; ++e) { const size_t ro = (size_t)e * NIN; bf0[e] = (short)*(const GAS bf16*)(Vk + ro); bf1_[e] = (short)*(const GAS bf16*)(Vk + ro + 32); }
#pragma unroll
        for (int i = 0; i < 4; ++i) if (ks <= 2 * i + 1) {
            const bf16x8 a = *(const GAS bf16x8*)(GW + (size_t)(32 * i + r32) * 128 + 16 * ks + 8 * hi);
            acc[i][0] = MFMA32(a, bf0, acc[i][0]); acc[i][1] = MFMA32(a, bf1_, acc[i][1]); }
        asm volatile("" ::: "memory");
    }
    const float* bs = I.p[7] + ((size_t)l * 8 + h) * 128;
#pragma unroll
    for (int i = 0; i < 4; ++i) {
        bf16* Ui = PROJ + (mrow0 + 32 * i + 4 * hi) * NIN + h * 64 + r32; asm volatile("" : "+v"(Ui));
        const float* bsi = bs + 32 * i + 4 * hi; asm volatile("" : "+v"(bsi));
#pragma unroll
        for (int r = 0; r < 16; ++r) { const int tl = (r & 3) + 8 * (r >> 2); const float bsv = bsi[tl];
            bf16* up = Ui + (size_t)tl * NIN;
            const float u0 = bf1(*(const GAS bf16*)up), u1 = bf1(*(const GAS bf16*)(up + 32));
            *(GAS bf16*)up = (bf16)f2bf(u0 * (acc[i][0][r] + bsv)); *(GAS bf16*)(up + 32) = (bf16)f2bf(u1 * (acc[i][1][r] + bsv));
            if ((r & 3) == 3) asm volatile("" ::: "memory"); }
    }
}
__device__ __forceinline__ void c4_phase(Frame& F, const In& I, int l) {
    for (int m = F.gw; m < M; m += F.ngw) rw_post_row(F, I, l, m);
    for (int u = F.gw; u < BATCH * 16 * 8; u += F.ngw) gmlp_unit(F, I, l, u >> 7, (u >> 3) & 15, u & 7);
}

__device__ __forceinline__ void router_row(Frame& F, const In& I, int m, const float* hbuf) {
    const int lane = F.lane;
    const GAS f32x4* xr = (const GAS f32x4*)(hbuf + (size_t)m * DM) + lane; const GAS f32x4* gr = (const GAS f32x4*)(I.p[23] + DM) + lane;
    const float* rw = I.p[27];
    float lg[8]; float s = 0.f;
#pragma unroll
    for (int e = 0; e < 8; ++e) lg[e] = 0.f;
    GAS v2u* o8 = (GAS v2u*)((bf16*)(F.ws + WS_XN) + (size_t)m * DM) + lane;
    f32x4 xv[8];
#pragma unroll
    for (int j = 0; j < 8; ++j) { const f32x4 x = xr[64 * j]; s += (x.x * x.x + x.y * x.y) + (x.z * x.z + x.w * x.w); xv[j] = x; }
    const float rstd = 1.0f / sqrtf(wave_sum(s) * (1.f / DM) + 1e-6f);
#pragma unroll
    for (int j = 0; j < 8; ++j) { const f32x4 g = gr[64 * j]; const float n[4] = {xv[j].x * rstd * g.x, xv[j].y * rstd * g.y, xv[j].z * rstd * g.z, xv[j].w * rstd * g.w};
        v2u o; o.x = pk2(n[0], n[1]); o.y = pk2(n[2], n[3]); o8[64 * j] = o;
        const int c0 = 4 * (lane + 64 * j);
#pragma unroll
        for (int q = 0; q < 4; ++q) { const f32x4 w0 = *(const GAS f32x4*)(rw + (size_t)(c0 + q) * 8), w1 = *(const GAS f32x4*)(rw + (size_t)(c0 + q) * 8 + 4);
            lg[0] += n[q] * w0.x; lg[1] += n[q] * w0.y; lg[2] += n[q] * w0.z; lg[3] += n[q] * w0.w; lg[4] += n[q] * w1.x; lg[5] += n[q] * w1.y; lg[6] += n[q] * w1.z; lg[7] += n[q] * w1.w; } }
#pragma unroll
    for (int e = 0; e < 8; ++e) lg[e] = wave_sum(lg[e]) + I.p[28][e];
    int e0 = 0; float v0 = lg[0];
#pragma unroll
    for (int e = 1; e < 8; ++e) if (lg[e] > v0) { v0 = lg[e]; e0 = e; }
    int e1 = -1; float v1 = -3.0e38f;
#pragma unroll
    for (int e = 0; e < 8; ++e) if (e != e0 && lg[e] > v1) { v1 = lg[e]; e1 = e; }
    const float p1 = 1.0f / (1.0f + __expf(v0 - v1)), p0 = 1.0f - p1;
    if (lane == 0) {
        unsigned* cnt = (unsigned*)(F.ws + WS_CTL) + CW_CNT;
        const unsigned s0 = __hip_atomic_fetch_add(cnt + e0, 1u, RLX_AGENT), s1 = __hip_atomic_fetch_add(cnt + e1, 1u, RLX_AGENT);
        int* tab = (int*)(F.ws + WS_TAB) + (size_t)m * 8;
        tab[0] = e0; tab[1] = e1; tab[2] = (int)s0; tab[3] = (int)s1; ((float*)tab)[4] = p0; ((float*)tab)[5] = p1;
    }
}
__device__ __forceinline__ void moe_offsets(Frame& F, int (&off)[8], int (&ts)[8], int& nrt) {
    const unsigned* cnt = (const unsigned*)(F.ws + WS_CTL) + CW_CNT; int acc = 0;
#pragma unroll
    for (int e = 0; e < 8; ++e) { const int c = (int)__builtin_amdgcn_readfirstlane((int)__hip_atomic_load(cnt + e, RLX_AGENT)); ts[e] = acc; off[e] = acc * 256; acc += (c + 255) >> 8; }
    nrt = acc;
}
__device__ __forceinline__ void gather_phase(Frame& F) {
    const unsigned* cnt = (const unsigned*)(F.ws + WS_CTL) + CW_CNT;
    const int cj = (F.lane < 8) ? (int)__hip_atomic_load(cnt + (F.lane & 7), RLX_AGENT) : 0;
    const int tiles = (cj + 255) >> 8; int incl = tiles;
#pragma unroll
    for (int d = 1; d < 8; d <<= 1) { const int t = __shfl_up(incl, d); if (F.lane >= d) incl += t; }
    const int offv = (incl - tiles) * 256;
    const bf16* XN = (const bf16*)(F.ws + WS_XN); bf16* XG = (bf16*)(F.ws + WS_XG);
    for (int m = F.gw; m < M; m += F.ngw) {
        int* tab = (int*)(F.ws + WS_TAB) + (size_t)m * 8;
        const int e0 = tab[0], e1 = tab[1], s0 = __shfl(offv, e0) + tab[2], s1 = __shfl(offv, e1) + tab[3];
        const GAS v4u* src = (const GAS v4u*)(XN + (size_t)m * DM) + F.lane; GAS v4u* d0 = (GAS v4u*)(XG + (size_t)s0 * DM) + F.lane; GAS v4u* d1 = (GAS v4u*)(XG + (size_t)s1 * DM) + F.lane;
#pragma unroll
        for (int j = 0; j < 4; ++j) { const v4u x = src[64 * j]; d0[64 * j] = x; d1[64 * j] = x; }
        if (F.lane == 0) { tab[6] = s0; tab[7] = s1; }
    }
}
__device__ __forceinline__ void final_row(Frame& F, const In& I, int m, float* hbuf) {
    const int lane = F.lane;
    const int* tab = (const int*)(F.ws + WS_TAB) + (size_t)m * 8;
    const float p0 = ((const float*)tab)[4], p1 = ((const float*)tab)[5]; const int s0 = tab[6], s1 = tab[7];
    const bf16* Y2 = (const bf16*)(F.ws + WS_Y2);
    GAS f32x4* xr = (GAS f32x4*)(hbuf + (size_t)m * DM) + lane; const GAS f32x4* gr = (const GAS f32x4*)I.p[32] + lane;
    const GAS v2u* ya = (const GAS v2u*)(Y2 + (size_t)s0 * DM) + lane; const GAS v2u* yb = (const GAS v2u*)(Y2 + (size_t)s1 * DM) + lane;
    f32x4 v[8]; float s = 0.f;
#pragma unroll
    for (int j = 0; j < 8; ++j) { f32x4 x = xr[64 * j]; const v2u a = ya[64 * j], b = yb[64 * j];
        x.x += p0 * bfl(a.x) + p1 * bfl(b.x); x.y += p0 * bfh(a.x) + p1 * bfh(b.x); x.z += p0 * bfl(a.y) + p1 * bfl(b.y); x.w += p0 * bfh(a.y) + p1 * bfh(b.y);
        v[j] = x; s += (x.x * x.x + x.y * x.y) + (x.z * x.z + x.w * x.w); }
    const float rstd = 1.0f / sqrtf(wave_sum(s) * (1.f / DM) + 1e-6f);
#pragma unroll
    for (int j = 0; j < 8; ++j) { const f32x4 g = gr[64 * j]; xr[64 * j] = (f32x4){v[j].x * rstd * g.x, v[j].y * rstd * g.y, v[j].z * rstd * g.z, v[j].w * rstd * g.w}; }
}
#ifndef RPT_MASK
#define RPT_MASK 0
#endif

#ifndef PH_MASK
#define PH_MASK 0xFFFFFF
#endif
#define PK(kind) (((PH_MASK) >> (kind)) & 1)
#define IN(k) (lo <= (k) && (k) < hi)
#ifdef PROBE_A0
#define STAMP(p) do { if (blockIdx.x == 0 && F.tid == 0) ((LAS unsigned long long*)(F.lds + LDSCTL_OFF + 256))[(p)] = __builtin_amdgcn_s_memrealtime(); } while (0)
#else
#define STAMP(p) do { } while (0)
#endif
#define SEAM(k) do { if (IN(k) && IN((k) + 1)) xcd_barrier(bar); STAMP((k) + 1); } while (0)
template <int l> __device__ __forceinline__ void layer_body(Frame& F, const In& I, unsigned char* ws, float* hout, const XcdBarrier& bar, int lo, int hi) {
    LAS unsigned char* ring = F.lds;
    bf16* const XN = (bf16*)(ws + WS_XN); bf16* const PROJ = (bf16*)(ws + WS_PROJ); bf16* const RWT = (bf16*)(ws + WS_RWT);
        const int base = 1 + 11 * l;
        const float* hin = (l == 0) ? I.p[0] : (const float*)hout;
        if (PK(1) && IN(base + 0)) {
            pg8::Gemm g{XN, (const bf16*)(ws + WS_WIN) + (size_t)l * NIN * 2048, 2048, 2048, 2048}; pg8::StaticOrder S; S.init(M, NIN, F.G, (int)blockIdx.x);
            pg8::EpiInProj E{PROJ, I.p[3] + l * 3 * DM};
            pg8::gemm_phase<pg8::EpiInProj, pg8::StaticOrder, PG8_ALIGN, PG8_SP2>(ring, g, S, E);
        } SEAM(base + 0);
        if (PK(2) && IN(base + 1)) { c1_phase(F, I, l); if (RPT_MASK & 4) { xcd_barrier(bar); attn_dummy_phase(F); } } SEAM(base + 1);
        if (PK(3) && IN(base + 2)) {
            int kl = 256; asm volatile("" : "+s"(kl));
            pg8::Gemm g{RWT + RWT_LA, (const bf16*)(ws + WS_LORA) + (size_t)l * 1536 * 256, kl, 256, 256}; pg8::StaticOrder S; S.init(M, 1536, F.G, (int)blockIdx.x);
            pg8::EpiLora E{PROJ, RWT + RWT_KK, RWT + RWT_K, RWT + RWT_G, I.p[9] + l * 512, I.p[11] + l * 512, I.p[15] + l * 512};
            pg8::gemm_phase<pg8::EpiLora, pg8::StaticOrder, PG8_ALIGN, PG8_SP2>(ring, g, S, E);
        } SEAM(base + 2);
        if (PK(4) && IN(base + 3)) { scan_phase(F); if (RPT_MASK & 2) { xcd_barrier(bar); scan_phase(F); } } SEAM(base + 3);
        if (PK(5) && IN(base + 4)) { c4_phase(F, I, l); } SEAM(base + 4);
        if (PK(6) && IN(base + 5)) {
            pg8::Gemm g{PROJ, (const bf16*)(ws + WS_PC) + (size_t)l * 2048 * 2048, 512, NIN, 2048}; pg8::MergeOrder S; S.so.init(M, DM, F.G, (int)blockIdx.x);
            pg8::EpiMerge E{PROJ, XN};
            pg8::gemm_phase<pg8::EpiMerge, pg8::MergeOrder, PG8_ALIGN, PG8_SP2>(ring, g, S, E);
        } SEAM(base + 5);
        if (PK(7) && IN(base + 6)) {
            pg8::Gemm g{XN, (const bf16*)(ws + WS_WO) + (size_t)l * 2048 * 2048, 2048, 2048, 2048}; pg8::StaticOrder S; S.init(M, DM, F.G, (int)blockIdx.x);
            pg8::EpiResid E{hin, hout};
            pg8::gemm_phase<pg8::EpiResid, pg8::StaticOrder, PG8_ALIGN, PG8_SP2>(ring, g, S, E);
        } SEAM(base + 6);
        if (l == 0) {
            if (PK(8) && IN(base + 7)) { for (int m = F.gw; m < M; m += F.ngw) rms_row_to_bf16(hout + (size_t)m * DM, I.p[23], XN + (size_t)m * DM, F.lane); } SEAM(base + 7);
            if (PK(9) && IN(base + 8)) {
                pg8::Gemm g{XN, (const bf16*)(ws + WS_W13), 2048, 2048, 2048}; pg8::StaticOrder S; S.init(M, 2 * DFF, F.G, (int)blockIdx.x);
                pg8::EpiSwiGLU E{(bf16*)(ws + WS_H), DFF, 2 * DFF / 256};
                pg8::gemm_phase<pg8::EpiSwiGLU, pg8::StaticOrder, PG8_ALIGN, PG8_SP2>(ring, g, S, E);
            } SEAM(base + 8);
            if (PK(10) && IN(base + 9)) {
                pg8::Gemm g{(const bf16*)(ws + WS_H), (const bf16*)(ws + WS_W2), DFF, DFF, DFF}; pg8::StaticOrder S; S.init(M, DM, F.G, (int)blockIdx.x);
                pg8::EpiResid E{hout, hout};
                pg8::gemm_phase<pg8::EpiResid, pg8::StaticOrder, PG8_ALIGN, PG8_SP2>(ring, g, S, E);
            } SEAM(base + 9);
            if (PK(8) && IN(base + 10)) { for (int m = F.gw; m < M; m += F.ngw) rms_row_to_bf16(hout + (size_t)m * DM, I.p[1] + DM, XN + (size_t)m * DM, F.lane); } SEAM(base + 10);
        } else {
            if (PK(11) && IN(base + 7)) { for (int m = F.gw; m < M; m += F.ngw) router_row(F, I, m, hout); } SEAM(base + 7);
            if (PK(12) && IN(base + 8)) { gather_phase(F); } SEAM(base + 8);
            if (PK(13) && IN(base + 9)) {
                pg8::MoeOrder S; int off[8]; moe_offsets(F, off, S.ts, S.nrt); S.nt = 2 * DFE / 256; S.G = F.G; S.c = (int)blockIdx.x;
                pg8::Gemm g{(const bf16*)(ws + WS_XG), (const bf16*)(ws + WS_W13E), 2048, 2048, 2048};
                pg8::EpiSwiGLU E{(bf16*)(ws + WS_HX), DFE, 2 * DFE / 256};
                pg8::gemm_phase<pg8::EpiSwiGLU, pg8::MoeOrder, PG8_ALIGN, PG8_SP2>(ring, g, S, E);
            } SEAM(base + 9);
            if (PK(14) && IN(base + 10)) {
                pg8::MoeOrder S; int off[8]; moe_offsets(F, off, S.ts, S.nrt); S.nt = DM / 256; S.G = F.G; S.c = (int)blockIdx.x;
                pg8::Gemm g{(const bf16*)(ws + WS_HX), (const bf16*)(ws + WS_W2E), DFE, DFE, DFE};
                pg8::EpiPlain E{(bf16*)(ws + WS_Y2), DM, DM / 256};
                pg8::gemm_phase<pg8::EpiPlain, pg8::MoeOrder, PG8_ALIGN, PG8_SP2>(ring, g, S, E);
            } SEAM(base + 10);
            if (PK(15) && IN(base + 11)) { for (int m = F.gw; m < M; m += F.ngw) final_row(F, I, m, hout); }
        }
    }
struct Args { In in; float* out; unsigned char* ws; int ph_lo, ph_hi; };
__global__ void __launch_bounds__(NWAVES * 64, 2) trunk_fwd(Args args) {
    extern __shared__ __attribute__((aligned(16))) unsigned char lds_raw[];
    Frame F;
    F.lds = (LAS unsigned char*)lds_raw; F.ws = args.ws; F.in = nullptr;
    F.tid = threadIdx.x; F.lane = F.tid & 63; F.wave = __builtin_amdgcn_readfirstlane(F.tid >> 6);
    F.G = gridDim.x; F.gw = blockIdx.x * NWAVES + F.wave; F.ngw = F.G * NWAVES;
    const In& I = args.in;
    unsigned char* ws = args.ws;
    for (int u = F.tid; u < (LDS_BYTES - LDSCTL_OFF) / 4; u += NWAVES * 64) ((LAS unsigned*)(F.lds + LDSCTL_OFF))[u] = 0u;
    __syncthreads();
    const int lo = args.ph_lo, hi = args.ph_hi;
    XcdBarrier bar; bar.bar = (unsigned*)(ws + WS_CTL) + CW_BAR; bar.x = 0; bar.st = nullptr;
    if (hi - lo > 1) bar = xcd_barrier_post((unsigned*)(ws + WS_CTL) + CW_BAR, (volatile LAS unsigned*)(F.lds + LDSCTL_OFF) + 8);
    LAS unsigned char* ring = F.lds;
    bf16* const XN = (bf16*)(ws + WS_XN); bf16* const PROJ = (bf16*)(ws + WS_PROJ); bf16* const RWT = (bf16*)(ws + WS_RWT);
    float* const hout = args.out;

    STAMP(0);
    if (PK(0) && IN(0)) { p0_prologue(F, I); if (RPT_MASK & 1) { xcd_barrier(bar); p0_prologue(F, I); } } SEAM(0);

    layer_body<0>(F, I, ws, hout, bar, lo, hi);
    layer_body<1>(F, I, ws, hout, bar, lo, hi);
#ifdef PROBE_A0
    xcd_barrier(bar); STAMP(N_PHASES);
    if (blockIdx.x == 0) {
        const LAS unsigned long long* ts = (const LAS unsigned long long*)(F.lds + LDSCTL_OFF + 256);
        __syncthreads();
        const float x1 = (float)(ts[PROBE_A1 + 1] - ts[PROBE_A0]) * 0.01f, x2 = (float)(ts[PROBE_B1 + 1] - ts[PROBE_B0]) * 0.01f;
        if (F.tid == 0) hout[0] = x1;
        for (int i = F.tid; i < 100000; i += 512) hout[4096 + i] = x2 * 0.01f;
    }
#endif
#undef IN
#undef SEAM
}

#ifndef MK_SPLIT
#define MK_SPLIT 0
#endif
extern "C" void kernel_launch(void* const* d_in, const int* in_sizes, int n_in, void* d_out, int out_size, void* d_ws, size_t ws_size, hipStream_t stream) {
    static int grid = 0;
    if (grid == 0) {
        if (n_in != 33 || in_sizes[0] != M * DM || out_size != M * DM || ws_size < WS_END) { fprintf(stderr, "kernel_launch: unexpected shapes (n_in %d, ws %zu); nothing launched\n", n_in, ws_size); grid = -1; return; }
        int dev = 0, cus = 0, per_cu = 0;
        if (hipGetDevice(&dev) != hipSuccess || hipDeviceGetAttribute(&cus, hipDeviceAttributeMultiprocessorCount, dev) != hipSuccess) { grid = -1; return; }
        if (hipFuncSetAttribute((const void*)trunk_fwd, hipFuncAttributeMaxDynamicSharedMemorySize, LDS_BYTES) != hipSuccess) { fprintf(stderr, "kernel_launch: hipFuncSetAttribute failed\n"); grid = -1; return; }
        if (hipOccupancyMaxActiveBlocksPerMultiprocessor(&per_cu, (const void*)trunk_fwd, NWAVES * 64, LDS_BYTES) != hipSuccess || per_cu < 1) { fprintf(stderr, "kernel_launch: occupancy query says %d\n", per_cu); }
        (void)hipGetLastError();
        grid = cus;
    }
    if (grid < 0) return;
    if (hipMemsetAsync((char*)d_ws, 0, ZERO_BYTES, stream) != hipSuccess) return;
    Args a{};
    for (int i = 0; i < 33; ++i) a.in.p[i] = (const float*)d_in[i];
    a.out = (float*)d_out; a.ws = (unsigned char*)d_ws;
#if MK_SPLIT
    for (int p = 0; p < N_PHASES; ++p) { a.ph_lo = p; a.ph_hi = p + 1; hipLaunchKernelGGL(trunk_fwd, dim3(grid), dim3(NWAVES * 64), LDS_BYTES, stream, a); }
#else
    a.ph_lo = 0; a.ph_hi = N_PHASES;
    hipLaunchKernelGGL(trunk_fwd, dim3(grid), dim3(NWAVES * 64), LDS_BYTES, stream, a);
#endif
    const hipError_t le = hipPeekAtLastError();
    if (le != hipSuccess) fprintf(stderr, "kernel_launch: launch failed: %s\n", hipGetErrorName(le));
}
```

```cpp
#include <hip/hip_runtime.h>
#include <cstdio>
#include <cstdint>
namespace pg8 {
#define PG8_LAS __attribute__((address_space(3)))
typedef unsigned short bf16_t;
typedef short bf16x8 __attribute__((ext_vector_type(8)));
typedef float f32x4 __attribute__((ext_vector_type(4)));
typedef unsigned u32x4 __attribute__((ext_vector_type(4)));
constexpr int BM = 256, BK = 64, HALF = 128, HTB = HALF * BK * 2  , STAGE_BYTES = 8 * HTB, NXCD = 8, WGM = 8;

__host__ __device__ __forceinline__ int lds_byte(int r, int c) { const int st = (r >> 4) * 2 + (c >> 5), rr = r & 15, cc = c & 31, ob = rr * 64 + cc * 2; return st * 1024 + (ob ^ (((ob >> 9) & 1) << 5)); }
__host__ __device__ __forceinline__ void stage_rc(int b, int& R, int& C) { const int st = b / 1024, sb = b % 1024, swz = sb ^ (((sb >> 9) & 1) << 5); R = (st >> 1) * 16 + swz / 64; C = (st & 1) * 32 + (swz % 64) / 2; }
__host__ __device__ __forceinline__ int perm32(int rho) { const int n = rho >> 4, i = rho & 15; return 8 * (i >> 2) + 4 * n + (i & 3); }

struct Unit { int pm, pn, aoff, boff; };
struct Gemm { const bf16_t* A; const bf16_t* Bt; int K, lda, ldb; };

struct StaticOrder {
    int nM, nN, nwg, G, c;
    __host__ __device__ void init(int M, int N, int G_, int c_) { nM = M / BM; nN = N / BM; nwg = nM * nN; G = G_; c = c_; }
    __host__ __device__ bool next(int i, Unit& u) const {
        const long L = (long)i * G + c; if (L >= nwg) return false;
        int wgid = (int)L; { const int q = nwg / NXCD, r = nwg % NXCD, xcd = wgid % NXCD, off = wgid / NXCD; wgid = (xcd < r ? xcd * (q + 1) : r * (q + 1) + (xcd - r) * q) + off; }
        const int nig = WGM * nN, gid = wgid / nig, fm = gid * WGM, gsz = (nM - fm) < WGM ? (nM - fm) : WGM;
        u.pm = fm + ((wgid % nig) % gsz); u.pn = (wgid % nig) / gsz; u.aoff = 0; u.boff = 0; return true;
    }
    __device__ __forceinline__ void a_ready(const Unit&) const {}
    __device__ __forceinline__ void done(const Unit&) const {}
};

__device__ __forceinline__ unsigned cvt_pk_bf16(float lo, float hi) { unsigned r; asm volatile("v_cvt_pk_bf16_f32 %0, %1, %2" : "=v"(r) : "v"(lo), "v"(hi)); return r; }
typedef float f32x2 __attribute__((ext_vector_type(2)));
__device__ __forceinline__ f32x2 gelu_pk(f32x2 v) {
    const f32x2 av = __builtin_elementwise_abs(v), d = av * 0.2316418882f + 1.0f;
    f32x2 t; t.x = __builtin_amdgcn_rcpf(d.x); t.y = __builtin_amdgcn_rcpf(d.y);
    f32x2 q = t * 0.5307027145f + (-0.7265760135f); q = q * t + 0.7107068705f; q = q * t + (-0.142248368f); q = q * t + 0.127414796f; q = q * t;
    const f32x2 s = (v * v) * (-0.72134752044f);
    f32x2 e; e.x = __builtin_amdgcn_exp2f(s.x); e.y = __builtin_amdgcn_exp2f(s.y);
    const f32x2 m = v * (q * e), r = v - m;
    f32x2 o; o.x = v.x < 0.f ? m.x : r.x; o.y = v.y < 0.f ? m.y : r.y; return o;
}

template <int ACT  > struct EpiBf16 {
    static constexpr bool PERM = true, AFTER_DRAIN = false; static_assert(ACT == 0 || ACT == 1, "EpiBf16: ACT is 0 (none) or 1 (gelu_pk)");
    bf16_t* O; int ldc; const float* bias; int split_cols; size_t split_stride; float scale0;
    __device__ __forceinline__ void operator()(const f32x4 (&acc)[2][2][4][2], const Unit& u, int wr, int wc, int fr, int fq) const {
        const int row0 = u.pm * BM + wr * 64 + fr; int colt = u.pn * BM; bf16_t* base = O;
        float sc = 1.f; if (split_cols) { const int t = colt / split_cols; base += (size_t)t * split_stride; colt -= t * split_cols; if (t == 0) sc = scale0; }
        const int col0 = colt + wc * 32 + 8 * fq, bcol0 = u.pn * BM + wc * 32 + 8 * fq;
        f32x4 bv[2][2];
#pragma unroll
        for (int bj = 0; bj < 2; ++bj)
#pragma unroll
            for (int n = 0; n < 2; ++n) bv[bj][n] = bias ? *(const f32x4*)(bias + bcol0 + bj * HALF + 4 * n) : (f32x4){0.f, 0.f, 0.f, 0.f};
#pragma unroll
        for (int ai = 0; ai < 2; ++ai)
#pragma unroll
            for (int m = 0; m < 4; ++m) { bf16_t* rowp = base + (size_t)(row0 + ai * HALF + m * 16) * ldc + col0;
#pragma unroll
                for (int bj = 0; bj < 2; ++bj) { f32x4 v0 = acc[ai][bj][m][0] + bv[bj][0], v1 = acc[ai][bj][m][1] + bv[bj][1];
                    if (ACT == 1) { f32x2 a = gelu_pk((f32x2){v0[0], v0[1]}), b = gelu_pk((f32x2){v0[2], v0[3]}), c = gelu_pk((f32x2){v1[0], v1[1]}), d = gelu_pk((f32x2){v1[2], v1[3]});
                        v0 = (f32x4){a.x, a.y, b.x, b.y}; v1 = (f32x4){c.x, c.y, d.x, d.y}; }
                    v0 = v0 * sc; v1 = v1 * sc; u32x4 w; w.x = cvt_pk_bf16(v0[0], v0[1]); w.y = cvt_pk_bf16(v0[2], v0[3]); w.z = cvt_pk_bf16(v1[0], v1[1]); w.w = cvt_pk_bf16(v1[2], v1[3]);
                    *(u32x4*)(rowp + bj * HALF) = w; } }
    }
};

template <class Epi, class Sched, bool ALIGN_EPI = false, bool SP2 = false>
__device__ __forceinline__ void gemm_phase(PG8_LAS unsigned char* lds, const Gemm g, const Sched& S, const Epi& E) {
    const int tid = threadIdx.x, wid = __builtin_amdgcn_readfirstlane(tid >> 6), lane = tid & 63, wr = wid >> 2, wc = wid & 3, fr = lane & 15, fq = lane >> 4;
    const int K = g.K, nt = K / BK;
    unsigned voffA[2], voffB[2];
#pragma unroll
    for (int i = 0; i < 2; ++i) { int R, C; stage_rc(tid * 16 + i * 8192, R, C); const int Rb = Epi::PERM ? ((R & ~31) + perm32(R & 31)) : R;
        voffA[i] = (unsigned)(R * g.lda + C) * 2u; voffB[i] = (unsigned)(Rb * g.ldb + C) * 2u; }
    const size_t kstep = (size_t)(BK * 2);
    const size_t hstepA = (size_t)HALF * g.lda * 2, hstepB = (size_t)HALF * g.ldb * 2;
    const size_t tstepA = 2 * hstepA, tstepB = 2 * hstepB;
    const unsigned ldsw = (unsigned)wid * 1024u;
    const int aoff = lds_byte(wr * 64 + fr, fq * 8), boff = lds_byte(wc * 32 + fr, fq * 8);
#define PG8_SA(b, h) (((b) * 2 + (h)) * HTB)
#define PG8_SB(b, h) ((4 + (b) * 2 + (h)) * HTB)
#define PG8_STAGE(bufoff, gbase, voff) do { _Pragma("unroll") for (int _i = 0; _i < 2; ++_i) \
        __builtin_amdgcn_global_load_lds((const unsigned*)((const char*)(gbase) + (voff)[_i]), (PG8_LAS unsigned*)(lds + (bufoff) + ldsw + _i * 8192), 16, 0, 0); } while (0)
#define PG8_LDA(dst, b, h) do { _Pragma("unroll") for (int m = 0; m < 4; ++m) _Pragma("unroll") for (int k = 0; k < 2; ++k) dst[m][k] = *(const PG8_LAS bf16x8*)(lds + PG8_SA(b, h) + aoff + m * 2048 + k * 1024); } while (0)
#define PG8_LDB(dst, b, h) do { _Pragma("unroll") for (int n = 0; n < 2; ++n) _Pragma("unroll") for (int k = 0; k < 2; ++k) dst[n][k] = *(const PG8_LAS bf16x8*)(lds + PG8_SB(b, h) + boff + n * 2048 + k * 1024); } while (0)
#define PG8_MMA(ai, bj, At, Bt) do { __builtin_amdgcn_s_setprio(1); _Pragma("unroll") for (int m = 0; m < 4; ++m) _Pragma("unroll") for (int n = 0; n < 2; ++n) _Pragma("unroll") for (int k = 0; k < 2; ++k) \
        acc[ai][bj][m][n] = __builtin_amdgcn_mfma_f32_16x16x32_bf16(Bt[n][k], At[m][k], acc[ai][bj][m][n], 0, 0, 0); __builtin_amdgcn_s_setprio(0); } while (0)
#define PG8_WAIT_V(n) asm volatile("s_waitcnt vmcnt(" #n ")" ::: "memory")
#define PG8_WAIT_L(n) asm volatile("s_waitcnt lgkmcnt(" #n ")" ::: "memory")
#define PG8_BAR __builtin_amdgcn_s_barrier()
#define PG8_SCHED __builtin_amdgcn_sched_barrier(0)
    Unit cur, nxt; int ui = 0;
    if (!S.next(0, cur)) return;
    f32x4 acc[2][2][4][2];
#pragma unroll
    for (int a = 0; a < 2; ++a)
#pragma unroll
        for (int b = 0; b < 2; ++b)
#pragma unroll
            for (int m = 0; m < 4; ++m)
#pragma unroll
                for (int n = 0; n < 2; ++n) acc[a][b][m][n] = (f32x4){0.f, 0.f, 0.f, 0.f};
    bf16x8 At[4][2], B0[2][2], B1[2][2];
    const char* cA = (const char*)g.A + (size_t)cur.pm * tstepA + (size_t)cur.aoff * 2; const char* cB = (const char*)g.Bt + (size_t)cur.pn * tstepB + (size_t)cur.boff * 2;
    S.a_ready(cur);
    if constexpr (SP2) {
        PG8_STAGE(PG8_SB(0, 0), cB, voffB); PG8_STAGE(PG8_SB(0, 1), cB + hstepB, voffB); PG8_STAGE(PG8_SA(0, 0), cA, voffA); PG8_STAGE(PG8_SA(0, 1), cA + hstepA, voffA);
        if (wr == 1) PG8_BAR;
        PG8_WAIT_V(2); PG8_BAR;
        PG8_STAGE(PG8_SB(1, 0), cB + kstep, voffB); PG8_STAGE(PG8_SA(1, 0), cA + kstep, voffA); PG8_STAGE(PG8_SB(1, 1), cB + hstepB + kstep, voffB);
        PG8_WAIT_V(6); PG8_BAR;
    } else {
        PG8_STAGE(PG8_SB(0, 0), cB, voffB); PG8_STAGE(PG8_SA(0, 0), cA, voffA); PG8_STAGE(PG8_SB(0, 1), cB + hstepB, voffB); PG8_STAGE(PG8_SA(0, 1), cA + hstepA, voffA);
        if (wr == 1) PG8_BAR;
        PG8_WAIT_V(4); PG8_BAR;
        PG8_STAGE(PG8_SB(1, 0), cB + kstep, voffB); PG8_STAGE(PG8_SA(1, 0), cA + kstep, voffA); PG8_STAGE(PG8_SB(1, 1), cB + hstepB + kstep, voffB);
        PG8_WAIT_V(6); PG8_BAR;
    }
    for (;;) {
        const bool has_next = S.next(ui + 1, nxt);
        const char* nA = has_next ? (const char*)g.A + (size_t)nxt.pm * tstepA + (size_t)nxt.aoff * 2 : cA; const char* nB = has_next ? (const char*)g.Bt + (size_t)nxt.pn * tstepB + (size_t)nxt.boff * 2 : cB;
        for (int t = 0; t < nt; t += 2) {
            const bool last = (t == nt - 2);
            const char* a1 = cA + (size_t)(t + 1) * kstep;
            const char* a2 = last ? nA : cA + (size_t)(t + 2) * kstep; const char* b2 = last ? nB : cB + (size_t)(t + 2) * kstep;
            const char* a3 = a2 + kstep; const char* b3 = b2 + kstep;
            if (last && has_next) S.a_ready(nxt);
            if constexpr (SP2) {
            PG8_LDB(B0, 0, 0); PG8_LDB(B1, 0, 1); PG8_SCHED; PG8_LDA(At, 0, 0); PG8_STAGE(PG8_SA(1, 1), a1 + hstepA, voffA);
            PG8_WAIT_V(8); PG8_WAIT_L(0); PG8_BAR; PG8_MMA(0, 0, At, B0); PG8_MMA(0, 1, At, B1); PG8_BAR; PG8_SCHED;
            PG8_LDA(At, 0, 1); PG8_STAGE(PG8_SB(0, 0), b2, voffB); PG8_STAGE(PG8_SB(0, 1), b2 + hstepB, voffB); PG8_STAGE(PG8_SA(0, 0), a2, voffA);
            PG8_WAIT_V(8); PG8_WAIT_L(0); PG8_BAR; PG8_MMA(1, 0, At, B0); PG8_MMA(1, 1, At, B1); PG8_BAR; PG8_SCHED;
            PG8_LDB(B0, 1, 0); PG8_LDB(B1, 1, 1); PG8_SCHED; PG8_LDA(At, 1, 0); PG8_STAGE(PG8_SA(0, 1), a2 + hstepA, voffA);
            PG8_WAIT_V(8); PG8_WAIT_L(0); PG8_BAR; PG8_MMA(0, 0, At, B0); PG8_MMA(0, 1, At, B1); PG8_BAR; PG8_SCHED;
            PG8_LDA(At, 1, 1); PG8_STAGE(PG8_SB(1, 0), b3, voffB); PG8_STAGE(PG8_SB(1, 1), b3 + hstepB, voffB); PG8_STAGE(PG8_SA(1, 0), a3, voffA);
            PG8_WAIT_V(8); PG8_WAIT_L(0); PG8_BAR; PG8_MMA(1, 0, At, B0); PG8_MMA(1, 1, At, B1); PG8_BAR; PG8_SCHED;
            } else {
            PG8_LDB(B0, 0, 0); PG8_SCHED; PG8_LDA(At, 0, 0); PG8_STAGE(PG8_SA(1, 1), a1 + hstepA, voffA);
            PG8_WAIT_L(8); PG8_BAR; PG8_WAIT_L(0); PG8_MMA(0, 0, At, B0); PG8_BAR; PG8_SCHED;
            PG8_LDB(B1, 0, 1); PG8_STAGE(PG8_SB(0, 0), b2, voffB);
            PG8_BAR; PG8_WAIT_L(0); PG8_MMA(0, 1, At, B1); PG8_BAR;
            PG8_LDA(At, 0, 1); PG8_STAGE(PG8_SA(0, 0), a2, voffA);
            PG8_BAR; PG8_WAIT_L(0); PG8_MMA(1, 0, At, B0); PG8_BAR; PG8_SCHED;
            PG8_STAGE(PG8_SB(0, 1), b2 + hstepB, voffB);
            PG8_WAIT_V(6); PG8_BAR; PG8_MMA(1, 1, At, B1); PG8_BAR;
            PG8_LDB(B0, 1, 0); PG8_SCHED; PG8_LDA(At, 1, 0); PG8_STAGE(PG8_SA(0, 1), a2 + hstepA, voffA);
            PG8_WAIT_L(8); PG8_BAR; PG8_WAIT_L(0); PG8_MMA(0, 0, At, B0); PG8_BAR; PG8_SCHED;
            PG8_LDB(B1, 1, 1); PG8_STAGE(PG8_SB(1, 0), b3, voffB);
            PG8_BAR; PG8_WAIT_L(0); PG8_MMA(0, 1, At, B1); PG8_BAR;
            PG8_LDA(At, 1, 1); PG8_STAGE(PG8_SA(1, 0), a3, voffA);
            PG8_BAR; PG8_WAIT_L(0); PG8_MMA(1, 0, At, B0); PG8_BAR; PG8_SCHED;
            PG8_STAGE(PG8_SB(1, 1), b3 + hstepB, voffB);
            PG8_WAIT_V(6); PG8_BAR; PG8_MMA(1, 1, At, B1); PG8_BAR;
            }
        }
        if constexpr (ALIGN_EPI) { if (wr == 0) PG8_BAR; }
        if constexpr (!Epi::AFTER_DRAIN) { E(acc, cur, wr, wc, fr, fq); S.done(cur); }
        if (!has_next) break;
#pragma unroll
        for (int a = 0; a < 2; ++a)
#pragma unroll
            for (int b = 0; b < 2; ++b)
#pragma unroll
                for (int m = 0; m < 4; ++m)
#pragma unroll
                    for (int n = 0; n < 2; ++n) acc[a][b][m][n] = (f32x4){0.f, 0.f, 0.f, 0.f};
        cur = nxt; cA = nA; cB = nB; ++ui;
        if constexpr (ALIGN_EPI) { if (wr == 1) PG8_BAR; }
    }
    PG8_WAIT_V(0);
    if constexpr (!ALIGN_EPI) { if (wr == 0) PG8_BAR; }
    PG8_BAR;
    if constexpr (Epi::AFTER_DRAIN) { E.fused(acc, cur, wr, wc, fr, fq, lds, wid, lane); S.done(cur); }
#undef PG8_SA
#undef PG8_SB
#undef PG8_STAGE
#undef PG8_LDA
#undef PG8_LDB
#undef PG8_MMA
#undef PG8_WAIT_V
#undef PG8_WAIT_L
#undef PG8_BAR
#undef PG8_SCHED
}
}
namespace pg8 {
__device__ __forceinline__ float fsigmoid(float x) { return __builtin_amdgcn_rcpf(1.0f + __builtin_amdgcn_exp2f(-1.4426950408889634f * x)); }
__device__ __forceinline__ float gelu_tanh(float x) { const float y = 1.5957691216057308f * (x + 0.044715f * x * x * x); return x * fsigmoid(y); }
__device__ __forceinline__ float bf_lo(unsigned w) { return __uint_as_float(w << 16); }
__device__ __forceinline__ float bf_hi(unsigned w) { return __uint_as_float(w & 0xffff0000u); }
__device__ __forceinline__ u32x4 pack8(const f32x4 v0, const f32x4 v1) { u32x4 w; w.x = cvt_pk_bf16(v0[0], v0[1]); w.y = cvt_pk_bf16(v0[2], v0[3]); w.z = cvt_pk_bf16(v1[0], v1[1]); w.w = cvt_pk_bf16(v1[2], v1[3]); return w; }
__device__ __forceinline__ void unpack8(const u32x4 w, f32x4& v0, f32x4& v1) { v0 = (f32x4){bf_lo(w.x), bf_hi(w.x), bf_lo(w.y), bf_hi(w.y)}; v1 = (f32x4){bf_lo(w.z), bf_hi(w.z), bf_lo(w.w), bf_hi(w.w)}; }

struct EpiInProj {
    static constexpr bool PERM = true, AFTER_DRAIN = false;
    bf16_t* O; const float* gate_b;
    __device__ __forceinline__ void operator()(const f32x4 (&acc)[2][2][4][2], const Unit& u, int wr, int wc, int fr, int fq) const {
        asm volatile("" : "+v"(fr), "+v"(fq));
        const int row0 = u.pm * BM + wr * 64 + fr, col0 = u.pn * BM + wc * 32 + 8 * fq;
        const int mode = u.pn < 4 ? 1 : (u.pn >= 23 ? 2 : 0);
        f32x4 bv[2][2];
#pragma unroll
        for (int bj = 0; bj < 2; ++bj)
#pragma unroll
            for (int n = 0; n < 2; ++n) bv[bj][n] = (mode == 2) ? *(const f32x4*)(gate_b + (col0 - 5888) + bj * HALF + 4 * n) : (f32x4){0.f, 0.f, 0.f, 0.f};
#pragma unroll
        for (int ai = 0; ai < 2; ++ai)
#pragma unroll
            for (int m = 0; m < 4; ++m) { bf16_t* rowp = O + (size_t)(row0 + ai * HALF + m * 16) * 12032 + col0;
#pragma unroll
                for (int bj = 0; bj < 2; ++bj) { f32x4 v0 = acc[ai][bj][m][0] + bv[bj][0], v1 = acc[ai][bj][m][1] + bv[bj][1];
                    if (mode == 1) {
#pragma unroll
                        for (int e = 0; e < 4; ++e) { v0[e] = gelu_tanh(v0[e]); v1[e] = gelu_tanh(v1[e]); } }
                    else if (mode == 2) {
#pragma unroll
                        for (int e = 0; e < 4; ++e) { v0[e] = fsigmoid(v0[e]); v1[e] = fsigmoid(v1[e]); } }
                    *(u32x4*)(rowp + bj * HALF) = pack8(v0, v1); } }
    }
};

struct EpiLora {
    static constexpr bool PERM = true, AFTER_DRAIN = false;
    bf16_t* PROJ; const bf16_t* KK; const bf16_t* RSK; bf16_t* G; const float* w0; const float* a0; const float* ka;
    __device__ __forceinline__ void operator()(const f32x4 (&acc)[2][2][4][2], const Unit& u, int wr, int wc, int fr, int fq) const {
        asm volatile("" : "+v"(fr), "+v"(fq));
        const int row0 = u.pm * BM + wr * 64 + fr, ch0 = (u.pn & 1) * BM + wc * 32 + 8 * fq, kind = u.pn >> 1;
        if (kind == 0) {
#pragma unroll
            for (int bj = 0; bj < 2; ++bj) { const int ch = ch0 + bj * HALF; const f32x4 b0 = *(const f32x4*)(w0 + ch), b1 = *(const f32x4*)(w0 + ch + 4);
#pragma unroll
                for (int ai = 0; ai < 2; ++ai)
#pragma unroll
                    for (int m = 0; m < 4; ++m) { const size_t row = (size_t)(row0 + ai * HALF + m * 16);
                        f32x4 v0 = acc[ai][bj][m][0] + b0, v1 = acc[ai][bj][m][1] + b1;
#pragma unroll
                        for (int e = 0; e < 4; ++e) { v0[e] = -0.6065306597126334f * fsigmoid(v0[e]); v1[e] = -0.6065306597126334f * fsigmoid(v1[e]); }
                        *(u32x4*)(PROJ + row * 12032 + 3840 + ch) = pack8(v0, v1); } }
        } else if (kind == 1) {
            f32x4 b0[2], b1[2], c0[2], c1[2];
#pragma unroll
            for (int bj = 0; bj < 2; ++bj) { const int ch = ch0 + bj * HALF; b0[bj] = *(const f32x4*)(a0 + ch); b1[bj] = *(const f32x4*)(a0 + ch + 4); c0[bj] = *(const f32x4*)(ka + ch); c1[bj] = *(const f32x4*)(ka + ch + 4); }
#pragma unroll
            for (int ai = 0; ai < 2; ++ai)
#pragma unroll
                for (int m = 0; m < 4; ++m) { size_t row = (size_t)(row0 + ai * HALF + m * 16); asm volatile("" : "+v"(row));
                    const bf16_t* kr = RSK + row * 512 + ch0; const bf16_t* qr = KK + row * 512 + ch0; bf16_t* pr = PROJ + row * 12032 + ch0;
#pragma unroll
                    for (int bj = 0; bj < 2; ++bj) {
                        const u32x4 kw = *(const u32x4*)(kr + bj * HALF), qw = *(const u32x4*)(qr + bj * HALF);
                        f32x4 k0, k1, q0, q1; unpack8(kw, k0, k1); unpack8(qw, q0, q1);
                        f32x4 p0, p1;
#pragma unroll
                        for (int e = 0; e < 4; ++e) { const float a_0 = fsigmoid(acc[ai][bj][m][0][e] + b0[bj][e]), a_1 = fsigmoid(acc[ai][bj][m][1][e] + b1[bj][e]);
                            p0[e] = k0[e] * (1.0f + (a_0 - 1.0f) * c0[bj][e]); p1[e] = k1[e] * (1.0f + (a_1 - 1.0f) * c1[bj][e]); q0[e] *= a_0; q1[e] *= a_1; }
                        *(u32x4*)(pr + 4352 + bj * HALF) = pack8(q0, q1);
                        *(u32x4*)(pr + 4864 + bj * HALF) = pack8(p0, p1); }
                    asm volatile("" ::: "memory"); }
        } else {
#pragma unroll
            for (int bj = 0; bj < 2; ++bj) { const int ch = ch0 + bj * HALF;
#pragma unroll
                for (int ai = 0; ai < 2; ++ai)
#pragma unroll
                    for (int m = 0; m < 4; ++m) { const size_t row = (size_t)(row0 + ai * HALF + m * 16); *(u32x4*)(G + row * 512 + ch) = pack8(acc[ai][bj][m][0], acc[ai][bj][m][1]); } }
        }
    }
};

struct EpiMerge {
    static constexpr bool PERM = true, AFTER_DRAIN = false;
    const bf16_t* PROJ; bf16_t* MG;
    __device__ __forceinline__ void operator()(const f32x4 (&acc)[2][2][4][2], const Unit& u, int wr, int wc, int fr, int fq) const {
        asm volatile("" : "+v"(fr), "+v"(fq));
        const int row0 = u.pm * BM + wr * 64 + fr, col0 = u.pn * BM + wc * 32 + 8 * fq, ks = u.boff >> 9, gi = ks > 2 ? 2 : ks;
#pragma unroll
        for (int ai = 0; ai < 2; ++ai)
#pragma unroll
            for (int m = 0; m < 4; ++m) { const size_t row = (size_t)(row0 + ai * HALF + m * 16);
#pragma unroll
                for (int bj = 0; bj < 2; ++bj) { const int col = col0 + bj * HALF;
                    f32x4 g0, g1, p0 = (f32x4){0.f, 0.f, 0.f, 0.f}, p1 = p0;
                    unpack8(*(const u32x4*)(PROJ + row * 12032 + 5888 + gi * 2048 + col), g0, g1);
                    if (ks != 0) unpack8(*(const u32x4*)(MG + row * 2048 + col), p0, p1);
                    p0 = p0 + g0 * acc[ai][bj][m][0]; p1 = p1 + g1 * acc[ai][bj][m][1];
                    *(u32x4*)(MG + row * 2048 + col) = pack8(p0, p1); } }
    }
};

struct EpiResid {
    static constexpr bool PERM = false, AFTER_DRAIN = false;
    const float* hin; float* out;
    __device__ __forceinline__ void operator()(const f32x4 (&acc)[2][2][4][2], const Unit& u, int wr, int wc, int fr, int fq) const {
        asm volatile("" : "+v"(fr), "+v"(fq));
        const int row0 = u.pm * BM + wr * 64 + fr, col0 = u.pn * BM + wc * 32 + 4 * fq;
#pragma unroll
        for (int ai = 0; ai < 2; ++ai)
#pragma unroll
            for (int m = 0; m < 4; ++m) { const size_t off = (size_t)(row0 + ai * HALF + m * 16) * 2048 + col0;
#pragma unroll
                for (int bj = 0; bj < 2; ++bj)
#pragma unroll
                    for (int n = 0; n < 2; ++n) { const f32x4 bs = *(const f32x4*)(hin + off + bj * HALF + n * 16); *(f32x4*)(out + off + bj * HALF + n * 16) = bs + acc[ai][bj][m][n]; } }
    }
};

struct EpiSwiGLU {
    static constexpr bool PERM = true, AFTER_DRAIN = false;
    bf16_t* O; int ldc, nt;
    __device__ __forceinline__ void operator()(const f32x4 (&acc)[2][2][4][2], const Unit& u, int wr, int wc, int fr, int fq) const {
        asm volatile("" : "+v"(fr), "+v"(fq));
        const int row0 = u.pm * BM + wr * 64 + fr, col0 = (u.pn % nt) * HALF + wc * 32 + 8 * fq;
#pragma unroll
        for (int ai = 0; ai < 2; ++ai)
#pragma unroll
            for (int m = 0; m < 4; ++m) { bf16_t* rowp = O + (size_t)(row0 + ai * HALF + m * 16) * ldc + col0;
                f32x4 v0, v1;
#pragma unroll
                for (int e = 0; e < 4; ++e) { const float a_0 = acc[ai][0][m][0][e], a_1 = acc[ai][0][m][1][e];
                    v0[e] = a_0 * fsigmoid(a_0) * acc[ai][1][m][0][e]; v1[e] = a_1 * fsigmoid(a_1) * acc[ai][1][m][1][e]; }
                *(u32x4*)rowp = pack8(v0, v1); }
    }
};

struct EpiPlain {
    static constexpr bool PERM = true, AFTER_DRAIN = false;
    bf16_t* O; int ldc, nt;
    __device__ __forceinline__ void operator()(const f32x4 (&acc)[2][2][4][2], const Unit& u, int wr, int wc, int fr, int fq) const {
        asm volatile("" : "+v"(fr), "+v"(fq));
        const int row0 = u.pm * BM + wr * 64 + fr, col0 = (u.pn % nt) * BM + wc * 32 + 8 * fq;
#pragma unroll
        for (int ai = 0; ai < 2; ++ai)
#pragma unroll
            for (int m = 0; m < 4; ++m) { bf16_t* rowp = O + (size_t)(row0 + ai * HALF + m * 16) * ldc + col0;
#pragma unroll
                for (int bj = 0; bj < 2; ++bj) *(u32x4*)(rowp + bj * HALF) = pack8(acc[ai][bj][m][0], acc[ai][bj][m][1]); }
    }
};

struct MergeOrder {
    StaticOrder so;
    __device__ __forceinline__ bool next(int i, Unit& u) const {
        if (!so.next(i >> 2, u)) return false;
        const int ks = i & 3; u.boff = ks * 512; u.aoff = ks == 0 ? 0 : (ks == 1 ? 1024 : (ks == 2 ? 2816 : 3328)); return true;
    }
    __device__ __forceinline__ void a_ready(const Unit&) const {}
    __device__ __forceinline__ void done(const Unit&) const {}
};

struct MoeOrder {
    int ts[8]; int nrt, nt, G, c;
    __device__ __forceinline__ bool next(int i, Unit& u) const {
        const long L = (long)i * G + c; if (L >= (long)nrt * nt) return false;
        const int rt = (int)(L / nt), pnl = (int)(L % nt); int e = 0;
#pragma unroll
        for (int j = 1; j < 8; ++j) e += (rt >= ts[j]) ? 1 : 0;
        u.pm = rt; u.pn = e * nt + pnl; u.aoff = 0; u.boff = 0; return true;
    }
    __device__ __forceinline__ void a_ready(const Unit&) const {}
    __device__ __forceinline__ void done(const Unit&) const {}
};
}

#ifndef PG8_SP2
#define PG8_SP2 true
#endif
#ifndef PG8_ALIGN
#define PG8_ALIGN true
#endif
constexpr int NWAVES = 8;
constexpr int BATCH = 8, SEQ = 2048, DM = 2048, M = BATCH * SEQ;
constexpr int NIN = 12032, GM_OFF = 0, RW_OFF = 1024, SB_OFF = 2816, GATE_OFF = 5888;
constexpr int C_LW = 3840, C_KKA = 4352, C_KP = 4864;
constexpr int YRAW_BYTE = 3072;
constexpr int DFF = 5632, DFE = 2816, NEXP = 8;
constexpr int XG_ROWS = 2 * M + NEXP * 256;
constexpr int N_PHASES = 24;
constexpr size_t MiB = 1u << 20;
constexpr size_t WS_CTL = 0, WS_LORA = 1 * MiB, ZERO_BYTES = 3 * MiB;
constexpr size_t WS_TAB = 3 * MiB, WS_GMW = 4 * MiB;
constexpr size_t WS_WIN = 5 * MiB, WS_PC = 99 * MiB, WS_WO = 115 * MiB, WS_W13 = 131 * MiB, WS_W2 = 175 * MiB, WS_W13E = 197 * MiB, WS_W2E = 373 * MiB;
constexpr size_t WS_XN = 461 * MiB, WS_PROJ = 525 * MiB, WS_RWT = 901 * MiB, WS_END = 989 * MiB;
constexpr size_t WS_H = WS_PROJ;
constexpr size_t WS_XG = 525 * MiB, WS_HX = 661 * MiB, WS_Y2 = 848 * MiB;
static_assert(WS_Y2 + (size_t)XG_ROWS * DM * 2 <= WS_END && WS_HX + (size_t)XG_ROWS * DFE * 2 <= WS_Y2 && WS_XG + (size_t)XG_ROWS * DM * 2 <= WS_HX, "moe overlay");
static_assert(WS_PROJ + (size_t)M * NIN * 2 <= WS_RWT && WS_H + (size_t)M * DFF * 2 <= WS_RWT && WS_RWT + (size_t)M * (5 * 512 + 256) * 2 <= WS_END, "ws map");
constexpr size_t RWT_R = 0, RWT_K = (size_t)M * 512, RWT_V = 2 * (size_t)M * 512, RWT_KK = 3 * (size_t)M * 512, RWT_G = 4 * (size_t)M * 512, RWT_LA = 5 * (size_t)M * 512;
constexpr int CW_BAR = 4096, CW_CNT = 1024;
constexpr int LDS_BYTES = 147456, LDSCTL_OFF = LDS_BYTES - 1024;

#define GAS __attribute__((address_space(1)))
#define LAS __attribute__((address_space(3)))
typedef unsigned short bf16;
typedef unsigned v4u __attribute__((ext_vector_type(4)));
typedef unsigned v2u __attribute__((ext_vector_type(2)));
typedef float f32x4 __attribute__((ext_vector_type(4)));
typedef float f32x16 __attribute__((ext_vector_type(16)));
typedef short bf16x8 __attribute__((ext_vector_type(8)));
typedef GAS unsigned gu32;
#define RLX_AGENT __ATOMIC_RELAXED, __HIP_MEMORY_SCOPE_AGENT
#define LDS_WAIT() asm volatile("s_waitcnt lgkmcnt(0)" ::: "memory")
#define VM_WAIT() asm volatile("s_waitcnt vmcnt(0)" ::: "memory")
__device__ __forceinline__ unsigned f2bf(float f) { unsigned u = __builtin_bit_cast(unsigned, f); return (u + 0x7fffu + ((u >> 16) & 1u)) >> 16; }
typedef float f32x2_t __attribute__((ext_vector_type(2))); typedef __bf16 bf16x2_t __attribute__((ext_vector_type(2)));
__device__ __forceinline__ unsigned pk2(float lo, float hi) { f32x2_t v = {lo, hi}; bf16x2_t b = __builtin_convertvector(v, bf16x2_t); return __builtin_bit_cast(unsigned, b); }
__device__ __forceinline__ float bfl(unsigned w) { return __uint_as_float(w << 16); }
__device__ __forceinline__ float bfh(unsigned w) { return __uint_as_float(w & 0xffff0000u); }
__device__ __forceinline__ float bf1(bf16 h) { return __uint_as_float((unsigned)h << 16); }
__device__ __forceinline__ float fsig(float x) { return __builtin_amdgcn_rcpf(1.0f + __builtin_amdgcn_exp2f(-1.4426950408889634f * x)); }
__device__ __forceinline__ void unpk8(const v4u w, float (&v)[8]) { v[0] = bfl(w.x); v[1] = bfh(w.x); v[2] = bfl(w.y); v[3] = bfh(w.y); v[4] = bfl(w.z); v[5] = bfh(w.z); v[6] = bfl(w.w); v[7] = bfh(w.w); }
__device__ __forceinline__ v4u pk8(const float (&v)[8]) { v4u w; w.x = pk2(v[0], v[1]); w.y = pk2(v[2], v[3]); w.z = pk2(v[4], v[5]); w.w = pk2(v[6], v[7]); return w; }

#define XB_TMO      128
#define XB_XCNT(j)  (256  + 64 * (j))
#define XB_XSUB(j)  (1280 + 64 * (j))
#define XB_XGEN(j)  (2304 + 64 * (j))
#define XB_TOP      3328
#define XB_TOPGEN   3392
#define XCD_BAR_WORDS 3456
#define XB_SPIN_CAP (1u << 18)
__device__ __forceinline__ unsigned xb_ld(unsigned* p)              { return __hip_atomic_load(p, __ATOMIC_RELAXED, __HIP_MEMORY_SCOPE_AGENT); }
__device__ __forceinline__ unsigned xb_add(unsigned* p, unsigned v) { return __hip_atomic_fetch_add(p, v, __ATOMIC_RELAXED, __HIP_MEMORY_SCOPE_AGENT); }
__device__ __forceinline__ unsigned xb_xcc_id() { return (unsigned)__builtin_amdgcn_s_getreg((3 << 11) | 20) & 0xFu; }
#define XB_SPIN(cond, bar) do { unsigned _sp = 0; while (cond) { __builtin_amdgcn_s_sleep(1); \
    if ((++_sp & 255u) == 0u) { if (xb_ld(&(bar)[XB_TMO])) break; if (_sp > XB_SPIN_CAP) { atomicAdd(&(bar)[XB_TMO], 1u); break; } } } } while (0)
struct XcdBarrier { unsigned* bar; unsigned x; volatile LAS unsigned* st; };
__device__ __forceinline__ XcdBarrier xcd_barrier_post(unsigned* bar, volatile LAS unsigned* st) {
    XcdBarrier b; b.bar = bar; b.x = xb_xcc_id(); b.st = st;
    if (threadIdx.x == 0) (void)xb_add(&bar[XB_XCNT(b.x)], 1u);
    return b;
}
__device__ __forceinline__ void xcd_barrier_complete(unsigned* bar, unsigned x, unsigned& nloc, unsigned& nx) {
    const unsigned G = gridDim.x * gridDim.y * gridDim.z;
    unsigned sum, cnt, mine, sp = 0u;
    for (;;) {
        sum = 0u; cnt = 0u; mine = 0u;
#pragma unroll
        for (unsigned j = 0; j < 16; ++j) { const unsigned c = xb_ld(&bar[XB_XCNT(j)]); sum += c; cnt += (c > 0u) ? 1u : 0u; mine = (j == x) ? c : mine; }
        if (sum == G) break;
        __builtin_amdgcn_s_sleep(1);
        if ((++sp & 255u) == 0u) { if (xb_ld(&bar[XB_TMO])) break; if (sp > XB_SPIN_CAP) { atomicAdd(&bar[XB_TMO], 1u); break; } }
    }
    nloc = mine > 0u ? mine : 1u; nx = cnt > 0u ? cnt : 1u;
}
__device__ __forceinline__ void xcd_barrier(const XcdBarrier& b) {
    asm volatile("s_waitcnt vmcnt(0)" ::: "memory");
    __syncthreads();
    if (threadIdx.x == 0) {
        unsigned* bar = b.bar;
        __builtin_amdgcn_s_waitcnt(0);
        unsigned nloc = b.st[0], nx = b.st[1];
        if (nloc == 0u) { xcd_barrier_complete(bar, b.x, nloc, nx); b.st[0] = nloc; b.st[1] = nx; }
        const unsigned old = xb_add(&bar[XB_XSUB(b.x)], 1u);
        const unsigned gen = old / nloc;
        if (old + 1u == (gen + 1u) * nloc) {
            __builtin_amdgcn_fence(__ATOMIC_RELEASE, "agent");
            asm volatile("s_waitcnt vmcnt(0)" ::: "memory");
            const unsigned og = xb_add(&bar[XB_TOP], 1u);
            const unsigned tg = og / nx;
            if (og + 1u == (tg + 1u) * nx) xb_add(&bar[XB_TOPGEN], 1u);
            else XB_SPIN(xb_ld(&bar[XB_TOPGEN]) == tg, bar);
            __builtin_amdgcn_fence(__ATOMIC_ACQUIRE, "agent");
            xb_add(&bar[XB_XGEN(b.x)], 1u);
            asm volatile("s_waitcnt vmcnt(0)" ::: "memory");
        } else {
            XB_SPIN(xb_ld(&bar[XB_XGEN(b.x)]) == gen, bar);
            __builtin_amdgcn_fence(__ATOMIC_ACQUIRE, "agent");
            asm volatile("s_waitcnt vmcnt(0)" ::: "memory");
        }
    }
    __syncthreads();
}

struct Frame {
    LAS unsigned char* lds;
    unsigned char* ws;
    const float* const* in;
    int tid, lane, wave, G, gw, ngw;
};
__device__ __forceinline__ float wave_sum(float v) {
#pragma unroll
    for (int o = 1; o < 64; o <<= 1) v += __shfl_xor(v, o);
    return v;
}
__device__ __forceinline__ float sum8(float v) { v += __shfl_xor(v, 1); v += __shfl_xor(v, 2); v += __shfl_xor(v, 4); return v; }

__device__ __forceinline__ void tr_item(const float* W, int N, bf16* WT, int ldo, int koff, int rowbase, int mode, float sc, LAS float* scr, int k0, int n0, int lane) {
    const int lq = lane & 15, lr = lane >> 4;
#pragma unroll 4
    for (int i = 0; i < 16; ++i) { const int kk = 4 * i + lr; const f32x4 v = *(const GAS f32x4*)(W + (size_t)(k0 + kk) * N + n0 + 4 * lq);
        LAS float* s = scr + kk * 65 + 4 * lq; s[0] = v.x * sc; s[1] = v.y * sc; s[2] = v.z * sc; s[3] = v.w * sc; }
    LDS_WAIT(); asm volatile("" ::: "memory");
    const int c = lane & 7, ns = lane >> 3;
#pragma unroll
    for (int j = 0; j < 8; ++j) { const int n = n0 + ns + 8 * j; const int row = rowbase + (mode ? ((n >> 7) * 256 + (n & 127) + (mode == 2 ? 128 : 0)) : n);
        const LAS float* s = scr + (8 * c) * 65 + ns + 8 * j;
        v4u o; o.x = pk2(s[0 * 65], s[1 * 65]); o.y = pk2(s[2 * 65], s[3 * 65]); o.z = pk2(s[4 * 65], s[5 * 65]); o.w = pk2(s[6 * 65], s[7 * 65]);
        *(GAS v4u*)(WT + (size_t)row * ldo + koff + k0 + 8 * c) = o; }
    LDS_WAIT(); asm volatile("" ::: "memory");
}

__device__ __forceinline__ void rms_row_to_bf16(const float* xrow, const float* gain, bf16* orow, int lane) {
    const GAS f32x4* xr = (const GAS f32x4*)xrow + lane; const GAS f32x4* gr = (const GAS f32x4*)gain + lane;
    f32x4 v[8]; float s = 0.f;
#pragma unroll
    for (int j = 0; j < 8; ++j) { v[j] = xr[64 * j]; s += (v[j].x * v[j].x + v[j].y * v[j].y) + (v[j].z * v[j].z + v[j].w * v[j].w); }
    const float rstd = 1.0f / sqrtf(wave_sum(s) * (1.f / DM) + 1e-6f);
    GAS v2u* o8 = (GAS v2u*)orow + lane;
#pragma unroll
    for (int j = 0; j < 8; ++j) { const f32x4 g = gr[64 * j]; v2u o; o.x = pk2(v[j].x * rstd * g.x, v[j].y * rstd * g.y); o.y = pk2(v[j].z * rstd * g.z, v[j].w * rstd * g.w); o8[64 * j] = o; }
}

struct In { const float* p[33]; };
constexpr int NJOBS = 43, JOBS_PRO = 4, JOBS_BG0 = 27;
__device__ __forceinline__ void tr_load32(f32x4 (&v)[8], const float* W, int N, int k0, int n0, int lane) {
    const int lq = lane & 15, lr = lane >> 4;
#pragma unroll
    for (int i = 0; i < 8; ++i) v[i] = *(const GAS f32x4*)(W + (size_t)(k0 + 4 * i + lr) * N + n0 + 4 * lq);
}
__device__ __forceinline__ void tr_store32(const f32x4 (&v)[8], bf16* WT, int ldo, int koff, int rowbase, int mode, float sc, LAS float* scr, int k0, int n0, int lane) {
    const int lq = lane & 15, lr = lane >> 4;
#pragma unroll
    for (int i = 0; i < 8; ++i) { LAS float* s = scr + (4 * i + lr) * 65 + 4 * lq; s[0] = v[i].x; s[1] = v[i].y; s[2] = v[i].z; s[3] = v[i].w; }
    LDS_WAIT(); asm volatile("" ::: "memory");
    const int c = lane & 3, ns = lane >> 2;
#pragma unroll
    for (int j = 0; j < 4; ++j) { const int n = n0 + ns + 16 * j; const int row = rowbase + (mode ? ((n >> 7) * 256 + (n & 127) + (mode == 2 ? 128 : 0)) : n);
        const LAS float* s = scr + (8 * c) * 65 + ns + 16 * j;
        v4u o; o.x = pk2(s[0 * 65] * sc, s[1 * 65] * sc); o.y = pk2(s[2 * 65] * sc, s[3 * 65] * sc); o.z = pk2(s[4 * 65] * sc, s[5 * 65] * sc); o.w = pk2(s[6 * 65] * sc, s[7 * 65] * sc);
        *(GAS v4u*)(WT + (size_t)row * ldo + koff + k0 + 8 * c) = o; }
    LDS_WAIT(); asm volatile("" ::: "memory");
}
__device__ __forceinline__ void conv_jobs(const LAS unsigned long long* ptab, unsigned char* ws, int jlo, int jhi, int wid, int nw, LAS float* scr, int lane) {
    int rot = 0;
    for (int j = jlo; j < jhi; ++j) {
        int pi; size_t wo = 0, wso; size_t wto = 0; int Kd, N, ldo, koff = 0, rowbase = 0, mode = 0, slo = 0, shi = 0;
        if (j == 0 || j == 11) { const int l = j == 0 ? 0 : 1; pi = 2; wo = (size_t)l * 2048 * NIN; Kd = 2048; N = NIN; wso = WS_WIN; wto = (size_t)l * NIN * 2048; ldo = 2048; slo = SB_OFF; shi = SB_OFF + 1024; }
        else if ((j >= 1 && j < 4) || (j >= 12 && j < 15)) { const int l = j < 4 ? 0 : 1, q = j < 4 ? j - 1 : j - 12;
            pi = q == 0 ? 10 : (q == 1 ? 12 : 13); wo = (size_t)l * (q == 2 ? 128 : 64) * 512; Kd = q == 2 ? 128 : 64; N = 512;
            wso = WS_LORA; wto = (size_t)l * 1536 * 256; ldo = 256; koff = 64 * q; rowbase = 512 * q; }
        else if ((j >= 4 && j < 7) || (j >= 15 && j < 18)) { const int l = j < 7 ? 0 : 1, q = j < 7 ? j - 4 : j - 15;
            pi = 19 + q; wo = (size_t)l * (q == 2 ? 1024 : 512) * 2048; Kd = q == 2 ? 1024 : 512; N = 2048;
            wso = WS_PC; wto = (size_t)l * 2048 * 2048; ldo = 2048; koff = 512 * q; }
        else if (j == 7 || j == 18) { const int l = j == 7 ? 0 : 1; pi = 22; wo = (size_t)l * 2048 * 2048; Kd = 2048; N = 2048; wso = WS_WO; wto = (size_t)l * 2048 * 2048; ldo = 2048; }
        else if (j == 8)  { pi = 24; Kd = 2048; N = DFF; wso = WS_W13; ldo = 2048; mode = 1; }
        else if (j == 9)  { pi = 25; Kd = 2048; N = DFF; wso = WS_W13; ldo = 2048; mode = 2; }
        else if (j == 10) { pi = 26; Kd = DFF; N = 2048; wso = WS_W2; ldo = DFF; }
        else if (j < 27) { const int e = j - 19; pi = 29; wo = (size_t)e * 2048 * DFE; Kd = 2048; N = DFE; wso = WS_W13E; ldo = 2048; rowbase = e * 2 * DFE; mode = 1; }
        else if (j < 35) { const int e = j - 27; pi = 30; wo = (size_t)e * 2048 * DFE; Kd = 2048; N = DFE; wso = WS_W13E; ldo = 2048; rowbase = e * 2 * DFE; mode = 2; }
        else             { const int e = j - 35; pi = 31; wo = (size_t)e * DFE * 2048; Kd = DFE; N = 2048; wso = WS_W2E; ldo = DFE; rowbase = e * 2048; }
        const float* W = (const float*)ptab[pi] + wo; bf16* WT = (bf16*)(ws + wso) + wto;
        const int nnb = N / 64, nitems = (Kd / 32) * nnb;
        int start = wid - rot; if (start < 0) start += nw;
#define CV_LOAD(V, it_) do { const int kb_ = (it_) / nnb, nb_ = (it_) - kb_ * nnb; tr_load32(V, W, N, 32 * kb_, 64 * nb_, lane); } while (0)
#define CV_STORE(V, it_) do { const int kb_ = (it_) / nnb, nb_ = (it_) - kb_ * nnb, n0_ = 64 * nb_; tr_store32(V, WT, ldo, koff, rowbase, mode, (n0_ >= slo && n0_ < shi) ? 0.125f : 1.0f, scr, 32 * kb_, n0_, lane); } while (0)
        f32x4 va[8], vb[8];
        if (start < nitems) CV_LOAD(va, start);
        for (int it = start; it < nitems; it += 2 * nw) {
            { const int i1 = it + nw < nitems ? it + nw : it; CV_LOAD(vb, i1); }
            CV_STORE(va, it);
            if (it + nw >= nitems) break;
            { const int i2 = it + 2 * nw < nitems ? it + 2 * nw : it + nw; CV_LOAD(va, i2); }
            CV_STORE(vb, it + nw);
        }
#undef CV_LOAD
#undef CV_STORE
        rot = (rot + nitems) % nw;
    }
}
__device__ __forceinline__ void p0_prologue(Frame& F, const In& I) {
    unsigned char* ws = F.ws;
    conv_jobs((const LAS unsigned long long*)(F.lds + LDSCTL_OFF + 256), ws, 0, JOBS_PRO, F.gw, F.ngw, (LAS float*)(F.lds + F.wave * 8320), F.lane);
    { const float* gw = I.p[6]; bf16* o = (bf16*)(ws + WS_GMW);
      for (int g = blockIdx.x * 512 + F.tid; g < 2 * 8 * 128 * 128 / 8; g += F.G * 512) { const int s0 = (g & 15) * 8, t = (g >> 4) & 127;
          const f32x4 a = *(const GAS f32x4*)(gw + (size_t)g * 8), b = *(const GAS f32x4*)(gw + (size_t)g * 8 + 4);
          float v[8] = {a.x, a.y, a.z, a.w, b.x, b.y, b.z, b.w};
#pragma unroll
          for (int e = 0; e < 8; ++e) if (s0 + e > t) v[e] = 0.f;
          *(GAS v4u*)(o + (size_t)g * 8) = pk8(v); } }
    for (int m = F.gw; m < M; m += F.ngw) rms_row_to_bf16(I.p[0] + (size_t)m * DM, I.p[1], (bf16*)(ws + WS_XN) + (size_t)m * DM, F.lane);
}

__device__ __forceinline__ void rw_elem_row(Frame& F, const In& I, int l, int m) {
    bf16* PROJ = (bf16*)(F.ws + WS_PROJ); bf16* RWT = (bf16*)(F.ws + WS_RWT);
    const bool has_prev = (m % SEQ) != 0;
    const bf16* cur = PROJ + (size_t)m * NIN + RW_OFF; const bf16* prv = cur - NIN;
    const float* mu = I.p[8] + l * 1792; const float* kkw = I.p[14] + l * 512;
#pragma unroll
    for (int i = 0; i < 4; ++i) {
        const int c = F.lane + 64 * i;
        if (c < 224) {
            float x[8], p[8];
            unpk8(*(const GAS v4u*)(cur + 8 * c), x);
            if (has_prev) unpk8(*(const GAS v4u*)(prv + 8 * c), p); else {
#pragma unroll
                for (int e = 0; e < 8; ++e) p[e] = 0.f; }
            const f32x4 m0 = *(const GAS f32x4*)(mu + 8 * c), m1 = *(const GAS f32x4*)(mu + 8 * c + 4);
            const float mm[8] = {m0.x, m0.y, m0.z, m0.w, m1.x, m1.y, m1.z, m1.w};
#pragma unroll
            for (int e = 0; e < 8; ++e) x[e] = x[e] + (p[e] - x[e]) * mm[e];
            if (i == 0) { *(GAS v4u*)(RWT + RWT_R + (size_t)m * 512 + 8 * c) = pk8(x); }
            else if (i == 1) { const int ch = 8 * (c - 64);
                *(GAS v4u*)(RWT + RWT_K + (size_t)m * 512 + ch) = pk8(x);
                const f32x4 k0 = *(const GAS f32x4*)(kkw + ch), k1 = *(const GAS f32x4*)(kkw + ch + 4);
                const float kw[8] = {k0.x, k0.y, k0.z, k0.w, k1.x, k1.y, k1.z, k1.w};
                float q[8], ss = 0.f;
#pragma unroll
                for (int e = 0; e < 8; ++e) { q[e] = x[e] * kw[e]; ss += q[e] * q[e]; }
                ss = sum8(ss);
                const float inv = 1.0f / fmaxf(sqrtf(ss), 1e-12f);
#pragma unroll
                for (int e = 0; e < 8; ++e) q[e] *= inv;
                *(GAS v4u*)(RWT + RWT_KK + (size_t)m * 512 + ch) = pk8(q); }
            else if (i == 2) { *(GAS v4u*)(RWT + RWT_V + (size_t)m * 512 + 8 * (c - 128)) = pk8(x); }
            else { const int cc = c - 192;
#pragma unroll
                for (int e = 0; e < 8; ++e) { if (cc < 8) x[e] = 1.0f - 2.0f * __builtin_amdgcn_rcpf(1.0f + __builtin_amdgcn_exp2f(2.885390081777927f * x[e])); else if (cc >= 16) x[e] = fsig(x[e]); }
                *(GAS v4u*)(RWT + RWT_LA + (size_t)m * 256 + 8 * cc) = pk8(x); }
        }
    }
}
__device__ __forceinline__ void gm_ln_row(Frame& F, const In& I, int l, int m) {
    bf16* vp = (bf16*)(F.ws + WS_PROJ) + (size_t)m * NIN + 512 + 8 * F.lane;
    float x[8]; unpk8(*(const GAS v4u*)vp, x);
    float s = 0.f;
#pragma unroll
    for (int e = 0; e < 8; ++e) s += x[e];
    const float mean = wave_sum(s) * (1.f / 512.f); float q = 0.f;
#pragma unroll
    for (int e = 0; e < 8; ++e) { x[e] -= mean; q += x[e] * x[e]; }
    const float rstd = 1.0f / sqrtf(wave_sum(q) * (1.f / 512.f) + 1e-5f);
    const float* g = I.p[4] + l * 512 + 8 * F.lane; const float* b = I.p[5] + l * 512 + 8 * F.lane;
    const f32x4 g0 = *(const GAS f32x4*)g, g1 = *(const GAS f32x4*)(g + 4), b0 = *(const GAS f32x4*)b, b1 = *(const GAS f32x4*)(b + 4);
    const float gg[8] = {g0.x, g0.y, g0.z, g0.w, g1.x, g1.y, g1.z, g1.w}, bb[8] = {b0.x, b0.y, b0.z, b0.w, b1.x, b1.y, b1.z, b1.w};
#pragma unroll
    for (int e = 0; e < 8; ++e) x[e] = x[e] * rstd * gg[e] + bb[e];
    *(GAS v4u*)vp = pk8(x);
}
#define MFMA32(a, b, c) __builtin_amdgcn_mfma_f32_32x32x16_bf16((a), (b), (c), 0, 0, 0)
__device__ __forceinline__ int crow(int r, int hi) { return (r & 3) + 8 * (r >> 2) + 4 * hi; }
__device__ __forceinline__ void sb_attn_unit(bf16* PROJ, int b, int h, int qt, int lane, int ocol = SB_OFF) {
    const int r32 = lane & 31, hi = lane >> 5;
    const size_t rowb = (size_t)b * SEQ;
    const bf16* Qp = PROJ + (rowb + qt * 32 + r32) * NIN + SB_OFF + h * 64 + hi * 8;
    bf16x8 qf[4];
#pragma unroll
    for (int ds = 0; ds < 4; ++ds) qf[ds] = *(const GAS bf16x8*)(Qp + ds * 16);
    f32x16 o0, o1;
#pragma unroll
    for (int r = 0; r < 16; ++r) { o0[r] = 0.f; o1[r] = 0.f; }
    float R = 0.f;
    const int tq = qt * 32 + r32;
    for (int kt = qt; kt >= 0; --kt) {
        const bf16* Kp = PROJ + (rowb + kt * 32 + r32) * NIN + SB_OFF + 1024 + h * 64 + hi * 8;
        bf16x8 kf[4];
#pragma unroll
        for (int ds = 0; ds < 4; ++ds) kf[ds] = *(const GAS bf16x8*)(Kp + ds * 16);
        const bf16* Vp = PROJ + (rowb + kt * 32) * NIN + SB_OFF + 2048 + h * 64 + r32;
        bf16x8 vf[2][2];
#pragma unroll
        for (int j = 0; j < 2; ++j)
#pragma unroll
            for (int dt = 0; dt < 2; ++dt)
#pragma unroll
                for (int e = 0; e < 8; ++e) vf[j][dt][e] = (short)*(const GAS bf16*)(Vp + (size_t)crow(8 * j + e, hi) * NIN + dt * 32);
        f32x16 st;
#pragma unroll
        for (int r = 0; r < 16; ++r) st[r] = 0.f;
#pragma unroll
        for (int ds = 0; ds < 4; ++ds) st = MFMA32(kf[ds], qf[ds], st);
        float sp[16]; const bool diag = (kt == qt);
#pragma unroll
        for (int r = 0; r < 16; ++r) { const float z = st[r]; const int s = kt * 32 + crow(r, hi);
            float v = (z > 20.f) ? z : 0.6931471805599453f * __builtin_amdgcn_logf(1.0f + __builtin_amdgcn_exp2f(1.4426950408889634f * z));
            if (diag && s >= tq) v = 0.f;
            sp[r] = v; }
        float rs[4], prs[4];
#pragma unroll
        for (int g = 0; g < 4; ++g) { rs[g] = (sp[4 * g] + sp[4 * g + 1]) + (sp[4 * g + 2] + sp[4 * g + 3]); prs[g] = __shfl_xor(rs[g], 32); }
        float carry = R; float att[16];
#pragma unroll
        for (int g = 3; g >= 0; --g) { float c = carry + (hi == 0 ? prs[g] : 0.f);
#pragma unroll
            for (int i = 3; i >= 0; --i) { const int r = 4 * g + i; c += sp[r]; const int s = kt * 32 + crow(r, hi);
                float a = __builtin_amdgcn_exp2f(1.4426950408889634f * (st[r] - c));
                if (diag && s >= tq) a = 0.f;
                att[r] = a; }
            carry += rs[g] + prs[g]; }
        R = carry;
        bf16x8 pa[2];
#pragma unroll
        for (int j = 0; j < 2; ++j) { v4u w; w.x = pk2(att[8 * j], att[8 * j + 1]); w.y = pk2(att[8 * j + 2], att[8 * j + 3]); w.z = pk2(att[8 * j + 4], att[8 * j + 5]); w.w = pk2(att[8 * j + 6], att[8 * j + 7]); pa[j] = __builtin_bit_cast(bf16x8, w); }
#pragma unroll
        for (int j = 0; j < 2; ++j) { o0 = MFMA32(pa[j], vf[j][0], o0); o1 = MFMA32(pa[j], vf[j][1], o1); }
        if (__all(R > 110.f)) break;
    }
    bf16* Op = PROJ + (rowb + qt * 32) * NIN + ocol + h * 64 + r32;
#pragma unroll
    for (int r = 0; r < 16; ++r) { const size_t ro = (size_t)crow(r, hi) * NIN; *(GAS bf16*)(Op + ro) = (bf16)f2bf(o0[r]); *(GAS bf16*)(Op + ro + 32) = (bf16)f2bf(o1[r]); }
}
__device__ __forceinline__ void c1_phase(Frame& F, const In& I, int l) {
    for (int m = F.gw; m < M; m += F.ngw) { rw_elem_row(F, I, l, m); gm_ln_row(F, I, l, m); }
    bf16* PROJ = (bf16*)(F.ws + WS_PROJ);
    for (int u = F.gw; u < BATCH * 16 * 64; u += F.ngw) { const int qt = 63 - (u >> 7), bh = u & 127; sb_attn_unit(PROJ, bh >> 4, bh & 15, qt, F.lane); }
}

__device__ __forceinline__ void attn_dummy_phase(Frame& F) {
    bf16* PROJ = (bf16*)(F.ws + WS_PROJ);
    for (int u = F.gw; u < BATCH * 16 * 64; u += F.ngw) { const int qt = 63 - (u >> 7), bh = u & 127; sb_attn_unit(PROJ, bh >> 4, bh & 15, qt, F.lane, 1536); }
}

template <int CTRL> __device__ __forceinline__ float dppf(float v) { return __builtin_bit_cast(float, __builtin_amdgcn_update_dpp(0, __builtin_bit_cast(int, v), CTRL, 0xf, 0xf, true)); }
__device__ __forceinline__ float rowsum16(float x) { x += dppf<0xB1>(x); x += dppf<0x4E>(x); x += dppf<0x141>(x); x += dppf<0x140>(x); return x; }
__device__ __forceinline__ void lds_wait_ge(volatile LAS unsigned* w, unsigned target) {
    for (unsigned sp = 0; sp < (1u << 22); ++sp) { if ((unsigned)__builtin_amdgcn_readfirstlane((int)w[0]) >= target) break; __builtin_amdgcn_s_sleep(1); }
}
__device__ __forceinline__ void lds_wait4_ge(volatile LAS unsigned* w, unsigned target) {
    for (unsigned sp = 0; sp < (1u << 22); ++sp) { const unsigned a = w[0], b = w[1], c = w[2], d = w[3]; const unsigned m = min(min(a, b), min(c, d));
        if ((unsigned)__builtin_amdgcn_readfirstlane((int)m) >= target) break; __builtin_amdgcn_s_sleep(1); }
}
__device__ __forceinline__ void scan_phase(Frame& F, const In& I, int jlo, int jhi) {
    typedef float f32x2 __attribute__((ext_vector_type(2)));
    constexpr int TC = 32, NC = SEQ / TC, VEC_B = TC * 5 * 64 * 4, VV_B = TC * 16 * 4, YP_B = TC * 16 * 4 * 4, BUF_B = VEC_B + VV_B + YP_B, CV_OFF = 2 * BUF_B;
    static_assert(CV_OFF + 3 * 8320 <= LDSCTL_OFF, "scan LDS map");
    const bf16* PROJ = (const bf16*)(F.ws + WS_PROJ); const bf16* RWT = (const bf16*)(F.ws + WS_RWT);
    const int lane = F.lane;
    volatile LAS unsigned* f_ready = (volatile LAS unsigned*)(F.lds + LDSCTL_OFF + 64);
    volatile LAS unsigned* f_done = (volatile LAS unsigned*)(F.lds + LDSCTL_OFF + 80);
    bool bg_done = false;
    for (int u = blockIdx.x; u < BATCH * 8 * 4; u += F.G) {
        const int rb = u & 3, bh = u >> 2, h = bh & 7, b = bh >> 3;
        const size_t m0 = (size_t)b * SEQ;
        __syncthreads();
        if (F.tid < 8) f_ready[F.tid] = 0u;
        LDS_WAIT(); __syncthreads();
        if (F.wave >= 5) {
            if (!bg_done) conv_jobs((const LAS unsigned long long*)(F.lds + LDSCTL_OFF + 256), F.ws, jlo, jhi, blockIdx.x * 3 + (F.wave - 5), F.G * 3, (LAS float*)(F.lds + CV_OFF + (F.wave - 5) * 8320), lane);
            bg_done = true;
        } else if (F.wave == 4) {
            const int st8 = lane >> 3, ch = h * 64 + 8 * (lane & 7);
            v4u rgA[4][5], rvA, rgB[4][5], rvB;
#define SCAN_LOAD(rg, rv, c) do { _Pragma("unroll") for (int q = 0; q < 4; ++q) { const size_t mr = m0 + (size_t)(c) * TC + 8 * q + st8; \
                rg[q][0] = *(const GAS v4u*)(RWT + RWT_KK + mr * 512 + ch); rg[q][1] = *(const GAS v4u*)(PROJ + mr * NIN + C_KKA + ch); rg[q][2] = *(const GAS v4u*)(PROJ + mr * NIN + C_KP + ch); \
                rg[q][3] = *(const GAS v4u*)(PROJ + mr * NIN + C_LW + ch); rg[q][4] = *(const GAS v4u*)(RWT + RWT_R + mr * 512 + ch); } \
                rv = *(const GAS v4u*)(RWT + RWT_V + (m0 + (size_t)(c) * TC + (lane >> 1)) * 512 + h * 64 + rb * 16 + 8 * (lane & 1)); } while (0)
#define SCAN_STORE(rg, rv, c) do { LAS unsigned char* bb = F.lds + ((c) & 1) * BUF_B; \
                _Pragma("unroll") for (int q = 0; q < 4; ++q) { _Pragma("unroll") for (int a = 0; a < 5; ++a) { float x[8]; unpk8(rg[q][a], x); \
                    if (a == 3) { _Pragma("unroll") for (int e = 0; e < 8; ++e) x[e] = __builtin_amdgcn_exp2f(1.4426950408889634f * x[e]); } \
                    LAS f32x4* d = (LAS f32x4*)(bb + (((8 * q + st8) * 5 + a) * 64 + 8 * (lane & 7)) * 4); d[0] = (f32x4){x[0], x[1], x[2], x[3]}; d[1] = (f32x4){x[4], x[5], x[6], x[7]}; } } \
                { float x[8]; unpk8(rv, x); LAS f32x4* d = (LAS f32x4*)(bb + VEC_B + ((lane >> 1) * 16 + 8 * (lane & 1)) * 4); d[0] = (f32x4){x[0], x[1], x[2], x[3]}; d[1] = (f32x4){x[4], x[5], x[6], x[7]}; } } while (0)
#define SCAN_FLUSH(c) do { const LAS f32x4* yp = (const LAS f32x4*)(F.lds + ((c) & 1) * BUF_B + VEC_B + VV_B); \
                _Pragma("unroll") for (int k = 0; k < 4; ++k) { const int idx = k * 128 + lane * 2, t = idx >> 4, ri = idx & 15; \
                const f32x4 q0 = yp[idx], q1 = yp[idx + 1]; const float y0 = (q0.x + q0.y) + (q0.z + q0.w), y1 = (q1.x + q1.y) + (q1.z + q1.w); \
                float* dst = (float*)((unsigned char*)F.ws + WS_PROJ + (m0 + (size_t)(c) * TC + t) * (size_t)(NIN * 2) + YRAW_BYTE) + h * 64 + rb * 16 + ri; \
                *(GAS f32x2*)dst = (f32x2){y0, y1}; } } while (0)
#define SCAN_STEP(rg, rv, c) do { if ((c) >= 2) { lds_wait4_ge(f_done, (unsigned)((c) - 1)); SCAN_FLUSH((c) - 2); } \
                SCAN_STORE(rg, rv, (c)); LDS_WAIT(); asm volatile("" ::: "memory"); if (lane == 0) f_ready[0] = (unsigned)((c) + 1); \
                { const int cn = (c) + 2 < NC ? (c) + 2 : (c); SCAN_LOAD(rg, rv, cn); } } while (0)
            __builtin_amdgcn_s_setprio(2);
            SCAN_LOAD(rgA, rvA, 0); SCAN_LOAD(rgB, rvB, 1);
            for (int c = 0; c < NC; c += 2) { SCAN_STEP(rgA, rvA, c); SCAN_STEP(rgB, rvB, c + 1); }
            lds_wait4_ge(f_done, (unsigned)NC);
            SCAN_FLUSH(NC - 2); SCAN_FLUSH(NC - 1);
            __builtin_amdgcn_s_setprio(0);
#undef SCAN_STEP
#undef SCAN_LOAD
#undef SCAN_STORE
#undef SCAN_FLUSH
        } else {
            const int cw = F.wave, rl = lane >> 4, kq = lane & 15, row = 4 * cw + rl;
            f32x2 Sa = (f32x2){0.f, 0.f}, Sb = Sa;
            __builtin_amdgcn_s_setprio(3);
            for (int c = 0; c < NC; ++c) {
                lds_wait_ge(f_ready, (unsigned)(c + 1));
                const LAS unsigned char* bb = F.lds + (c & 1) * BUF_B;
                const LAS f32x4* vp = (const LAS f32x4*)bb + kq;
                const LAS float* vvp = (const LAS float*)(bb + VEC_B) + row;
                LAS float* yp = (LAS float*)(bb + VEC_B + VV_B) + row * 4 + (kq >> 2);
                f32x4 kk = vp[0], kka = vp[16], kp = vp[32], w = vp[48], r = vp[64]; float vv = vvp[0];
#pragma unroll 2
                for (int t = 0; t < TC; ++t) {
                    const LAS f32x4* np = vp + (t + 1) * 80;
                    const f32x4 nkk = np[0], nkka = np[16], nkp = np[32], nw = np[48], nr = np[64]; const float nvv = vvp[(t + 1) * 16];
                    f32x2 P = Sa * (f32x2){kk.x, kk.y}; P = Sb * (f32x2){kk.z, kk.w} + P;
                    float p = P.x + P.y;
                    p = rowsum16(p);
                    const float sa = -p;
                    Sa = Sa * (f32x2){w.x, w.y} + (f32x2){kka.x, kka.y} * sa; Sb = Sb * (f32x2){w.z, w.w} + (f32x2){kka.z, kka.w} * sa;
                    Sa = (f32x2){kp.x, kp.y} * vv + Sa; Sb = (f32x2){kp.z, kp.w} * vv + Sb;
                    f32x2 Y = Sa * (f32x2){r.x, r.y}; Y = Sb * (f32x2){r.z, r.w} + Y;
                    float y = Y.x + Y.y;
                    y += dppf<0xB1>(y); y += dppf<0x4E>(y);
                    yp[t * 64] = y;
                    kk = nkk; kka = nkka; kp = nkp; w = nw; r = nr; vv = nvv;
                }
                LDS_WAIT(); asm volatile("" ::: "memory");
                if (lane == 0) f_done[cw] = (unsigned)(c + 1);
            }
            __builtin_amdgcn_s_setprio(0);
        }
    }
    if (F.wave >= 5 && !bg_done) conv_jobs((const LAS unsigned long long*)(F.lds + LDSCTL_OFF + 256), F.ws, jlo, jhi, blockIdx.x * 3 + (F.wave - 5), F.G * 3, (LAS float*)(F.lds + CV_OFF + (F.wave - 5) * 8320), lane);
}

__device__ __forceinline__ void rw_post_row(Frame& F, const In& I, int l, int m) {
    bf16* PROJ = (bf16*)(F.ws + WS_PROJ); const bf16* RWT = (const bf16*)(F.ws + WS_RWT);
    const int ch = 8 * F.lane;
    const float* yr = (const float*)((const unsigned char*)F.ws + WS_PROJ + (size_t)m * (NIN * 2) + YRAW_BYTE) + ch;
    const f32x4 y0 = *(const GAS f32x4*)yr, y1 = *(const GAS f32x4*)(yr + 4);
    float y[8] = {y0.x, y0.y, y0.z, y0.w, y1.x, y1.y, y1.z, y1.w};
    float r[8], kp[8], v[8], g[8];
    unpk8(*(const GAS v4u*)(RWT + RWT_R + (size_t)m * 512 + ch), r); unpk8(*(const GAS v4u*)(PROJ + (size_t)m * NIN + C_KP + ch), kp);
    unpk8(*(const GAS v4u*)(RWT + RWT_V + (size_t)m * 512 + ch), v); unpk8(*(const GAS v4u*)(RWT + RWT_G + (size_t)m * 512 + ch), g);
    const float* rk = I.p[16] + l * 512 + ch; const float* lg = I.p[17] + l * 512 + ch; const float* lb = I.p[18] + l * 512 + ch;
    const f32x4 a0 = *(const GAS f32x4*)rk, a1 = *(const GAS f32x4*)(rk + 4), b0 = *(const GAS f32x4*)lg, b1 = *(const GAS f32x4*)(lg + 4), c0 = *(const GAS f32x4*)lb, c1 = *(const GAS f32x4*)(lb + 4);
    const float rkk[8] = {a0.x, a0.y, a0.z, a0.w, a1.x, a1.y, a1.z, a1.w}, lgg[8] = {b0.x, b0.y, b0.z, b0.w, b1.x, b1.y, b1.z, b1.w}, lbb[8] = {c0.x, c0.y, c0.z, c0.w, c1.x, c1.y, c1.z, c1.w};
    float s = 0.f, bs = 0.f;
#pragma unroll
    for (int e = 0; e < 8; ++e) { s += y[e]; bs += r[e] * kp[e] * rkk[e]; }
    const float mean = sum8(s) * (1.f / 64.f); bs = sum8(bs);
    float q = 0.f;
#pragma unroll
    for (int e = 0; e < 8; ++e) { y[e] -= mean; q += y[e] * y[e]; }
    const float rstd = 1.0f / sqrtf(sum8(q) * (1.f / 64.f) + 64e-5f);
    float o[8];
#pragma unroll
    for (int e = 0; e < 8; ++e) o[e] = (y[e] * rstd * lgg[e] + lbb[e] + bs * v[e]) * g[e];
    *(GAS v4u*)(PROJ + (size_t)m * NIN + RW_OFF + ch) = pk8(o);
}
__device__ __forceinline__ void gmlp_unit(Frame& F, const In& I, int l, int b, int c, int h) {
    bf16* PROJ = (bf16*)(F.ws + WS_PROJ); const bf16* GW = (const bf16*)(F.ws + WS_GMW) + ((size_t)l * 8 + h) * 128 * 128;
    const int lane = F.lane, r32 = lane & 31, hi = lane >> 5;
    const size_t mrow0 = (size_t)b * SEQ + (size_t)c * 128;
    f32x16 acc[4][2];
#pragma unroll
    for (int i = 0; i < 4; ++i)
#pragma unroll
        for (int j = 0; j < 2; ++j)
#pragma unroll
            for (int r = 0; r < 16; ++r) acc[i][j][r] = 0.f;
    const bf16* Vp = PROJ + mrow0 * NIN + 512 + h * 64 + r32;
#pragma unroll
    for (int ks = 0; ks < 8; ++ks) {
        bf16x8 bf0, bf1_;
        const bf16* Vk = Vp + (size_t)(16 * ks + 8 * hi) * NIN; asm volatile("" : "+v"(Vk));
#pragma unroll
        for (int e = 0; e < 8; ++e) { const size_t ro = (size_t)e * NIN; bf0[e] = (short)*(const GAS bf16*)(Vk + ro); bf1_[e] = (short)*(const GAS bf16*)(Vk + ro + 32); }
#pragma unroll
        for (int i = 0; i < 4; ++i) if (ks <= 2 * i + 1) {
            const bf16x8 a = *(const GAS bf16x8*)(GW + (size_t)(32 * i + r32) * 128 + 16 * ks + 8 * hi);
            acc[i][0] = MFMA32(a, bf0, acc[i][0]); acc[i][1] = MFMA32(a, bf1_, acc[i][1]); }
        asm volatile("" ::: "memory");
    }
    const float* bs = I.p[7] + ((size_t)l * 8 + h) * 128;
#pragma unroll
    for (int i = 0; i < 4; ++i) {
        bf16* Ui = PROJ + (mrow0 + 32 * i + 4 * hi) * NIN + h * 64 + r32; asm volatile("" : "+v"(Ui));
        const float* bsi = bs + 32 * i + 4 * hi; asm volatile("" : "+v"(bsi));
#pragma unroll
        for (int r = 0; r < 16; ++r) { const int tl = (r & 3) + 8 * (r >> 2); const float bsv = bsi[tl];
            bf16* up = Ui + (size_t)tl * NIN;
            const float u0 = bf1(*(const GAS bf16*)up), u1 = bf1(*(const GAS bf16*)(up + 32));
            *(GAS bf16*)up = (bf16)f2bf(u0 * (acc[i][0][r] + bsv)); *(GAS bf16*)(up + 32) = (bf16)f2bf(u1 * (acc[i][1][r] + bsv));
            if ((r & 3) == 3) asm volatile("" ::: "memory"); }
    }
}
__device__ __forceinline__ void c4_phase(Frame& F, const In& I, int l) {
    for (int m = F.gw; m < M; m += F.ngw) rw_post_row(F, I, l, m);
    for (int u = F.gw; u < BATCH * 16 * 8; u += F.ngw) gmlp_unit(F, I, l, u >> 7, (u >> 3) & 15, u & 7);
}

__device__ __forceinline__ void router_row(Frame& F, const In& I, int m, const float* hbuf) {
    const int lane = F.lane;
    const GAS f32x4* xr = (const GAS f32x4*)(hbuf + (size_t)m * DM) + lane; const GAS f32x4* gr = (const GAS f32x4*)(I.p[23] + DM) + lane;
    const float* rw = I.p[27];
    float lg[8]; float s = 0.f;
#pragma unroll
    for (int e = 0; e < 8; ++e) lg[e] = 0.f;
    GAS v2u* o8 = (GAS v2u*)((bf16*)(F.ws + WS_XN) + (size_t)m * DM) + lane;
    f32x4 xv[8];
#pragma unroll
    for (int j = 0; j < 8; ++j) { const f32x4 x = xr[64 * j]; s += (x.x * x.x + x.y * x.y) + (x.z * x.z + x.w * x.w); xv[j] = x; }
    const float rstd = 1.0f / sqrtf(wave_sum(s) * (1.f / DM) + 1e-6f);
#pragma unroll
    for (int j = 0; j < 8; ++j) { const f32x4 g = gr[64 * j]; const float n[4] = {xv[j].x * rstd * g.x, xv[j].y * rstd * g.y, xv[j].z * rstd * g.z, xv[j].w * rstd * g.w};
        v2u o; o.x = pk2(n[0], n[1]); o.y = pk2(n[2], n[3]); o8[64 * j] = o;
        const int c0 = 4 * (lane + 64 * j);
#pragma unroll
        for (int q = 0; q < 4; ++q) { const f32x4 w0 = *(const GAS f32x4*)(rw + (size_t)(c0 + q) * 8), w1 = *(const GAS f32x4*)(rw + (size_t)(c0 + q) * 8 + 4);
            lg[0] += n[q] * w0.x; lg[1] += n[q] * w0.y; lg[2] += n[q] * w0.z; lg[3] += n[q] * w0.w; lg[4] += n[q] * w1.x; lg[5] += n[q] * w1.y; lg[6] += n[q] * w1.z; lg[7] += n[q] * w1.w; } }
#pragma unroll
    for (int e = 0; e < 8; ++e) lg[e] = wave_sum(lg[e]) + I.p[28][e];
    int e0 = 0; float v0 = lg[0];
#pragma unroll
    for (int e = 1; e < 8; ++e) if (lg[e] > v0) { v0 = lg[e]; e0 = e; }
    int e1 = -1; float v1 = -3.0e38f;
#pragma unroll
    for (int e = 0; e < 8; ++e) if (e != e0 && lg[e] > v1) { v1 = lg[e]; e1 = e; }
    const float p1 = 1.0f / (1.0f + __expf(v0 - v1)), p0 = 1.0f - p1;
    if (lane == 0) {
        unsigned* cnt = (unsigned*)(F.ws + WS_CTL) + CW_CNT;
        const unsigned s0 = __hip_atomic_fetch_add(cnt + e0, 1u, RLX_AGENT), s1 = __hip_atomic_fetch_add(cnt + e1, 1u, RLX_AGENT);
        int* tab = (int*)(F.ws + WS_TAB) + (size_t)m * 8;
        tab[0] = e0; tab[1] = e1; tab[2] = (int)s0; tab[3] = (int)s1; ((float*)tab)[4] = p0; ((float*)tab)[5] = p1;
    }
}
__device__ __forceinline__ void moe_offsets(Frame& F, int (&off)[8], int (&ts)[8], int& nrt) {
    const unsigned* cnt = (const unsigned*)(F.ws + WS_CTL) + CW_CNT; int acc = 0;
#pragma unroll
    for (int e = 0; e < 8; ++e) { const int c = (int)__builtin_amdgcn_readfirstlane((int)__hip_atomic_load(cnt + e, RLX_AGENT)); ts[e] = acc; off[e] = acc * 256; acc += (c + 255) >> 8; }
    nrt = acc;
}
__device__ __forceinline__ void gather_phase(Frame& F) {
    const unsigned* cnt = (const unsigned*)(F.ws + WS_CTL) + CW_CNT;
    const int cj = (F.lane < 8) ? (int)__hip_atomic_load(cnt + (F.lane & 7), RLX_AGENT) : 0;
    const int tiles = (cj + 255) >> 8; int incl = tiles;
#pragma unroll
    for (int d = 1; d < 8; d <<= 1) { const int t = __shfl_up(incl, d); if (F.lane >= d) incl += t; }
    const int offv = (incl - tiles) * 256;
    const bf16* XN = (const bf16*)(F.ws + WS_XN); bf16* XG = (bf16*)(F.ws + WS_XG);
    for (int m = F.gw; m < M; m += F.ngw) {
        int* tab = (int*)(F.ws + WS_TAB) + (size_t)m * 8;
        const int e0 = tab[0], e1 = tab[1], s0 = __shfl(offv, e0) + tab[2], s1 = __shfl(offv, e1) + tab[3];
        const GAS v4u* src = (const GAS v4u*)(XN + (size_t)m * DM) + F.lane; GAS v4u* d0 = (GAS v4u*)(XG + (size_t)s0 * DM) + F.lane; GAS v4u* d1 = (GAS v4u*)(XG + (size_t)s1 * DM) + F.lane;
#pragma unroll
        for (int j = 0; j < 4; ++j) { const v4u x = src[64 * j]; d0[64 * j] = x; d1[64 * j] = x; }
        if (F.lane == 0) { tab[6] = s0; tab[7] = s1; }
    }
}
__device__ __forceinline__ void final_row(Frame& F, const In& I, int m, float* hbuf) {
    const int lane = F.lane;
    const int* tab = (const int*)(F.ws + WS_TAB) + (size_t)m * 8;
    const float p0 = ((const float*)tab)[4], p1 = ((const float*)tab)[5]; const int s0 = tab[6], s1 = tab[7];
    const bf16* Y2 = (const bf16*)(F.ws + WS_Y2);
    GAS f32x4* xr = (GAS f32x4*)(hbuf + (size_t)m * DM) + lane; const GAS f32x4* gr = (const GAS f32x4*)I.p[32] + lane;
    const GAS v2u* ya = (const GAS v2u*)(Y2 + (size_t)s0 * DM) + lane; const GAS v2u* yb = (const GAS v2u*)(Y2 + (size_t)s1 * DM) + lane;
    f32x4 v[8]; float s = 0.f;
#pragma unroll
    for (int j = 0; j < 8; ++j) { f32x4 x = xr[64 * j]; const v2u a = ya[64 * j], b = yb[64 * j];
        x.x += p0 * bfl(a.x) + p1 * bfl(b.x); x.y += p0 * bfh(a.x) + p1 * bfh(b.x); x.z += p0 * bfl(a.y) + p1 * bfl(b.y); x.w += p0 * bfh(a.y) + p1 * bfh(b.y);
        v[j] = x; s += (x.x * x.x + x.y * x.y) + (x.z * x.z + x.w * x.w); }
    const float rstd = 1.0f / sqrtf(wave_sum(s) * (1.f / DM) + 1e-6f);
#pragma unroll
    for (int j = 0; j < 8; ++j) { const f32x4 g = gr[64 * j]; xr[64 * j] = (f32x4){v[j].x * rstd * g.x, v[j].y * rstd * g.y, v[j].z * rstd * g.z, v[j].w * rstd * g.w}; }
}
#ifndef RPT_MASK
#define RPT_MASK 0
#endif

#ifndef PH_MASK
#define PH_MASK 0xFFFFFF
#endif
#define PK(kind) (((PH_MASK) >> (kind)) & 1)
#define IN(k) (lo <= (k) && (k) < hi)
#ifdef PROBE_A0
#define STAMP(p) do { if (blockIdx.x == 0 && F.tid == 0) ((LAS unsigned long long*)(F.lds + LDSCTL_OFF + 600))[(p)] = __builtin_amdgcn_s_memrealtime(); } while (0)
#else
#define STAMP(p) do { } while (0)
#endif
#define SEAM(k) do { if (IN(k) && IN((k) + 1)) xcd_barrier(bar); STAMP((k) + 1); } while (0)
template <int l> __device__ __forceinline__ void layer_body(Frame& F, const In& I, unsigned char* ws, float* hout, const XcdBarrier& bar, int lo, int hi) {
    LAS unsigned char* ring = F.lds;
    bf16* const XN = (bf16*)(ws + WS_XN); bf16* const PROJ = (bf16*)(ws + WS_PROJ); bf16* const RWT = (bf16*)(ws + WS_RWT);
        const int base = 1 + 11 * l;
        const float* hin = (l == 0) ? I.p[0] : (const float*)hout;
        if (PK(1) && IN(base + 0)) {
            pg8::Gemm g{XN, (const bf16*)(ws + WS_WIN) + (size_t)l * NIN * 2048, 2048, 2048, 2048}; pg8::StaticOrder S; S.init(M, NIN, F.G, (int)blockIdx.x);
            pg8::EpiInProj E{PROJ, I.p[3] + l * 3 * DM};
            pg8::gemm_phase<pg8::EpiInProj, pg8::StaticOrder, PG8_ALIGN, PG8_SP2>(ring, g, S, E);
            if (RPT_MASK & 8) { xcd_barrier(bar); pg8::gemm_phase<pg8::EpiInProj, pg8::StaticOrder, PG8_ALIGN, PG8_SP2>(ring, g, S, E); }
        } SEAM(base + 0);
        if (PK(2) && IN(base + 1)) { c1_phase(F, I, l); if (RPT_MASK & 4) { xcd_barrier(bar); attn_dummy_phase(F); } } SEAM(base + 1);
        if (PK(3) && IN(base + 2)) {
            int kl = 256; asm volatile("" : "+s"(kl));
            pg8::Gemm g{RWT + RWT_LA, (const bf16*)(ws + WS_LORA) + (size_t)l * 1536 * 256, kl, 256, 256}; pg8::StaticOrder S; S.init(M, 1536, F.G, (int)blockIdx.x);
            pg8::EpiLora E{PROJ, RWT + RWT_KK, RWT + RWT_K, RWT + RWT_G, I.p[9] + l * 512, I.p[11] + l * 512, I.p[15] + l * 512};
            pg8::gemm_phase<pg8::EpiLora, pg8::StaticOrder, PG8_ALIGN, PG8_SP2>(ring, g, S, E);
        } SEAM(base + 2);
        if (PK(4) && IN(base + 3)) { scan_phase(F, I, l == 0 ? JOBS_PRO : JOBS_BG0, l == 0 ? JOBS_BG0 : NJOBS); } SEAM(base + 3);
        if (PK(5) && IN(base + 4)) { c4_phase(F, I, l); } SEAM(base + 4);
        if (PK(6) && IN(base + 5)) {
            pg8::Gemm g{PROJ, (const bf16*)(ws + WS_PC) + (size_t)l * 2048 * 2048, 512, NIN, 2048}; pg8::MergeOrder S; S.so.init(M, DM, F.G, (int)blockIdx.x);
            pg8::EpiMerge E{PROJ, XN};
            pg8::gemm_phase<pg8::EpiMerge, pg8::MergeOrder, PG8_ALIGN, PG8_SP2>(ring, g, S, E);
        } SEAM(base + 5);
        if (PK(7) && IN(base + 6)) {
            pg8::Gemm g{XN, (const bf16*)(ws + WS_WO) + (size_t)l * 2048 * 2048, 2048, 2048, 2048}; pg8::StaticOrder S; S.init(M, DM, F.G, (int)blockIdx.x);
            pg8::EpiResid E{hin, hout};
            pg8::gemm_phase<pg8::EpiResid, pg8::StaticOrder, PG8_ALIGN, PG8_SP2>(ring, g, S, E);
        } SEAM(base + 6);
        if (l == 0) {
            if (PK(8) && IN(base + 7)) { for (int m = F.gw; m < M; m += F.ngw) rms_row_to_bf16(hout + (size_t)m * DM, I.p[23], XN + (size_t)m * DM, F.lane); } SEAM(base + 7);
            if (PK(9) && IN(base + 8)) {
                pg8::Gemm g{XN, (const bf16*)(ws + WS_W13), 2048, 2048, 2048}; pg8::StaticOrder S; S.init(M, 2 * DFF, F.G, (int)blockIdx.x);
                pg8::EpiSwiGLU E{(bf16*)(ws + WS_H), DFF, 2 * DFF / 256};
                pg8::gemm_phase<pg8::EpiSwiGLU, pg8::StaticOrder, PG8_ALIGN, PG8_SP2>(ring, g, S, E);
                if (RPT_MASK & 16) { xcd_barrier(bar); pg8::gemm_phase<pg8::EpiSwiGLU, pg8::StaticOrder, PG8_ALIGN, PG8_SP2>(ring, g, S, E); }
            } SEAM(base + 8);
            if (PK(10) && IN(base + 9)) {
                pg8::Gemm g{(const bf16*)(ws + WS_H), (const bf16*)(ws + WS_W2), DFF, DFF, DFF}; pg8::StaticOrder S; S.init(M, DM, F.G, (int)blockIdx.x);
                pg8::EpiResid E{hout, hout};
                pg8::gemm_phase<pg8::EpiResid, pg8::StaticOrder, PG8_ALIGN, PG8_SP2>(ring, g, S, E);
            } SEAM(base + 9);
            if (PK(8) && IN(base + 10)) { for (int m = F.gw; m < M; m += F.ngw) rms_row_to_bf16(hout + (size_t)m * DM, I.p[1] + DM, XN + (size_t)m * DM, F.lane); } SEAM(base + 10);
        } else {
            if (PK(11) && IN(base + 7)) { for (int m = F.gw; m < M; m += F.ngw) router_row(F, I, m, hout); } SEAM(base + 7);
            if (PK(12) && IN(base + 8)) { gather_phase(F); } SEAM(base + 8);
            if (PK(13) && IN(base + 9)) {
                pg8::MoeOrder S; int off[8]; moe_offsets(F, off, S.ts, S.nrt); S.nt = 2 * DFE / 256; S.G = F.G; S.c = (int)blockIdx.x;
                pg8::Gemm g{(const bf16*)(ws + WS_XG), (const bf16*)(ws + WS_W13E), 2048, 2048, 2048};
                pg8::EpiSwiGLU E{(bf16*)(ws + WS_HX), DFE, 2 * DFE / 256};
                pg8::gemm_phase<pg8::EpiSwiGLU, pg8::MoeOrder, PG8_ALIGN, PG8_SP2>(ring, g, S, E);
                if (RPT_MASK & 32) { xcd_barrier(bar); pg8::gemm_phase<pg8::EpiSwiGLU, pg8::MoeOrder, PG8_ALIGN, PG8_SP2>(ring, g, S, E); }
            } SEAM(base + 9);
            if (PK(14) && IN(base + 10)) {
                pg8::MoeOrder S; int off[8]; moe_offsets(F, off, S.ts, S.nrt); S.nt = DM / 256; S.G = F.G; S.c = (int)blockIdx.x;
                pg8::Gemm g{(const bf16*)(ws + WS_HX), (const bf16*)(ws + WS_W2E), DFE, DFE, DFE};
                pg8::EpiPlain E{(bf16*)(ws + WS_Y2), DM, DM / 256};
                pg8::gemm_phase<pg8::EpiPlain, pg8::MoeOrder, PG8_ALIGN, PG8_SP2>(ring, g, S, E);
                if (RPT_MASK & 64) { xcd_barrier(bar); pg8::gemm_phase<pg8::EpiPlain, pg8::MoeOrder, PG8_ALIGN, PG8_SP2>(ring, g, S, E); }
            } SEAM(base + 10);
            if (PK(15) && IN(base + 11)) { for (int m = F.gw; m < M; m += F.ngw) final_row(F, I, m, hout); }
        }
    }
struct Args { In in; float* out; unsigned char* ws; int ph_lo, ph_hi; };
__global__ void __launch_bounds__(NWAVES * 64, 2) trunk_fwd(Args args) {
    extern __shared__ __attribute__((aligned(16))) unsigned char lds_raw[];
    Frame F;
    F.lds = (LAS unsigned char*)lds_raw; F.ws = args.ws; F.in = nullptr;
    F.tid = threadIdx.x; F.lane = F.tid & 63; F.wave = __builtin_amdgcn_readfirstlane(F.tid >> 6);
    F.G = gridDim.x; F.gw = blockIdx.x * NWAVES + F.wave; F.ngw = F.G * NWAVES;
    const In& I = args.in;
    unsigned char* ws = args.ws;
    for (int u = F.tid; u < (LDS_BYTES - LDSCTL_OFF) / 4; u += NWAVES * 64) ((LAS unsigned*)(F.lds + LDSCTL_OFF))[u] = 0u;
    __syncthreads();
    if (F.tid == 0) {
#pragma unroll
        for (int k = 0; k < 33; ++k) ((LAS unsigned long long*)(F.lds + LDSCTL_OFF + 256))[k] = (unsigned long long)I.p[k];
    }
    __syncthreads();
    const int lo = args.ph_lo, hi = args.ph_hi;
    XcdBarrier bar; bar.bar = (unsigned*)(ws + WS_CTL) + CW_BAR; bar.x = 0; bar.st = nullptr;
    if (hi - lo > 1) bar = xcd_barrier_post((unsigned*)(ws + WS_CTL) + CW_BAR, (volatile LAS unsigned*)(F.lds + LDSCTL_OFF) + 8);
    LAS unsigned char* ring = F.lds;
    bf16* const XN = (bf16*)(ws + WS_XN); bf16* const PROJ = (bf16*)(ws + WS_PROJ); bf16* const RWT = (bf16*)(ws + WS_RWT);
    float* const hout = args.out;

    STAMP(0);
    if (PK(0) && IN(0)) { p0_prologue(F, I); if (RPT_MASK & 1) { xcd_barrier(bar); p0_prologue(F, I); } } SEAM(0);

    layer_body<0>(F, I, ws, hout, bar, lo, hi);
    layer_body<1>(F, I, ws, hout, bar, lo, hi);
#ifdef PROBE_A0
    xcd_barrier(bar); STAMP(N_PHASES);
    if (blockIdx.x == 0) {
        const LAS unsigned long long* ts = (const LAS unsigned long long*)(F.lds + LDSCTL_OFF + 600);
        __syncthreads();
        const float x1 = (float)(ts[PROBE_A1 + 1] - ts[PROBE_A0]) * 0.01f, x2 = (float)(ts[PROBE_B1 + 1] - ts[PROBE_B0]) * 0.01f;
        if (F.tid == 0) hout[0] = x1;
        for (int i = F.tid; i < 100000; i += 512) hout[4096 + i] = x2 * 0.01f;
    }
#endif
#undef IN
#undef SEAM
}

#ifndef MK_SPLIT
#define MK_SPLIT 0
#endif
extern "C" void kernel_launch(void* const* d_in, const int* in_sizes, int n_in, void* d_out, int out_size, void* d_ws, size_t ws_size, hipStream_t stream) {
    static int grid = 0;
    if (grid == 0) {
        if (n_in != 33 || in_sizes[0] != M * DM || out_size != M * DM || ws_size < WS_END) { fprintf(stderr, "kernel_launch: unexpected shapes (n_in %d, ws %zu); nothing launched\n", n_in, ws_size); grid = -1; return; }
        int dev = 0, cus = 0, per_cu = 0;
        if (hipGetDevice(&dev) != hipSuccess || hipDeviceGetAttribute(&cus, hipDeviceAttributeMultiprocessorCount, dev) != hipSuccess) { grid = -1; return; }
        if (hipFuncSetAttribute((const void*)trunk_fwd, hipFuncAttributeMaxDynamicSharedMemorySize, LDS_BYTES) != hipSuccess) { fprintf(stderr, "kernel_launch: hipFuncSetAttribute failed\n"); grid = -1; return; }
        if (hipOccupancyMaxActiveBlocksPerMultiprocessor(&per_cu, (const void*)trunk_fwd, NWAVES * 64, LDS_BYTES) != hipSuccess || per_cu < 1) { fprintf(stderr, "kernel_launch: occupancy query says %d\n", per_cu); }
        (void)hipGetLastError();
        grid = cus;
    }
    if (grid < 0) return;
    if (hipMemsetAsync((char*)d_ws, 0, ZERO_BYTES, stream) != hipSuccess) return;
    Args a{};
    for (int i = 0; i < 33; ++i) a.in.p[i] = (const float*)d_in[i];
    a.out = (float*)d_out; a.ws = (unsigned char*)d_ws;
#if MK_SPLIT
    for (int p = 0; p < N_PHASES; ++p) { a.ph_lo = p; a.ph_hi = p + 1; hipLaunchKernelGGL(trunk_fwd, dim3(grid), dim3(NWAVES * 64), LDS_BYTES, stream, a); }
#else
    a.ph_lo = 0; a.ph_hi = N_PHASES;
    hipLaunchKernelGGL(trunk_fwd, dim3(grid), dim3(NWAVES * 64), LDS_BYTES, stream, a);
#endif
    const hipError_t le = hipPeekAtLastError();
    if (le != hipSuccess) fprintf(stderr, "kernel_launch: launch failed: %s\n", hipGetErrorName(le));
}
```

```cpp
#include <hip/hip_runtime.h>
#include <cstdio>
#include <cstdint>
namespace pg8 {
#define PG8_LAS __attribute__((address_space(3)))
typedef unsigned short bf16_t;
typedef short bf16x8 __attribute__((ext_vector_type(8)));
typedef float f32x4 __attribute__((ext_vector_type(4)));
typedef unsigned u32x4 __attribute__((ext_vector_type(4)));
typedef int i32x4 __attribute__((ext_vector_type(4)));
typedef int i32x8 __attribute__((ext_vector_type(8)));
constexpr int BM = 256, BK = 64, HALF = 128, HTB = HALF * BK * 2  , STAGE_BYTES = 8 * HTB, NXCD = 8, WGM = 8;

__host__ __device__ __forceinline__ int lds_byte(int r, int c) { const int st = (r >> 4) * 2 + (c >> 5), rr = r & 15, cc = c & 31, ob = rr * 64 + cc * 2; return st * 1024 + (ob ^ (((ob >> 9) & 1) << 5)); }
__host__ __device__ __forceinline__ void stage_rc(int b, int& R, int& C) { const int st = b / 1024, sb = b % 1024, swz = sb ^ (((sb >> 9) & 1) << 5); R = (st >> 1) * 16 + swz / 64; C = (st & 1) * 32 + (swz % 64) / 2; }
__host__ __device__ __forceinline__ int perm32(int rho) { const int n = rho >> 4, i = rho & 15; return 8 * (i >> 2) + 4 * n + (i & 3); }

struct Unit { int pm, pn, aoff, boff; };
struct Gemm { const bf16_t* A; const bf16_t* Bt; int K, lda, ldb; };

struct StaticOrder {
    int nM, nN, nwg, G, c;
    __host__ __device__ void init(int M, int N, int G_, int c_) { nM = M / BM; nN = N / BM; nwg = nM * nN; G = G_; c = c_; }
    __host__ __device__ bool next(int i, Unit& u) const {
        const long L = (long)i * G + c; if (L >= nwg) return false;
        int wgid = (int)L; { const int q = nwg / NXCD, r = nwg % NXCD, xcd = wgid % NXCD, off = wgid / NXCD; wgid = (xcd < r ? xcd * (q + 1) : r * (q + 1) + (xcd - r) * q) + off; }
        const int nig = WGM * nN, gid = wgid / nig, fm = gid * WGM, gsz = (nM - fm) < WGM ? (nM - fm) : WGM;
        u.pm = fm + ((wgid % nig) % gsz); u.pn = (wgid % nig) / gsz; u.aoff = 0; u.boff = 0; return true;
    }
    __device__ __forceinline__ void a_ready(const Unit&) const {}
    __device__ __forceinline__ void done(const Unit&) const {}
};

__device__ __forceinline__ unsigned cvt_pk_bf16(float lo, float hi) { unsigned r; asm volatile("v_cvt_pk_bf16_f32 %0, %1, %2" : "=v"(r) : "v"(lo), "v"(hi)); return r; }
typedef float f32x2 __attribute__((ext_vector_type(2)));
__device__ __forceinline__ f32x2 gelu_pk(f32x2 v) {
    const f32x2 av = __builtin_elementwise_abs(v), d = av * 0.2316418882f + 1.0f;
    f32x2 t; t.x = __builtin_amdgcn_rcpf(d.x); t.y = __builtin_amdgcn_rcpf(d.y);
    f32x2 q = t * 0.5307027145f + (-0.7265760135f); q = q * t + 0.7107068705f; q = q * t + (-0.142248368f); q = q * t + 0.127414796f; q = q * t;
    const f32x2 s = (v * v) * (-0.72134752044f);
    f32x2 e; e.x = __builtin_amdgcn_exp2f(s.x); e.y = __builtin_amdgcn_exp2f(s.y);
    const f32x2 m = v * (q * e), r = v - m;
    f32x2 o; o.x = v.x < 0.f ? m.x : r.x; o.y = v.y < 0.f ? m.y : r.y; return o;
}

template <int ACT  > struct EpiBf16 {
    static constexpr bool PERM = true, AFTER_DRAIN = false; static_assert(ACT == 0 || ACT == 1, "EpiBf16: ACT is 0 (none) or 1 (gelu_pk)");
    bf16_t* O; int ldc; const float* bias; int split_cols; size_t split_stride; float scale0;
    __device__ __forceinline__ void operator()(const f32x4 (&acc)[2][2][4][2], const Unit& u, int wr, int wc, int fr, int fq) const {
        const int row0 = u.pm * BM + wr * 64 + fr; int colt = u.pn * BM; bf16_t* base = O;
        float sc = 1.f; if (split_cols) { const int t = colt / split_cols; base += (size_t)t * split_stride; colt -= t * split_cols; if (t == 0) sc = scale0; }
        const int col0 = colt + wc * 32 + 8 * fq, bcol0 = u.pn * BM + wc * 32 + 8 * fq;
        f32x4 bv[2][2];
#pragma unroll
        for (int bj = 0; bj < 2; ++bj)
#pragma unroll
            for (int n = 0; n < 2; ++n) bv[bj][n] = bias ? *(const f32x4*)(bias + bcol0 + bj * HALF + 4 * n) : (f32x4){0.f, 0.f, 0.f, 0.f};
#pragma unroll
        for (int ai = 0; ai < 2; ++ai)
#pragma unroll
            for (int m = 0; m < 4; ++m) { bf16_t* rowp = base + (size_t)(row0 + ai * HALF + m * 16) * ldc + col0;
#pragma unroll
                for (int bj = 0; bj < 2; ++bj) { f32x4 v0 = acc[ai][bj][m][0] + bv[bj][0], v1 = acc[ai][bj][m][1] + bv[bj][1];
                    if (ACT == 1) { f32x2 a = gelu_pk((f32x2){v0[0], v0[1]}), b = gelu_pk((f32x2){v0[2], v0[3]}), c = gelu_pk((f32x2){v1[0], v1[1]}), d = gelu_pk((f32x2){v1[2], v1[3]});
                        v0 = (f32x4){a.x, a.y, b.x, b.y}; v1 = (f32x4){c.x, c.y, d.x, d.y}; }
                    v0 = v0 * sc; v1 = v1 * sc; u32x4 w; w.x = cvt_pk_bf16(v0[0], v0[1]); w.y = cvt_pk_bf16(v0[2], v0[3]); w.z = cvt_pk_bf16(v1[0], v1[1]); w.w = cvt_pk_bf16(v1[2], v1[3]);
                    *(u32x4*)(rowp + bj * HALF) = w; } }
    }
};

template <class Epi, class Sched, bool ALIGN_EPI = false, bool SP2 = false, bool FP8 = false>
__device__ __forceinline__ void gemm_phase(PG8_LAS unsigned char* lds, const Gemm g, const Sched& S, const Epi& E) {
    const int tid = threadIdx.x, wid = __builtin_amdgcn_readfirstlane(tid >> 6), lane = tid & 63, wr = wid >> 2, wc = wid & 3, fr = lane & 15, fq = lane >> 4;
    const int K = g.K, nt = K / BK;
    unsigned voffA[2], voffB[2];
#pragma unroll
    for (int i = 0; i < 2; ++i) { int R, C; stage_rc(tid * 16 + i * 8192, R, C); const int Rb = Epi::PERM ? ((R & ~31) + perm32(R & 31)) : R;
        voffA[i] = (unsigned)(R * g.lda + C) * 2u; voffB[i] = (unsigned)(Rb * g.ldb + C) * 2u; }
    const size_t kstep = (size_t)(BK * 2);
    const size_t hstepA = (size_t)HALF * g.lda * 2, hstepB = (size_t)HALF * g.ldb * 2;
    const size_t tstepA = 2 * hstepA, tstepB = 2 * hstepB;
    const unsigned ldsw = (unsigned)wid * 1024u;
    const int aoff = lds_byte(wr * 64 + fr, fq * 8), boff = lds_byte(wc * 32 + fr, fq * 8);
#define PG8_SA(b, h) (((b) * 2 + (h)) * HTB)
#define PG8_SB(b, h) ((4 + (b) * 2 + (h)) * HTB)
#define PG8_STAGE(bufoff, gbase, voff) do { _Pragma("unroll") for (int _i = 0; _i < 2; ++_i) \
        __builtin_amdgcn_global_load_lds((const unsigned*)((const char*)(gbase) + (voff)[_i]), (PG8_LAS unsigned*)(lds + (bufoff) + ldsw + _i * 8192), 16, 0, 0); } while (0)
#define PG8_CAT2(lo, hi) __builtin_shufflevector(__builtin_bit_cast(i32x4, lo), __builtin_bit_cast(i32x4, hi), 0, 1, 2, 3, 4, 5, 6, 7)
#define PG8_LDA(dst, b, h) do { _Pragma("unroll") for (int m = 0; m < 4; ++m) { const bf16x8 lo_ = *(const PG8_LAS bf16x8*)(lds + PG8_SA(b, h) + aoff + m * 2048), hi_ = *(const PG8_LAS bf16x8*)(lds + PG8_SA(b, h) + aoff + m * 2048 + 1024); \
        if constexpr (FP8) dst##8[m] = PG8_CAT2(lo_, hi_); else { dst[m][0] = lo_; dst[m][1] = hi_; } } } while (0)
#define PG8_LDB(dst, b, h) do { _Pragma("unroll") for (int n = 0; n < 2; ++n) { const bf16x8 lo_ = *(const PG8_LAS bf16x8*)(lds + PG8_SB(b, h) + boff + n * 2048), hi_ = *(const PG8_LAS bf16x8*)(lds + PG8_SB(b, h) + boff + n * 2048 + 1024); \
        if constexpr (FP8) dst##8[n] = PG8_CAT2(lo_, hi_); else { dst[n][0] = lo_; dst[n][1] = hi_; } } } while (0)
#define PG8_MMA(ai, bj, At, Bt) do { __builtin_amdgcn_s_setprio(1); \
        if constexpr (FP8) { _Pragma("unroll") for (int m = 0; m < 4; ++m) _Pragma("unroll") for (int n = 0; n < 2; ++n) \
            asm volatile("v_mfma_scale_f32_16x16x128_f8f6f4 %0, %1, %2, %0, %3, %3 op_sel_hi:[0,0,0]" : "+v"(acc[ai][bj][m][n]) : "v"(Bt##8[n]), "v"(At##8[m]), "v"(f8scale)); } \
        else { _Pragma("unroll") for (int m = 0; m < 4; ++m) _Pragma("unroll") for (int n = 0; n < 2; ++n) _Pragma("unroll") for (int k = 0; k < 2; ++k) \
            acc[ai][bj][m][n] = __builtin_amdgcn_mfma_f32_16x16x32_bf16(Bt[n][k], At[m][k], acc[ai][bj][m][n], 0, 0, 0); } \
        __builtin_amdgcn_s_setprio(0); } while (0)
#define PG8_WAIT_V(n) asm volatile("s_waitcnt vmcnt(" #n ")" ::: "memory")
#define PG8_WAIT_L(n) asm volatile("s_waitcnt lgkmcnt(" #n ")" ::: "memory")
#define PG8_BAR __builtin_amdgcn_s_barrier()
#define PG8_SCHED __builtin_amdgcn_sched_barrier(0)
    Unit cur, nxt; int ui = 0;
    if (!S.next(0, cur)) return;
    f32x4 acc[2][2][4][2];
#pragma unroll
    for (int a = 0; a < 2; ++a)
#pragma unroll
        for (int b = 0; b < 2; ++b)
#pragma unroll
            for (int m = 0; m < 4; ++m)
#pragma unroll
                for (int n = 0; n < 2; ++n) acc[a][b][m][n] = (f32x4){0.f, 0.f, 0.f, 0.f};
    bf16x8 At[4][2], B0[2][2], B1[2][2];
    i32x8 At8[4], B08[2], B18[2];
    int f8scale = 0x7f7f7f7f; asm volatile("" : "+v"(f8scale));
    const char* cA = (const char*)g.A + (size_t)cur.pm * tstepA + (size_t)cur.aoff * 2; const char* cB = (const char*)g.Bt + (size_t)cur.pn * tstepB + (size_t)cur.boff * 2;
    S.a_ready(cur);
    if constexpr (SP2) {
        PG8_STAGE(PG8_SB(0, 0), cB, voffB); PG8_STAGE(PG8_SB(0, 1), cB + hstepB, voffB); PG8_STAGE(PG8_SA(0, 0), cA, voffA); PG8_STAGE(PG8_SA(0, 1), cA + hstepA, voffA);
        if (wr == 1) PG8_BAR;
        PG8_WAIT_V(2); PG8_BAR;
        PG8_STAGE(PG8_SB(1, 0), cB + kstep, voffB); PG8_STAGE(PG8_SA(1, 0), cA + kstep, voffA); PG8_STAGE(PG8_SB(1, 1), cB + hstepB + kstep, voffB);
        PG8_WAIT_V(6); PG8_BAR;
    } else {
        PG8_STAGE(PG8_SB(0, 0), cB, voffB); PG8_STAGE(PG8_SA(0, 0), cA, voffA); PG8_STAGE(PG8_SB(0, 1), cB + hstepB, voffB); PG8_STAGE(PG8_SA(0, 1), cA + hstepA, voffA);
        if (wr == 1) PG8_BAR;
        PG8_WAIT_V(4); PG8_BAR;
        PG8_STAGE(PG8_SB(1, 0), cB + kstep, voffB); PG8_STAGE(PG8_SA(1, 0), cA + kstep, voffA); PG8_STAGE(PG8_SB(1, 1), cB + hstepB + kstep, voffB);
        PG8_WAIT_V(6); PG8_BAR;
    }
    for (;;) {
        const bool has_next = S.next(ui + 1, nxt);
        const char* nA = has_next ? (const char*)g.A + (size_t)nxt.pm * tstepA + (size_t)nxt.aoff * 2 : cA; const char* nB = has_next ? (const char*)g.Bt + (size_t)nxt.pn * tstepB + (size_t)nxt.boff * 2 : cB;
        for (int t = 0; t < nt; t += 2) {
            const bool last = (t == nt - 2);
            const char* a1 = cA + (size_t)(t + 1) * kstep;
            const char* a2 = last ? nA : cA + (size_t)(t + 2) * kstep; const char* b2 = last ? nB : cB + (size_t)(t + 2) * kstep;
            const char* a3 = a2 + kstep; const char* b3 = b2 + kstep;
            if (last && has_next) S.a_ready(nxt);
            if constexpr (SP2) {
            PG8_LDB(B0, 0, 0); PG8_LDB(B1, 0, 1); PG8_SCHED; PG8_LDA(At, 0, 0); PG8_STAGE(PG8_SA(1, 1), a1 + hstepA, voffA);
            PG8_WAIT_V(8); PG8_WAIT_L(0); PG8_BAR; PG8_MMA(0, 0, At, B0); PG8_MMA(0, 1, At, B1); PG8_BAR; PG8_SCHED;
            PG8_LDA(At, 0, 1); PG8_STAGE(PG8_SB(0, 0), b2, voffB); PG8_STAGE(PG8_SB(0, 1), b2 + hstepB, voffB); PG8_STAGE(PG8_SA(0, 0), a2, voffA);
            PG8_WAIT_V(8); PG8_WAIT_L(0); PG8_BAR; PG8_MMA(1, 0, At, B0); PG8_MMA(1, 1, At, B1); PG8_BAR; PG8_SCHED;
            PG8_LDB(B0, 1, 0); PG8_LDB(B1, 1, 1); PG8_SCHED; PG8_LDA(At, 1, 0); PG8_STAGE(PG8_SA(0, 1), a2 + hstepA, voffA);
            PG8_WAIT_V(8); PG8_WAIT_L(0); PG8_BAR; PG8_MMA(0, 0, At, B0); PG8_MMA(0, 1, At, B1); PG8_BAR; PG8_SCHED;
            PG8_LDA(At, 1, 1); PG8_STAGE(PG8_SB(1, 0), b3, voffB); PG8_STAGE(PG8_SB(1, 1), b3 + hstepB, voffB); PG8_STAGE(PG8_SA(1, 0), a3, voffA);
            PG8_WAIT_V(8); PG8_WAIT_L(0); PG8_BAR; PG8_MMA(1, 0, At, B0); PG8_MMA(1, 1, At, B1); PG8_BAR; PG8_SCHED;
            } else {
            PG8_LDB(B0, 0, 0); PG8_SCHED; PG8_LDA(At, 0, 0); PG8_STAGE(PG8_SA(1, 1), a1 + hstepA, voffA);
            PG8_WAIT_L(8); PG8_BAR; PG8_WAIT_L(0); PG8_MMA(0, 0, At, B0); PG8_BAR; PG8_SCHED;
            PG8_LDB(B1, 0, 1); PG8_STAGE(PG8_SB(0, 0), b2, voffB);
            PG8_BAR; PG8_WAIT_L(0); PG8_MMA(0, 1, At, B1); PG8_BAR;
            PG8_LDA(At, 0, 1); PG8_STAGE(PG8_SA(0, 0), a2, voffA);
            PG8_BAR; PG8_WAIT_L(0); PG8_MMA(1, 0, At, B0); PG8_BAR; PG8_SCHED;
            PG8_STAGE(PG8_SB(0, 1), b2 + hstepB, voffB);
            PG8_WAIT_V(6); PG8_BAR; PG8_MMA(1, 1, At, B1); PG8_BAR;
            PG8_LDB(B0, 1, 0); PG8_SCHED; PG8_LDA(At, 1, 0); PG8_STAGE(PG8_SA(0, 1), a2 + hstepA, voffA);
            PG8_WAIT_L(8); PG8_BAR; PG8_WAIT_L(0); PG8_MMA(0, 0, At, B0); PG8_BAR; PG8_SCHED;
            PG8_LDB(B1, 1, 1); PG8_STAGE(PG8_SB(1, 0), b3, voffB);
            PG8_BAR; PG8_WAIT_L(0); PG8_MMA(0, 1, At, B1); PG8_BAR;
            PG8_LDA(At, 1, 1); PG8_STAGE(PG8_SA(1, 0), a3, voffA);
            PG8_BAR; PG8_WAIT_L(0); PG8_MMA(1, 0, At, B0); PG8_BAR; PG8_SCHED;
            PG8_STAGE(PG8_SB(1, 1), b3 + hstepB, voffB);
            PG8_WAIT_V(6); PG8_BAR; PG8_MMA(1, 1, At, B1); PG8_BAR;
            }
        }
        if constexpr (FP8) asm volatile("s_nop 15\n\ts_nop 15" ::: "memory");
        if constexpr (ALIGN_EPI) { if (wr == 0) PG8_BAR; }
        if constexpr (!Epi::AFTER_DRAIN) { E(acc, cur, wr, wc, fr, fq); S.done(cur); }
        if (!has_next) break;
#pragma unroll
        for (int a = 0; a < 2; ++a)
#pragma unroll
            for (int b = 0; b < 2; ++b)
#pragma unroll
                for (int m = 0; m < 4; ++m)
#pragma unroll
                    for (int n = 0; n < 2; ++n) acc[a][b][m][n] = (f32x4){0.f, 0.f, 0.f, 0.f};
        cur = nxt; cA = nA; cB = nB; ++ui;
        if constexpr (ALIGN_EPI) { if (wr == 1) PG8_BAR; }
    }
    PG8_WAIT_V(0);
    if constexpr (!ALIGN_EPI) { if (wr == 0) PG8_BAR; }
    PG8_BAR;
    if constexpr (Epi::AFTER_DRAIN) { E.fused(acc, cur, wr, wc, fr, fq, lds, wid, lane); S.done(cur); }
#undef PG8_SA
#undef PG8_SB
#undef PG8_STAGE
#undef PG8_LDA
#undef PG8_LDB
#undef PG8_MMA
#undef PG8_CAT2
#undef PG8_WAIT_V
#undef PG8_WAIT_L
#undef PG8_BAR
#undef PG8_SCHED
}
}
namespace pg8 {
__device__ __forceinline__ float fsigmoid(float x) { return __builtin_amdgcn_rcpf(1.0f + __builtin_amdgcn_exp2f(-1.4426950408889634f * x)); }
__device__ __forceinline__ float gelu_tanh(float x) { const float y = 1.5957691216057308f * (x + 0.044715f * x * x * x); return x * fsigmoid(y); }
__device__ __forceinline__ float bf_lo(unsigned w) { return __uint_as_float(w << 16); }
__device__ __forceinline__ float bf_hi(unsigned w) { return __uint_as_float(w & 0xffff0000u); }
__device__ __forceinline__ u32x4 pack8(const f32x4 v0, const f32x4 v1) { u32x4 w; w.x = cvt_pk_bf16(v0[0], v0[1]); w.y = cvt_pk_bf16(v0[2], v0[3]); w.z = cvt_pk_bf16(v1[0], v1[1]); w.w = cvt_pk_bf16(v1[2], v1[3]); return w; }
__device__ __forceinline__ void unpack8(const u32x4 w, f32x4& v0, f32x4& v1) { v0 = (f32x4){bf_lo(w.x), bf_hi(w.x), bf_lo(w.y), bf_hi(w.y)}; v1 = (f32x4){bf_lo(w.z), bf_hi(w.z), bf_lo(w.w), bf_hi(w.w)}; }

typedef unsigned u32x2 __attribute__((ext_vector_type(2)));
__device__ __forceinline__ float clamp448(float x) { return __builtin_fminf(__builtin_fmaxf(x, -448.0f), 448.0f); }
__device__ __forceinline__ unsigned pk4_fp8(float a, float b, float c, float d) {
    int w = 0; w = __builtin_amdgcn_cvt_pk_fp8_f32(clamp448(a), clamp448(b), w, false); w = __builtin_amdgcn_cvt_pk_fp8_f32(clamp448(c), clamp448(d), w, true); return (unsigned)w; }
constexpr float F8_SW = 256.0f, F8_SX = 16.0f, F8_SH = 8.0f;

struct EpiInProj {
    static constexpr bool PERM = true, AFTER_DRAIN = false;
    bf16_t* O; const float* gate_b;
    __device__ __forceinline__ void operator()(const f32x4 (&acc)[2][2][4][2], const Unit& u, int wr, int wc, int fr, int fq) const {
        asm volatile("" : "+v"(fr), "+v"(fq));
        const int row0 = u.pm * BM + wr * 64 + fr, col0 = u.pn * BM + wc * 32 + 8 * fq;
        const int mode = u.pn < 4 ? 1 : (u.pn >= 23 ? 2 : 0);
        f32x4 bv[2][2];
#pragma unroll
        for (int bj = 0; bj < 2; ++bj)
#pragma unroll
            for (int n = 0; n < 2; ++n) bv[bj][n] = (mode == 2) ? *(const f32x4*)(gate_b + (col0 - 5888) + bj * HALF + 4 * n) : (f32x4){0.f, 0.f, 0.f, 0.f};
#pragma unroll
        for (int ai = 0; ai < 2; ++ai)
#pragma unroll
            for (int m = 0; m < 4; ++m) { bf16_t* rowp = O + (size_t)(row0 + ai * HALF + m * 16) * 12032 + col0;
#pragma unroll
                for (int bj = 0; bj < 2; ++bj) { f32x4 v0 = acc[ai][bj][m][0] + bv[bj][0], v1 = acc[ai][bj][m][1] + bv[bj][1];
                    if (mode == 1) {
#pragma unroll
                        for (int e = 0; e < 4; ++e) { v0[e] = gelu_tanh(v0[e]); v1[e] = gelu_tanh(v1[e]); } }
                    else if (mode == 2) {
#pragma unroll
                        for (int e = 0; e < 4; ++e) { v0[e] = fsigmoid(v0[e]); v1[e] = fsigmoid(v1[e]); } }
                    *(u32x4*)(rowp + bj * HALF) = pack8(v0, v1); } }
    }
};

struct EpiLora {
    static constexpr bool PERM = true, AFTER_DRAIN = false;
    bf16_t* PROJ; const bf16_t* KK; const bf16_t* RSK; bf16_t* G; const float* w0; const float* a0; const float* ka;
    __device__ __forceinline__ void operator()(const f32x4 (&acc)[2][2][4][2], const Unit& u, int wr, int wc, int fr, int fq) const {
        asm volatile("" : "+v"(fr), "+v"(fq));
        const int row0 = u.pm * BM + wr * 64 + fr, ch0 = (u.pn & 1) * BM + wc * 32 + 8 * fq, kind = u.pn >> 1;
        if (kind == 0) {
#pragma unroll
            for (int bj = 0; bj < 2; ++bj) { const int ch = ch0 + bj * HALF; const f32x4 b0 = *(const f32x4*)(w0 + ch), b1 = *(const f32x4*)(w0 + ch + 4);
#pragma unroll
                for (int ai = 0; ai < 2; ++ai)
#pragma unroll
                    for (int m = 0; m < 4; ++m) { const size_t row = (size_t)(row0 + ai * HALF + m * 16);
                        f32x4 v0 = acc[ai][bj][m][0] + b0, v1 = acc[ai][bj][m][1] + b1;
#pragma unroll
                        for (int e = 0; e < 4; ++e) { v0[e] = -0.6065306597126334f * fsigmoid(v0[e]); v1[e] = -0.6065306597126334f * fsigmoid(v1[e]); }
                        *(u32x4*)(PROJ + row * 12032 + 3840 + ch) = pack8(v0, v1); } }
        } else if (kind == 1) {
            f32x4 b0[2], b1[2], c0[2], c1[2];
#pragma unroll
            for (int bj = 0; bj < 2; ++bj) { const int ch = ch0 + bj * HALF; b0[bj] = *(const f32x4*)(a0 + ch); b1[bj] = *(const f32x4*)(a0 + ch + 4); c0[bj] = *(const f32x4*)(ka + ch); c1[bj] = *(const f32x4*)(ka + ch + 4); }
#pragma unroll
            for (int ai = 0; ai < 2; ++ai)
#pragma unroll
                for (int m = 0; m < 4; ++m) { size_t row = (size_t)(row0 + ai * HALF + m * 16); asm volatile("" : "+v"(row));
                    const bf16_t* kr = RSK + row * 512 + ch0; const bf16_t* qr = KK + row * 512 + ch0; bf16_t* pr = PROJ + row * 12032 + ch0;
#pragma unroll
                    for (int bj = 0; bj < 2; ++bj) {
                        const u32x4 kw = *(const u32x4*)(kr + bj * HALF), qw = *(const u32x4*)(qr + bj * HALF);
                        f32x4 k0, k1, q0, q1; unpack8(kw, k0, k1); unpack8(qw, q0, q1);
                        f32x4 p0, p1;
#pragma unroll
                        for (int e = 0; e < 4; ++e) { const float a_0 = fsigmoid(acc[ai][bj][m][0][e] + b0[bj][e]), a_1 = fsigmoid(acc[ai][bj][m][1][e] + b1[bj][e]);
                            p0[e] = k0[e] * (1.0f + (a_0 - 1.0f) * c0[bj][e]); p1[e] = k1[e] * (1.0f + (a_1 - 1.0f) * c1[bj][e]); q0[e] *= a_0; q1[e] *= a_1; }
                        *(u32x4*)(pr + 4352 + bj * HALF) = pack8(q0, q1);
                        *(u32x4*)(pr + 4864 + bj * HALF) = pack8(p0, p1); }
                    asm volatile("" ::: "memory"); }
        } else {
#pragma unroll
            for (int bj = 0; bj < 2; ++bj) { const int ch = ch0 + bj * HALF;
#pragma unroll
                for (int ai = 0; ai < 2; ++ai)
#pragma unroll
                    for (int m = 0; m < 4; ++m) { const size_t row = (size_t)(row0 + ai * HALF + m * 16); *(u32x4*)(G + row * 512 + ch) = pack8(acc[ai][bj][m][0], acc[ai][bj][m][1]); } }
        }
    }
};

struct EpiMerge {
    static constexpr bool PERM = true, AFTER_DRAIN = false;
    const bf16_t* PROJ; bf16_t* MG;
    __device__ __forceinline__ void operator()(const f32x4 (&acc)[2][2][4][2], const Unit& u, int wr, int wc, int fr, int fq) const {
        asm volatile("" : "+v"(fr), "+v"(fq));
        const int row0 = u.pm * BM + wr * 64 + fr, col0 = u.pn * BM + wc * 32 + 8 * fq, ks = u.boff >> 9, gi = ks > 2 ? 2 : ks;
#pragma unroll
        for (int ai = 0; ai < 2; ++ai)
#pragma unroll
            for (int m = 0; m < 4; ++m) { const size_t row = (size_t)(row0 + ai * HALF + m * 16);
#pragma unroll
                for (int bj = 0; bj < 2; ++bj) { const int col = col0 + bj * HALF;
                    f32x4 g0, g1, p0 = (f32x4){0.f, 0.f, 0.f, 0.f}, p1 = p0;
                    unpack8(*(const u32x4*)(PROJ + row * 12032 + 5888 + gi * 2048 + col), g0, g1);
                    if (ks != 0) unpack8(*(const u32x4*)(MG + row * 2048 + col), p0, p1);
                    p0 = p0 + g0 * acc[ai][bj][m][0]; p1 = p1 + g1 * acc[ai][bj][m][1];
                    *(u32x4*)(MG + row * 2048 + col) = pack8(p0, p1); } }
    }
};

struct EpiResid {
    static constexpr bool PERM = false, AFTER_DRAIN = false;
    const float* hin; float* out;
    __device__ __forceinline__ void operator()(const f32x4 (&acc)[2][2][4][2], const Unit& u, int wr, int wc, int fr, int fq) const {
        asm volatile("" : "+v"(fr), "+v"(fq));
        const int row0 = u.pm * BM + wr * 64 + fr, col0 = u.pn * BM + wc * 32 + 4 * fq;
#pragma unroll
        for (int ai = 0; ai < 2; ++ai)
#pragma unroll
            for (int m = 0; m < 4; ++m) { const size_t off = (size_t)(row0 + ai * HALF + m * 16) * 2048 + col0;
#pragma unroll
                for (int bj = 0; bj < 2; ++bj)
#pragma unroll
                    for (int n = 0; n < 2; ++n) { const f32x4 bs = *(const f32x4*)(hin + off + bj * HALF + n * 16); *(f32x4*)(out + off + bj * HALF + n * 16) = bs + acc[ai][bj][m][n]; } }
    }
};

struct EpiSwiGLU {
    static constexpr bool PERM = true, AFTER_DRAIN = false;
    bf16_t* O; int ldc, nt;
    __device__ __forceinline__ void operator()(const f32x4 (&acc)[2][2][4][2], const Unit& u, int wr, int wc, int fr, int fq) const {
        asm volatile("" : "+v"(fr), "+v"(fq));
        const int row0 = u.pm * BM + wr * 64 + fr, col0 = (u.pn % nt) * HALF + wc * 32 + 8 * fq;
#pragma unroll
        for (int ai = 0; ai < 2; ++ai)
#pragma unroll
            for (int m = 0; m < 4; ++m) { bf16_t* rowp = O + (size_t)(row0 + ai * HALF + m * 16) * ldc + col0;
                f32x4 v0, v1;
#pragma unroll
                for (int e = 0; e < 4; ++e) { const float a_0 = acc[ai][0][m][0][e], a_1 = acc[ai][0][m][1][e];
                    v0[e] = a_0 * fsigmoid(a_0) * acc[ai][1][m][0][e]; v1[e] = a_1 * fsigmoid(a_1) * acc[ai][1][m][1][e]; }
                *(u32x4*)rowp = pack8(v0, v1); }
    }
};

struct EpiSwiGLU8 {
    static constexpr bool PERM = true, AFTER_DRAIN = false;
    unsigned char* O; int ldc, nt; float inv_sin;
    __device__ __forceinline__ void operator()(const f32x4 (&acc)[2][2][4][2], const Unit& u, int wr, int wc, int fr, int fq) const {
        asm volatile("" : "+v"(fr), "+v"(fq));
        const int row0 = u.pm * BM + wr * 64 + fr, col0 = (u.pn % nt) * HALF + wc * 32 + 8 * fq;
#pragma unroll
        for (int ai = 0; ai < 2; ++ai)
#pragma unroll
            for (int m = 0; m < 4; ++m) { unsigned char* rowp = O + (size_t)(row0 + ai * HALF + m * 16) * ldc + col0;
                f32x4 v0, v1;
#pragma unroll
                for (int e = 0; e < 4; ++e) { const float a_0 = acc[ai][0][m][0][e] * inv_sin, a_1 = acc[ai][0][m][1][e] * inv_sin;
                    v0[e] = a_0 * fsigmoid(a_0) * (acc[ai][1][m][0][e] * inv_sin) * F8_SH; v1[e] = a_1 * fsigmoid(a_1) * (acc[ai][1][m][1][e] * inv_sin) * F8_SH; }
                u32x2 w; w.x = pk4_fp8(v0[0], v0[1], v0[2], v0[3]); w.y = pk4_fp8(v1[0], v1[1], v1[2], v1[3]);
                *(u32x2*)rowp = w; }
    }
};

struct EpiPlain {
    static constexpr bool PERM = true, AFTER_DRAIN = false;
    bf16_t* O; int ldc, nt; float scale;
    __device__ __forceinline__ void operator()(const f32x4 (&acc)[2][2][4][2], const Unit& u, int wr, int wc, int fr, int fq) const {
        asm volatile("" : "+v"(fr), "+v"(fq));
        const int row0 = u.pm * BM + wr * 64 + fr, col0 = (u.pn % nt) * BM + wc * 32 + 8 * fq;
#pragma unroll
        for (int ai = 0; ai < 2; ++ai)
#pragma unroll
            for (int m = 0; m < 4; ++m) { bf16_t* rowp = O + (size_t)(row0 + ai * HALF + m * 16) * ldc + col0;
#pragma unroll
                for (int bj = 0; bj < 2; ++bj) *(u32x4*)(rowp + bj * HALF) = pack8(acc[ai][bj][m][0] * scale, acc[ai][bj][m][1] * scale); }
    }
};

struct MergeOrder {
    StaticOrder so;
    __device__ __forceinline__ bool next(int i, Unit& u) const {
        if (!so.next(i >> 2, u)) return false;
        const int ks = i & 3; u.boff = ks * 512; u.aoff = ks == 0 ? 0 : (ks == 1 ? 1024 : (ks == 2 ? 2816 : 3328)); return true;
    }
    __device__ __forceinline__ void a_ready(const Unit&) const {}
    __device__ __forceinline__ void done(const Unit&) const {}
};

struct MoeOrder {
    int ts[8]; int nrt, nt, G, c;
    __device__ __forceinline__ bool next(int i, Unit& u) const {
        const long L = (long)i * G + c; if (L >= (long)nrt * nt) return false;
        const int rt = (int)(L / nt), pnl = (int)(L % nt); int e = 0;
#pragma unroll
        for (int j = 1; j < 8; ++j) e += (rt >= ts[j]) ? 1 : 0;
        u.pm = rt; u.pn = e * nt + pnl; u.aoff = 0; u.boff = 0; return true;
    }
    __device__ __forceinline__ void a_ready(const Unit&) const {}
    __device__ __forceinline__ void done(const Unit&) const {}
};
}

#ifndef PG8_SP2
#define PG8_SP2 true
#endif
#ifndef PG8_ALIGN
#define PG8_ALIGN true
#endif
constexpr int NWAVES = 8;
constexpr int BATCH = 8, SEQ = 2048, DM = 2048, M = BATCH * SEQ;
constexpr int NIN = 12032, GM_OFF = 0, RW_OFF = 1024, SB_OFF = 2816, GATE_OFF = 5888;
constexpr int C_LW = 3840, C_KKA = 4352, C_KP = 4864;
constexpr int YRAW_BYTE = 3072;
constexpr int DFF = 5632, DFE = 2816, NEXP = 8;
constexpr int XG_ROWS = 2 * M + NEXP * 256;
constexpr int N_PHASES = 24;
constexpr size_t MiB = 1u << 20;
constexpr size_t WS_CTL = 0, WS_LORA = 1 * MiB, ZERO_BYTES = 3 * MiB;
constexpr size_t WS_TAB = 3 * MiB, WS_GMW = 4 * MiB;
constexpr size_t WS_WIN = 5 * MiB, WS_PC = 99 * MiB, WS_WO = 115 * MiB, WS_W13 = 131 * MiB, WS_W2 = 175 * MiB, WS_W13E = 197 * MiB, WS_W2E = 373 * MiB;
constexpr size_t WS_XN = 461 * MiB, WS_PROJ = 525 * MiB, WS_RWT = 901 * MiB, WS_END = 989 * MiB;
constexpr size_t WS_H = WS_PROJ;
constexpr size_t WS_XG = 525 * MiB, WS_HX = 661 * MiB, WS_Y2 = 848 * MiB;
static_assert(WS_Y2 + (size_t)XG_ROWS * DM * 2 <= WS_END && WS_HX + (size_t)XG_ROWS * DFE * 2 <= WS_Y2 && WS_XG + (size_t)XG_ROWS * DM * 2 <= WS_HX, "moe overlay");
static_assert(WS_PROJ + (size_t)M * NIN * 2 <= WS_RWT && WS_H + (size_t)M * DFF * 2 <= WS_RWT && WS_RWT + (size_t)M * (5 * 512 + 256) * 2 <= WS_END, "ws map");
constexpr size_t RWT_R = 0, RWT_K = (size_t)M * 512, RWT_V = 2 * (size_t)M * 512, RWT_KK = 3 * (size_t)M * 512, RWT_G = 4 * (size_t)M * 512, RWT_LA = 5 * (size_t)M * 512;
constexpr int CW_BAR = 4096, CW_CNT = 1024;
constexpr int LDS_BYTES = 147456, LDSCTL_OFF = LDS_BYTES - 1024;

#define GAS __attribute__((address_space(1)))
#define LAS __attribute__((address_space(3)))
typedef unsigned short bf16;
typedef unsigned v4u __attribute__((ext_vector_type(4)));
typedef unsigned v2u __attribute__((ext_vector_type(2)));
typedef float f32x4 __attribute__((ext_vector_type(4)));
typedef float f32x16 __attribute__((ext_vector_type(16)));
typedef short bf16x8 __attribute__((ext_vector_type(8)));
typedef GAS unsigned gu32;
#define RLX_AGENT __ATOMIC_RELAXED, __HIP_MEMORY_SCOPE_AGENT
#define LDS_WAIT() asm volatile("s_waitcnt lgkmcnt(0)" ::: "memory")
#define VM_WAIT() asm volatile("s_waitcnt vmcnt(0)" ::: "memory")
__device__ __forceinline__ unsigned f2bf(float f) { unsigned u = __builtin_bit_cast(unsigned, f); return (u + 0x7fffu + ((u >> 16) & 1u)) >> 16; }
typedef float f32x2_t __attribute__((ext_vector_type(2))); typedef __bf16 bf16x2_t __attribute__((ext_vector_type(2)));
__device__ __forceinline__ unsigned pk2(float lo, float hi) { f32x2_t v = {lo, hi}; bf16x2_t b = __builtin_convertvector(v, bf16x2_t); return __builtin_bit_cast(unsigned, b); }
__device__ __forceinline__ float bfl(unsigned w) { return __uint_as_float(w << 16); }
__device__ __forceinline__ float bfh(unsigned w) { return __uint_as_float(w & 0xffff0000u); }
__device__ __forceinline__ float bf1(bf16 h) { return __uint_as_float((unsigned)h << 16); }
__device__ __forceinline__ float fsig(float x) { return __builtin_amdgcn_rcpf(1.0f + __builtin_amdgcn_exp2f(-1.4426950408889634f * x)); }
__device__ __forceinline__ void unpk8(const v4u w, float (&v)[8]) { v[0] = bfl(w.x); v[1] = bfh(w.x); v[2] = bfl(w.y); v[3] = bfh(w.y); v[4] = bfl(w.z); v[5] = bfh(w.z); v[6] = bfl(w.w); v[7] = bfh(w.w); }
__device__ __forceinline__ v4u pk8(const float (&v)[8]) { v4u w; w.x = pk2(v[0], v[1]); w.y = pk2(v[2], v[3]); w.z = pk2(v[4], v[5]); w.w = pk2(v[6], v[7]); return w; }

#define XB_TMO      128
#define XB_XCNT(j)  (256  + 64 * (j))
#define XB_XSUB(j)  (1280 + 64 * (j))
#define XB_XGEN(j)  (2304 + 64 * (j))
#define XB_TOP      3328
#define XB_TOPGEN   3392
#define XCD_BAR_WORDS 3456
#define XB_SPIN_CAP (1u << 18)
__device__ __forceinline__ unsigned xb_ld(unsigned* p)              { return __hip_atomic_load(p, __ATOMIC_RELAXED, __HIP_MEMORY_SCOPE_AGENT); }
__device__ __forceinline__ unsigned xb_add(unsigned* p, unsigned v) { return __hip_atomic_fetch_add(p, v, __ATOMIC_RELAXED, __HIP_MEMORY_SCOPE_AGENT); }
__device__ __forceinline__ unsigned xb_xcc_id() { return (unsigned)__builtin_amdgcn_s_getreg((3 << 11) | 20) & 0xFu; }
#define XB_SPIN(cond, bar) do { unsigned _sp = 0; while (cond) { __builtin_amdgcn_s_sleep(1); \
    if ((++_sp & 255u) == 0u) { if (xb_ld(&(bar)[XB_TMO])) break; if (_sp > XB_SPIN_CAP) { atomicAdd(&(bar)[XB_TMO], 1u); break; } } } } while (0)
struct XcdBarrier { unsigned* bar; unsigned x; volatile LAS unsigned* st; };
__device__ __forceinline__ XcdBarrier xcd_barrier_post(unsigned* bar, volatile LAS unsigned* st) {
    XcdBarrier b; b.bar = bar; b.x = xb_xcc_id(); b.st = st;
    if (threadIdx.x == 0) (void)xb_add(&bar[XB_XCNT(b.x)], 1u);
    return b;
}
__device__ __forceinline__ void xcd_barrier_complete(unsigned* bar, unsigned x, unsigned& nloc, unsigned& nx) {
    const unsigned G = gridDim.x * gridDim.y * gridDim.z;
    unsigned sum, cnt, mine, sp = 0u;
    for (;;) {
        sum = 0u; cnt = 0u; mine = 0u;
#pragma unroll
        for (unsigned j = 0; j < 16; ++j) { const unsigned c = xb_ld(&bar[XB_XCNT(j)]); sum += c; cnt += (c > 0u) ? 1u : 0u; mine = (j == x) ? c : mine; }
        if (sum == G) break;
        __builtin_amdgcn_s_sleep(1);
        if ((++sp & 255u) == 0u) { if (xb_ld(&bar[XB_TMO])) break; if (sp > XB_SPIN_CAP) { atomicAdd(&bar[XB_TMO], 1u); break; } }
    }
    nloc = mine > 0u ? mine : 1u; nx = cnt > 0u ? cnt : 1u;
}
__device__ __forceinline__ void xcd_barrier(const XcdBarrier& b) {
    asm volatile("s_waitcnt vmcnt(0)" ::: "memory");
    __syncthreads();
    if (threadIdx.x == 0) {
        unsigned* bar = b.bar;
        __builtin_amdgcn_s_waitcnt(0);
        unsigned nloc = b.st[0], nx = b.st[1];
        if (nloc == 0u) { xcd_barrier_complete(bar, b.x, nloc, nx); b.st[0] = nloc; b.st[1] = nx; }
        const unsigned old = xb_add(&bar[XB_XSUB(b.x)], 1u);
        const unsigned gen = old / nloc;
        if (old + 1u == (gen + 1u) * nloc) {
            __builtin_amdgcn_fence(__ATOMIC_RELEASE, "agent");
            asm volatile("s_waitcnt vmcnt(0)" ::: "memory");
            const unsigned og = xb_add(&bar[XB_TOP], 1u);
            const unsigned tg = og / nx;
            if (og + 1u == (tg + 1u) * nx) xb_add(&bar[XB_TOPGEN], 1u);
            else XB_SPIN(xb_ld(&bar[XB_TOPGEN]) == tg, bar);
            __builtin_amdgcn_fence(__ATOMIC_ACQUIRE, "agent");
            xb_add(&bar[XB_XGEN(b.x)], 1u);
            asm volatile("s_waitcnt vmcnt(0)" ::: "memory");
        } else {
            XB_SPIN(xb_ld(&bar[XB_XGEN(b.x)]) == gen, bar);
            __builtin_amdgcn_fence(__ATOMIC_ACQUIRE, "agent");
            asm volatile("s_waitcnt vmcnt(0)" ::: "memory");
        }
    }
    __syncthreads();
}

struct Frame {
    LAS unsigned char* lds;
    unsigned char* ws;
    const float* const* in;
    int tid, lane, wave, G, gw, ngw;
};
__device__ __forceinline__ float wave_sum(float v) {
#pragma unroll
    for (int o = 1; o < 64; o <<= 1) v += __shfl_xor(v, o);
    return v;
}
__device__ __forceinline__ float sum8(float v) { v += __shfl_xor(v, 1); v += __shfl_xor(v, 2); v += __shfl_xor(v, 4); return v; }

__device__ __forceinline__ void tr_item(const float* W, int N, bf16* WT, int ldo, int koff, int rowbase, int mode, float sc, LAS float* scr, int k0, int n0, int lane) {
    const int lq = lane & 15, lr = lane >> 4;
#pragma unroll 4
    for (int i = 0; i < 16; ++i) { const int kk = 4 * i + lr; const f32x4 v = *(const GAS f32x4*)(W + (size_t)(k0 + kk) * N + n0 + 4 * lq);
        LAS float* s = scr + kk * 65 + 4 * lq; s[0] = v.x * sc; s[1] = v.y * sc; s[2] = v.z * sc; s[3] = v.w * sc; }
    LDS_WAIT(); asm volatile("" ::: "memory");
    const int c = lane & 7, ns = lane >> 3;
#pragma unroll
    for (int j = 0; j < 8; ++j) { const int n = n0 + ns + 8 * j; const int row = rowbase + (mode ? ((n >> 7) * 256 + (n & 127) + (mode == 2 ? 128 : 0)) : n);
        const LAS float* s = scr + (8 * c) * 65 + ns + 8 * j;
        v4u o; o.x = pk2(s[0 * 65], s[1 * 65]); o.y = pk2(s[2 * 65], s[3 * 65]); o.z = pk2(s[4 * 65], s[5 * 65]); o.w = pk2(s[6 * 65], s[7 * 65]);
        *(GAS v4u*)(WT + (size_t)row * ldo + koff + k0 + 8 * c) = o; }
    LDS_WAIT(); asm volatile("" ::: "memory");
}

__device__ __forceinline__ void rms_row_to_bf16(const float* xrow, const float* gain, bf16* orow, int lane) {
    const GAS f32x4* xr = (const GAS f32x4*)xrow + lane; const GAS f32x4* gr = (const GAS f32x4*)gain + lane;
    f32x4 v[8]; float s = 0.f;
#pragma unroll
    for (int j = 0; j < 8; ++j) { v[j] = xr[64 * j]; s += (v[j].x * v[j].x + v[j].y * v[j].y) + (v[j].z * v[j].z + v[j].w * v[j].w); }
    const float rstd = 1.0f / sqrtf(wave_sum(s) * (1.f / DM) + 1e-6f);
    GAS v2u* o8 = (GAS v2u*)orow + lane;
#pragma unroll
    for (int j = 0; j < 8; ++j) { const f32x4 g = gr[64 * j]; v2u o; o.x = pk2(v[j].x * rstd * g.x, v[j].y * rstd * g.y); o.y = pk2(v[j].z * rstd * g.z, v[j].w * rstd * g.w); o8[64 * j] = o; }
}

struct In { const float* p[33]; };
constexpr int NJOBS = 43, JOBS_PRO = 4, JOBS_BG0 = 27;
__device__ __forceinline__ void tr_load32(f32x4 (&v)[8], const float* W, int N, int k0, int n0, int lane) {
    const int lq = lane & 15, lr = lane >> 4;
#pragma unroll
    for (int i = 0; i < 8; ++i) v[i] = *(const GAS f32x4*)(W + (size_t)(k0 + 4 * i + lr) * N + n0 + 4 * lq);
}
__device__ __forceinline__ void tr_store32(const f32x4 (&v)[8], bf16* WT, int ldo, int koff, int rowbase, int mode, float sc, LAS float* scr, int k0, int n0, int lane) {
    const int lq = lane & 15, lr = lane >> 4;
#pragma unroll
    for (int i = 0; i < 8; ++i) { LAS float* s = scr + (4 * i + lr) * 65 + 4 * lq; s[0] = v[i].x; s[1] = v[i].y; s[2] = v[i].z; s[3] = v[i].w; }
    LDS_WAIT(); asm volatile("" ::: "memory");
    const int c = lane & 3, ns = lane >> 2;
#pragma unroll
    for (int j = 0; j < 4; ++j) { const int n = n0 + ns + 16 * j; const int row = rowbase + (mode ? ((n >> 7) * 256 + (n & 127) + (mode == 2 ? 128 : 0)) : n);
        const LAS float* s = scr + (8 * c) * 65 + ns + 16 * j;
        v4u o; o.x = pk2(s[0 * 65] * sc, s[1 * 65] * sc); o.y = pk2(s[2 * 65] * sc, s[3 * 65] * sc); o.z = pk2(s[4 * 65] * sc, s[5 * 65] * sc); o.w = pk2(s[6 * 65] * sc, s[7 * 65] * sc);
        *(GAS v4u*)(WT + (size_t)row * ldo + koff + k0 + 8 * c) = o; }
    LDS_WAIT(); asm volatile("" ::: "memory");
}
__device__ __forceinline__ void tr_store32_f8(const f32x4 (&v)[8], unsigned char* WT, int ldo, int koff, int rowbase, int mode, float sc, LAS float* scr, int k0, int n0, int lane) {
    const int lq = lane & 15, lr = lane >> 4;
#pragma unroll
    for (int i = 0; i < 8; ++i) { LAS float* s = scr + (4 * i + lr) * 65 + 4 * lq; s[0] = v[i].x; s[1] = v[i].y; s[2] = v[i].z; s[3] = v[i].w; }
    LDS_WAIT(); asm volatile("" ::: "memory");
    const int c = lane & 1, ns = lane >> 1;
#pragma unroll
    for (int j = 0; j < 2; ++j) { const int n = n0 + ns + 32 * j; const int row = rowbase + (mode ? ((n >> 7) * 256 + (n & 127) + (mode == 2 ? 128 : 0)) : n);
        const LAS float* s = scr + (16 * c) * 65 + ns + 32 * j;
        v4u o;
        o.x = pg8::pk4_fp8(s[0 * 65] * sc, s[1 * 65] * sc, s[2 * 65] * sc, s[3 * 65] * sc);   o.y = pg8::pk4_fp8(s[4 * 65] * sc, s[5 * 65] * sc, s[6 * 65] * sc, s[7 * 65] * sc);
        o.z = pg8::pk4_fp8(s[8 * 65] * sc, s[9 * 65] * sc, s[10 * 65] * sc, s[11 * 65] * sc); o.w = pg8::pk4_fp8(s[12 * 65] * sc, s[13 * 65] * sc, s[14 * 65] * sc, s[15 * 65] * sc);
        *(GAS v4u*)(WT + (size_t)row * ldo + koff + k0 + 16 * c) = o; }
    LDS_WAIT(); asm volatile("" ::: "memory");
}
__device__ __forceinline__ void conv_jobs(const LAS unsigned long long* ptab, unsigned char* ws, int jlo, int jhi, int wid, int nw, LAS float* scr, int lane) {
    int rot = 0;
    for (int j = jlo; j < jhi; ++j) {
        int pi; size_t wo = 0, wso; size_t wto = 0; int Kd, N, ldo, koff = 0, rowbase = 0, mode = 0, slo = 0, shi = 0;
        if (j == 0 || j == 11) { const int l = j == 0 ? 0 : 1; pi = 2; wo = (size_t)l * 2048 * NIN; Kd = 2048; N = NIN; wso = WS_WIN; wto = (size_t)l * NIN * 2048; ldo = 2048; slo = SB_OFF; shi = SB_OFF + 1024; }
        else if ((j >= 1 && j < 4) || (j >= 12 && j < 15)) { const int l = j < 4 ? 0 : 1, q = j < 4 ? j - 1 : j - 12;
            pi = q == 0 ? 10 : (q == 1 ? 12 : 13); wo = (size_t)l * (q == 2 ? 128 : 64) * 512; Kd = q == 2 ? 128 : 64; N = 512;
            wso = WS_LORA; wto = (size_t)l * 1536 * 256; ldo = 256; koff = 64 * q; rowbase = 512 * q; }
        else if ((j >= 4 && j < 7) || (j >= 15 && j < 18)) { const int l = j < 7 ? 0 : 1, q = j < 7 ? j - 4 : j - 15;
            pi = 19 + q; wo = (size_t)l * (q == 2 ? 1024 : 512) * 2048; Kd = q == 2 ? 1024 : 512; N = 2048;
            wso = WS_PC; wto = (size_t)l * 2048 * 2048; ldo = 2048; koff = 512 * q; }
        else if (j == 7 || j == 18) { const int l = j == 7 ? 0 : 1; pi = 22; wo = (size_t)l * 2048 * 2048; Kd = 2048; N = 2048; wso = WS_WO; wto = (size_t)l * 2048 * 2048; ldo = 2048; }
        else if (j == 8)  { pi = 24; Kd = 2048; N = DFF; wso = WS_W13; ldo = 2048; mode = 1; }
        else if (j == 9)  { pi = 25; Kd = 2048; N = DFF; wso = WS_W13; ldo = 2048; mode = 2; }
        else if (j == 10) { pi = 26; Kd = DFF; N = 2048; wso = WS_W2; ldo = DFF; }
        else if (j < 27) { const int e = j - 19; pi = 29; wo = (size_t)e * 2048 * DFE; Kd = 2048; N = DFE; wso = WS_W13E; ldo = 2048; rowbase = e * 2 * DFE; mode = 1; }
        else if (j < 35) { const int e = j - 27; pi = 30; wo = (size_t)e * 2048 * DFE; Kd = 2048; N = DFE; wso = WS_W13E; ldo = 2048; rowbase = e * 2 * DFE; mode = 2; }
        else             { const int e = j - 35; pi = 31; wo = (size_t)e * DFE * 2048; Kd = DFE; N = 2048; wso = WS_W2E; ldo = DFE; rowbase = e * 2048; }
        const float* W = (const float*)ptab[pi] + wo; bf16* WT = (bf16*)(ws + wso) + wto;
        const int nnb = N / 64, nitems = (Kd / 32) * nnb;
        int start = wid - rot; if (start < 0) start += nw;
#define CV_LOAD(V, it_) do { const int kb_ = (it_) / nnb, nb_ = (it_) - kb_ * nnb; tr_load32(V, W, N, 32 * kb_, 64 * nb_, lane); } while (0)
#define CV_STORE(V, it_) do { const int kb_ = (it_) / nnb, nb_ = (it_) - kb_ * nnb, n0_ = 64 * nb_; \
            if (j >= 19) tr_store32_f8(V, (unsigned char*)WT, ldo, koff, rowbase, mode, pg8::F8_SW, scr, 32 * kb_, n0_, lane);     \
            else tr_store32(V, WT, ldo, koff, rowbase, mode, (n0_ >= slo && n0_ < shi) ? 0.125f : 1.0f, scr, 32 * kb_, n0_, lane); } while (0)
        f32x4 va[8], vb[8];
        if (start < nitems) CV_LOAD(va, start);
        for (int it = start; it < nitems; it += 2 * nw) {
            { const int i1 = it + nw < nitems ? it + nw : it; CV_LOAD(vb, i1); }
            CV_STORE(va, it);
            if (it + nw >= nitems) break;
            { const int i2 = it + 2 * nw < nitems ? it + 2 * nw : it + nw; CV_LOAD(va, i2); }
            CV_STORE(vb, it + nw);
        }
#undef CV_LOAD
#undef CV_STORE
        rot = (rot + nitems) % nw;
    }
}
__device__ __forceinline__ void p0_prologue(Frame& F, const In& I) {
    unsigned char* ws = F.ws;
    conv_jobs((const LAS unsigned long long*)(F.lds + LDSCTL_OFF + 256), ws, 0, JOBS_PRO, F.gw, F.ngw, (LAS float*)(F.lds + F.wave * 8320), F.lane);
    { const float* gw = I.p[6]; bf16* o = (bf16*)(ws + WS_GMW);
      for (int g = blockIdx.x * 512 + F.tid; g < 2 * 8 * 128 * 128 / 8; g += F.G * 512) { const int s0 = (g & 15) * 8, t = (g >> 4) & 127;
          const f32x4 a = *(const GAS f32x4*)(gw + (size_t)g * 8), b = *(const GAS f32x4*)(gw + (size_t)g * 8 + 4);
          float v[8] = {a.x, a.y, a.z, a.w, b.x, b.y, b.z, b.w};
#pragma unroll
          for (int e = 0; e < 8; ++e) if (s0 + e > t) v[e] = 0.f;
          *(GAS v4u*)(o + (size_t)g * 8) = pk8(v); } }
    for (int m = F.gw; m < M; m += F.ngw) rms_row_to_bf16(I.p[0] + (size_t)m * DM, I.p[1], (bf16*)(ws + WS_XN) + (size_t)m * DM, F.lane);
}

__device__ __forceinline__ void rw_elem_row(Frame& F, const In& I, int l, int m) {
    bf16* PROJ = (bf16*)(F.ws + WS_PROJ); bf16* RWT = (bf16*)(F.ws + WS_RWT);
    const bool has_prev = (m % SEQ) != 0;
    const bf16* cur = PROJ + (size_t)m * NIN + RW_OFF; const bf16* prv = cur - NIN;
    const float* mu = I.p[8] + l * 1792; const float* kkw = I.p[14] + l * 512;
#pragma unroll
    for (int i = 0; i < 4; ++i) {
        const int c = F.lane + 64 * i;
        if (c < 224) {
            float x[8], p[8];
            unpk8(*(const GAS v4u*)(cur + 8 * c), x);
            if (has_prev) unpk8(*(const GAS v4u*)(prv + 8 * c), p); else {
#pragma unroll
                for (int e = 0; e < 8; ++e) p[e] = 0.f; }
            const f32x4 m0 = *(const GAS f32x4*)(mu + 8 * c), m1 = *(const GAS f32x4*)(mu + 8 * c + 4);
            const float mm[8] = {m0.x, m0.y, m0.z, m0.w, m1.x, m1.y, m1.z, m1.w};
#pragma unroll
            for (int e = 0; e < 8; ++e) x[e] = x[e] + (p[e] - x[e]) * mm[e];
            if (i == 0) { *(GAS v4u*)(RWT + RWT_R + (size_t)m * 512 + 8 * c) = pk8(x); }
            else if (i == 1) { const int ch = 8 * (c - 64);
                *(GAS v4u*)(RWT + RWT_K + (size_t)m * 512 + ch) = pk8(x);
                const f32x4 k0 = *(const GAS f32x4*)(kkw + ch), k1 = *(const GAS f32x4*)(kkw + ch + 4);
                const float kw[8] = {k0.x, k0.y, k0.z, k0.w, k1.x, k1.y, k1.z, k1.w};
                float q[8], ss = 0.f;
#pragma unroll
                for (int e = 0; e < 8; ++e) { q[e] = x[e] * kw[e]; ss += q[e] * q[e]; }
                ss = sum8(ss);
                const float inv = 1.0f / fmaxf(sqrtf(ss), 1e-12f);
#pragma unroll
                for (int e = 0; e < 8; ++e) q[e] *= inv;
                *(GAS v4u*)(RWT + RWT_KK + (size_t)m * 512 + ch) = pk8(q); }
            else if (i == 2) { *(GAS v4u*)(RWT + RWT_V + (size_t)m * 512 + 8 * (c - 128)) = pk8(x); }
            else { const int cc = c - 192;
#pragma unroll
                for (int e = 0; e < 8; ++e) { if (cc < 8) x[e] = 1.0f - 2.0f * __builtin_amdgcn_rcpf(1.0f + __builtin_amdgcn_exp2f(2.885390081777927f * x[e])); else if (cc >= 16) x[e] = fsig(x[e]); }
                *(GAS v4u*)(RWT + RWT_LA + (size_t)m * 256 + 8 * cc) = pk8(x); }
        }
    }
}
__device__ __forceinline__ void gm_ln_row(Frame& F, const In& I, int l, int m) {
    bf16* vp = (bf16*)(F.ws + WS_PROJ) + (size_t)m * NIN + 512 + 8 * F.lane;
    float x[8]; unpk8(*(const GAS v4u*)vp, x);
    float s = 0.f;
#pragma unroll
    for (int e = 0; e < 8; ++e) s += x[e];
    const float mean = wave_sum(s) * (1.f / 512.f); float q = 0.f;
#pragma unroll
    for (int e = 0; e < 8; ++e) { x[e] -= mean; q += x[e] * x[e]; }
    const float rstd = 1.0f / sqrtf(wave_sum(q) * (1.f / 512.f) + 1e-5f);
    const float* g = I.p[4] + l * 512 + 8 * F.lane; const float* b = I.p[5] + l * 512 + 8 * F.lane;
    const f32x4 g0 = *(const GAS f32x4*)g, g1 = *(const GAS f32x4*)(g + 4), b0 = *(const GAS f32x4*)b, b1 = *(const GAS f32x4*)(b + 4);
    const float gg[8] = {g0.x, g0.y, g0.z, g0.w, g1.x, g1.y, g1.z, g1.w}, bb[8] = {b0.x, b0.y, b0.z, b0.w, b1.x, b1.y, b1.z, b1.w};
#pragma unroll
    for (int e = 0; e < 8; ++e) x[e] = x[e] * rstd * gg[e] + bb[e];
    *(GAS v4u*)vp = pk8(x);
}
#define MFMA32(a, b, c) __builtin_amdgcn_mfma_f32_32x32x16_bf16((a), (b), (c), 0, 0, 0)
__device__ __forceinline__ int crow(int r, int hi) { return (r & 3) + 8 * (r >> 2) + 4 * hi; }
__device__ __forceinline__ void sb_attn_unit(bf16* PROJ, int b, int h, int qt, int lane, int ocol = SB_OFF) {
    const int r32 = lane & 31, hi = lane >> 5;
    const size_t rowb = (size_t)b * SEQ;
    const bf16* Qp = PROJ + (rowb + qt * 32 + r32) * NIN + SB_OFF + h * 64 + hi * 8;
    bf16x8 qf[4];
#pragma unroll
    for (int ds = 0; ds < 4; ++ds) qf[ds] = *(const GAS bf16x8*)(Qp + ds * 16);
    f32x16 o0, o1;
#pragma unroll
    for (int r = 0; r < 16; ++r) { o0[r] = 0.f; o1[r] = 0.f; }
    float R = 0.f;
    const int tq = qt * 32 + r32;
    for (int kt = qt; kt >= 0; --kt) {
        const bf16* Kp = PROJ + (rowb + kt * 32 + r32) * NIN + SB_OFF + 1024 + h * 64 + hi * 8;
        bf16x8 kf[4];
#pragma unroll
        for (int ds = 0; ds < 4; ++ds) kf[ds] = *(const GAS bf16x8*)(Kp + ds * 16);
        const bf16* Vp = PROJ + (rowb + kt * 32) * NIN + SB_OFF + 2048 + h * 64 + r32;
        bf16x8 vf[2][2];
#pragma unroll
        for (int j = 0; j < 2; ++j)
#pragma unroll
            for (int dt = 0; dt < 2; ++dt)
#pragma unroll
                for (int e = 0; e < 8; ++e) vf[j][dt][e] = (short)*(const GAS bf16*)(Vp + (size_t)crow(8 * j + e, hi) * NIN + dt * 32);
        f32x16 st;
#pragma unroll
        for (int r = 0; r < 16; ++r) st[r] = 0.f;
#pragma unroll
        for (int ds = 0; ds < 4; ++ds) st = MFMA32(kf[ds], qf[ds], st);
        float sp[16]; const bool diag = (kt == qt);
#pragma unroll
        for (int r = 0; r < 16; ++r) { const float z = st[r]; const int s = kt * 32 + crow(r, hi);
            float v = (z > 20.f) ? z : 0.6931471805599453f * __builtin_amdgcn_logf(1.0f + __builtin_amdgcn_exp2f(1.4426950408889634f * z));
            if (diag && s >= tq) v = 0.f;
            sp[r] = v; }
        float rs[4], prs[4];
#pragma unroll
        for (int g = 0; g < 4; ++g) { rs[g] = (sp[4 * g] + sp[4 * g + 1]) + (sp[4 * g + 2] + sp[4 * g + 3]); prs[g] = __shfl_xor(rs[g], 32); }
        float carry = R; float att[16];
#pragma unroll
        for (int g = 3; g >= 0; --g) { float c = carry + (hi == 0 ? prs[g] : 0.f);
#pragma unroll
            for (int i = 3; i >= 0; --i) { const int r = 4 * g + i; c += sp[r]; const int s = kt * 32 + crow(r, hi);
                float a = __builtin_amdgcn_exp2f(1.4426950408889634f * (st[r] - c));
                if (diag && s >= tq) a = 0.f;
                att[r] = a; }
            carry += rs[g] + prs[g]; }
        R = carry;
        bf16x8 pa[2];
#pragma unroll
        for (int j = 0; j < 2; ++j) { v4u w; w.x = pk2(att[8 * j], att[8 * j + 1]); w.y = pk2(att[8 * j + 2], att[8 * j + 3]); w.z = pk2(att[8 * j + 4], att[8 * j + 5]); w.w = pk2(att[8 * j + 6], att[8 * j + 7]); pa[j] = __builtin_bit_cast(bf16x8, w); }
#pragma unroll
        for (int j = 0; j < 2; ++j) { o0 = MFMA32(pa[j], vf[j][0], o0); o1 = MFMA32(pa[j], vf[j][1], o1); }
        if (__all(R > 110.f)) break;
    }
    bf16* Op = PROJ + (rowb + qt * 32) * NIN + ocol + h * 64 + r32;
#pragma unroll
    for (int r = 0; r < 16; ++r) { const size_t ro = (size_t)crow(r, hi) * NIN; *(GAS bf16*)(Op + ro) = (bf16)f2bf(o0[r]); *(GAS bf16*)(Op + ro + 32) = (bf16)f2bf(o1[r]); }
}
__device__ __forceinline__ void c1_phase(Frame& F, const In& I, int l) {
    for (int m = F.gw; m < M; m += F.ngw) { rw_elem_row(F, I, l, m); gm_ln_row(F, I, l, m); }
    bf16* PROJ = (bf16*)(F.ws + WS_PROJ);
    for (int u = F.gw; u < BATCH * 16 * 64; u += F.ngw) { const int qt = 63 - (u >> 7), bh = u & 127; sb_attn_unit(PROJ, bh >> 4, bh & 15, qt, F.lane); }
}

__device__ __forceinline__ void attn_dummy_phase(Frame& F) {
    bf16* PROJ = (bf16*)(F.ws + WS_PROJ);
    for (int u = F.gw; u < BATCH * 16 * 64; u += F.ngw) { const int qt = 63 - (u >> 7), bh = u & 127; sb_attn_unit(PROJ, bh >> 4, bh & 15, qt, F.lane, 1536); }
}

template <int CTRL> __device__ __forceinline__ float dppf(float v) { return __builtin_bit_cast(float, __builtin_amdgcn_update_dpp(0, __builtin_bit_cast(int, v), CTRL, 0xf, 0xf, true)); }
__device__ __forceinline__ float rowsum16(float x) { x += dppf<0xB1>(x); x += dppf<0x4E>(x); x += dppf<0x141>(x); x += dppf<0x140>(x); return x; }
__device__ __forceinline__ void lds_wait_ge(volatile LAS unsigned* w, unsigned target) {
    for (unsigned sp = 0; sp < (1u << 22); ++sp) { if ((unsigned)__builtin_amdgcn_readfirstlane((int)w[0]) >= target) break; __builtin_amdgcn_s_sleep(1); }
}
__device__ __forceinline__ void lds_wait4_ge(volatile LAS unsigned* w, unsigned target) {
    for (unsigned sp = 0; sp < (1u << 22); ++sp) { const unsigned a = w[0], b = w[1], c = w[2], d = w[3]; const unsigned m = min(min(a, b), min(c, d));
        if ((unsigned)__builtin_amdgcn_readfirstlane((int)m) >= target) break; __builtin_amdgcn_s_sleep(1); }
}
__device__ __forceinline__ void scan_phase(Frame& F, const In& I, int jlo, int jhi) {
    typedef float f32x2 __attribute__((ext_vector_type(2)));
    constexpr int TC = 32, NC = SEQ / TC, VEC_B = TC * 5 * 64 * 4, VV_B = TC * 16 * 4, YP_B = TC * 16 * 4 * 4, BUF_B = VEC_B + VV_B + YP_B, CV_OFF = 2 * BUF_B;
    static_assert(CV_OFF + 3 * 8320 <= LDSCTL_OFF, "scan LDS map");
    const bf16* PROJ = (const bf16*)(F.ws + WS_PROJ); const bf16* RWT = (const bf16*)(F.ws + WS_RWT);
    const int lane = F.lane;
    volatile LAS unsigned* f_ready = (volatile LAS unsigned*)(F.lds + LDSCTL_OFF + 64);
    volatile LAS unsigned* f_done = (volatile LAS unsigned*)(F.lds + LDSCTL_OFF + 80);
    bool bg_done = false;
    for (int u = blockIdx.x; u < BATCH * 8 * 4; u += F.G) {
        const int rb = u & 3, bh = u >> 2, h = bh & 7, b = bh >> 3;
        const size_t m0 = (size_t)b * SEQ;
        __syncthreads();
        if (F.tid < 8) f_ready[F.tid] = 0u;
        LDS_WAIT(); __syncthreads();
        if (F.wave >= 5) {
            if (!bg_done) conv_jobs((const LAS unsigned long long*)(F.lds + LDSCTL_OFF + 256), F.ws, jlo, jhi, blockIdx.x * 3 + (F.wave - 5), F.G * 3, (LAS float*)(F.lds + CV_OFF + (F.wave - 5) * 8320), lane);
            bg_done = true;
        } else if (F.wave == 4) {
            const int st8 = lane >> 3, ch = h * 64 + 8 * (lane & 7);
            v4u rgA[4][5], rvA, rgB[4][5], rvB;
#define SCAN_LOAD(rg, rv, c) do { _Pragma("unroll") for (int q = 0; q < 4; ++q) { const size_t mr = m0 + (size_t)(c) * TC + 8 * q + st8; \
                rg[q][0] = *(const GAS v4u*)(RWT + RWT_KK + mr * 512 + ch); rg[q][1] = *(const GAS v4u*)(PROJ + mr * NIN + C_KKA + ch); rg[q][2] = *(const GAS v4u*)(PROJ + mr * NIN + C_KP + ch); \
                rg[q][3] = *(const GAS v4u*)(PROJ + mr * NIN + C_LW + ch); rg[q][4] = *(const GAS v4u*)(RWT + RWT_R + mr * 512 + ch); } \
                rv = *(const GAS v4u*)(RWT + RWT_V + (m0 + (size_t)(c) * TC + (lane >> 1)) * 512 + h * 64 + rb * 16 + 8 * (lane & 1)); } while (0)
#define SCAN_STORE(rg, rv, c) do { LAS unsigned char* bb = F.lds + ((c) & 1) * BUF_B; \
                _Pragma("unroll") for (int q = 0; q < 4; ++q) { _Pragma("unroll") for (int a = 0; a < 5; ++a) { float x[8]; unpk8(rg[q][a], x); \
                    if (a == 3) { _Pragma("unroll") for (int e = 0; e < 8; ++e) x[e] = __builtin_amdgcn_exp2f(1.4426950408889634f * x[e]); } \
                    LAS f32x4* d = (LAS f32x4*)(bb + (((8 * q + st8) * 5 + a) * 64 + 8 * (lane & 7)) * 4); d[0] = (f32x4){x[0], x[1], x[2], x[3]}; d[1] = (f32x4){x[4], x[5], x[6], x[7]}; } } \
                { float x[8]; unpk8(rv, x); LAS f32x4* d = (LAS f32x4*)(bb + VEC_B + ((lane >> 1) * 16 + 8 * (lane & 1)) * 4); d[0] = (f32x4){x[0], x[1], x[2], x[3]}; d[1] = (f32x4){x[4], x[5], x[6], x[7]}; } } while (0)
#define SCAN_FLUSH(c) do { const LAS f32x4* yp = (const LAS f32x4*)(F.lds + ((c) & 1) * BUF_B + VEC_B + VV_B); \
                _Pragma("unroll") for (int k = 0; k < 4; ++k) { const int idx = k * 128 + lane * 2, t = idx >> 4, ri = idx & 15; \
                const f32x4 q0 = yp[idx], q1 = yp[idx + 1]; const float y0 = (q0.x + q0.y) + (q0.z + q0.w), y1 = (q1.x + q1.y) + (q1.z + q1.w); \
                float* dst = (float*)((unsigned char*)F.ws + WS_PROJ + (m0 + (size_t)(c) * TC + t) * (size_t)(NIN * 2) + YRAW_BYTE) + h * 64 + rb * 16 + ri; \
                *(GAS f32x2*)dst = (f32x2){y0, y1}; } } while (0)
#define SCAN_STEP(rg, rv, c) do { if ((c) >= 2) { lds_wait4_ge(f_done, (unsigned)((c) - 1)); SCAN_FLUSH((c) - 2); } \
                SCAN_STORE(rg, rv, (c)); LDS_WAIT(); asm volatile("" ::: "memory"); if (lane == 0) f_ready[0] = (unsigned)((c) + 1); \
                { const int cn = (c) + 2 < NC ? (c) + 2 : (c); SCAN_LOAD(rg, rv, cn); } } while (0)
            __builtin_amdgcn_s_setprio(2);
            SCAN_LOAD(rgA, rvA, 0); SCAN_LOAD(rgB, rvB, 1);
            for (int c = 0; c < NC; c += 2) { SCAN_STEP(rgA, rvA, c); SCAN_STEP(rgB, rvB, c + 1); }
            lds_wait4_ge(f_done, (unsigned)NC);
            SCAN_FLUSH(NC - 2); SCAN_FLUSH(NC - 1);
            __builtin_amdgcn_s_setprio(0);
#undef SCAN_STEP
#undef SCAN_LOAD
#undef SCAN_STORE
#undef SCAN_FLUSH
        } else {
            const int cw = F.wave, rl = lane >> 4, kq = lane & 15, row = 4 * cw + rl;
            f32x2 Sa = (f32x2){0.f, 0.f}, Sb = Sa;
            __builtin_amdgcn_s_setprio(3);
            for (int c = 0; c < NC; ++c) {
                lds_wait_ge(f_ready, (unsigned)(c + 1));
                const LAS unsigned char* bb = F.lds + (c & 1) * BUF_B;
                const LAS f32x4* vp = (const LAS f32x4*)bb + kq;
                const LAS float* vvp = (const LAS float*)(bb + VEC_B) + row;
                LAS float* yp = (LAS float*)(bb + VEC_B + VV_B) + row * 4 + (kq >> 2);
                f32x4 kk = vp[0], kka = vp[16], kp = vp[32], w = vp[48], r = vp[64]; float vv = vvp[0];
#pragma unroll 2
                for (int t = 0; t < TC; ++t) {
                    const LAS f32x4* np = vp + (t + 1) * 80;
                    const f32x4 nkk = np[0], nkka = np[16], nkp = np[32], nw = np[48], nr = np[64]; const float nvv = vvp[(t + 1) * 16];
                    f32x2 P = Sa * (f32x2){kk.x, kk.y}; P = Sb * (f32x2){kk.z, kk.w} + P;
                    float p = P.x + P.y;
                    p = rowsum16(p);
                    const float sa = -p;
                    Sa = Sa * (f32x2){w.x, w.y} + (f32x2){kka.x, kka.y} * sa; Sb = Sb * (f32x2){w.z, w.w} + (f32x2){kka.z, kka.w} * sa;
                    Sa = (f32x2){kp.x, kp.y} * vv + Sa; Sb = (f32x2){kp.z, kp.w} * vv + Sb;
                    f32x2 Y = Sa * (f32x2){r.x, r.y}; Y = Sb * (f32x2){r.z, r.w} + Y;
                    float y = Y.x + Y.y;
                    y += dppf<0xB1>(y); y += dppf<0x4E>(y);
                    yp[t * 64] = y;
                    kk = nkk; kka = nkka; kp = nkp; w = nw; r = nr; vv = nvv;
                }
                LDS_WAIT(); asm volatile("" ::: "memory");
                if (lane == 0) f_done[cw] = (unsigned)(c + 1);
            }
            __builtin_amdgcn_s_setprio(0);
        }
    }
    if (F.wave >= 5 && !bg_done) conv_jobs((const LAS unsigned long long*)(F.lds + LDSCTL_OFF + 256), F.ws, jlo, jhi, blockIdx.x * 3 + (F.wave - 5), F.G * 3, (LAS float*)(F.lds + CV_OFF + (F.wave - 5) * 8320), lane);
}

__device__ __forceinline__ void rw_post_row(Frame& F, const In& I, int l, int m) {
    bf16* PROJ = (bf16*)(F.ws + WS_PROJ); const bf16* RWT = (const bf16*)(F.ws + WS_RWT);
    const int ch = 8 * F.lane;
    const float* yr = (const float*)((const unsigned char*)F.ws + WS_PROJ + (size_t)m * (NIN * 2) + YRAW_BYTE) + ch;
    const f32x4 y0 = *(const GAS f32x4*)yr, y1 = *(const GAS f32x4*)(yr + 4);
    float y[8] = {y0.x, y0.y, y0.z, y0.w, y1.x, y1.y, y1.z, y1.w};
    float r[8], kp[8], v[8], g[8];
    unpk8(*(const GAS v4u*)(RWT + RWT_R + (size_t)m * 512 + ch), r); unpk8(*(const GAS v4u*)(PROJ + (size_t)m * NIN + C_KP + ch), kp);
    unpk8(*(const GAS v4u*)(RWT + RWT_V + (size_t)m * 512 + ch), v); unpk8(*(const GAS v4u*)(RWT + RWT_G + (size_t)m * 512 + ch), g);
    const float* rk = I.p[16] + l * 512 + ch; const float* lg = I.p[17] + l * 512 + ch; const float* lb = I.p[18] + l * 512 + ch;
    const f32x4 a0 = *(const GAS f32x4*)rk, a1 = *(const GAS f32x4*)(rk + 4), b0 = *(const GAS f32x4*)lg, b1 = *(const GAS f32x4*)(lg + 4), c0 = *(const GAS f32x4*)lb, c1 = *(const GAS f32x4*)(lb + 4);
    const float rkk[8] = {a0.x, a0.y, a0.z, a0.w, a1.x, a1.y, a1.z, a1.w}, lgg[8] = {b0.x, b0.y, b0.z, b0.w, b1.x, b1.y, b1.z, b1.w}, lbb[8] = {c0.x, c0.y, c0.z, c0.w, c1.x, c1.y, c1.z, c1.w};
    float s = 0.f, bs = 0.f;
#pragma unroll
    for (int e = 0; e < 8; ++e) { s += y[e]; bs += r[e] * kp[e] * rkk[e]; }
    const float mean = sum8(s) * (1.f / 64.f); bs = sum8(bs);
    float q = 0.f;
#pragma unroll
    for (int e = 0; e < 8; ++e) { y[e] -= mean; q += y[e] * y[e]; }
    const float rstd = 1.0f / sqrtf(sum8(q) * (1.f / 64.f) + 64e-5f);
    float o[8];
#pragma unroll
    for (int e = 0; e < 8; ++e) o[e] = (y[e] * rstd * lgg[e] + lbb[e] + bs * v[e]) * g[e];
    *(GAS v4u*)(PROJ + (size_t)m * NIN + RW_OFF + ch) = pk8(o);
}
__device__ __forceinline__ void gmlp_unit(Frame& F, const In& I, int l, int b, int c, int h) {
    bf16* PROJ = (bf16*)(F.ws + WS_PROJ); const bf16* GW = (const bf16*)(F.ws + WS_GMW) + ((size_t)l * 8 + h) * 128 * 128;
    const int lane = F.lane, r32 = lane & 31, hi = lane >> 5;
    const size_t mrow0 = (size_t)b * SEQ + (size_t)c * 128;
    f32x16 acc[4][2];
#pragma unroll
    for (int i = 0; i < 4; ++i)
#pragma unroll
        for (int j = 0; j < 2; ++j)
#pragma unroll
            for (int r = 0; r < 16; ++r) acc[i][j][r] = 0.f;
    const bf16* Vp = PROJ + mrow0 * NIN + 512 + h * 64 + r32;
#pragma unroll
    for (int ks = 0; ks < 8; ++ks) {
        bf16x8 bf0, bf1_;
        const bf16* Vk = Vp + (size_t)(16 * ks + 8 * hi) * NIN; asm volatile("" : "+v"(Vk));
#pragma unroll
        for (int e = 0; e < 8; ++e) { const size_t ro = (size_t)e * NIN; bf0[e] = (short)*(const GAS bf16*)(Vk + ro); bf1_[e] = (short)*(const GAS bf16*)(Vk + ro + 32); }
#pragma unroll
        for (int i = 0; i < 4; ++i) if (ks <= 2 * i + 1) {
            const bf16x8 a = *(const GAS bf16x8*)(GW + (size_t)(32 * i + r32) * 128 + 16 * ks + 8 * hi);
            acc[i][0] = MFMA32(a, bf0, acc[i][0]); acc[i][1] = MFMA32(a, bf1_, acc[i][1]); }
        asm volatile("" ::: "memory");
    }
    const float* bs = I.p[7] + ((size_t)l * 8 + h) * 128;
#pragma unroll
    for (int i = 0; i < 4; ++i) {
        bf16* Ui = PROJ + (mrow0 + 32 * i + 4 * hi) * NIN + h * 64 + r32; asm volatile("" : "+v"(Ui));
        const float* bsi = bs + 32 * i + 4 * hi; asm volatile("" : "+v"(bsi));
#pragma unroll
        for (int r = 0; r < 16; ++r) { const int tl = (r & 3) + 8 * (r >> 2); const float bsv = bsi[tl];
            bf16* up = Ui + (size_t)tl * NIN;
            const float u0 = bf1(*(const GAS bf16*)up), u1 = bf1(*(const GAS bf16*)(up + 32));
            *(GAS bf16*)up = (bf16)f2bf(u0 * (acc[i][0][r] + bsv)); *(GAS bf16*)(up + 32) = (bf16)f2bf(u1 * (acc[i][1][r] + bsv));
            if ((r & 3) == 3) asm volatile("" ::: "memory"); }
    }
}
__device__ __forceinline__ void c4_phase(Frame& F, const In& I, int l) {
    for (int m = F.gw; m < M; m += F.ngw) rw_post_row(F, I, l, m);
    for (int u = F.gw; u < BATCH * 16 * 8; u += F.ngw) gmlp_unit(F, I, l, u >> 7, (u >> 3) & 15, u & 7);
}

__device__ __forceinline__ void router_row(Frame& F, const In& I, int m, const float* hbuf) {
    const int lane = F.lane;
    const GAS f32x4* xr = (const GAS f32x4*)(hbuf + (size_t)m * DM) + lane; const GAS f32x4* gr = (const GAS f32x4*)(I.p[23] + DM) + lane;
    const float* rw = I.p[27];
    float lg[8]; float s = 0.f;
#pragma unroll
    for (int e = 0; e < 8; ++e) lg[e] = 0.f;
    GAS unsigned* o8 = (GAS unsigned*)((unsigned char*)(F.ws + WS_XN) + (size_t)m * DM) + lane;
    f32x4 xv[8];
#pragma unroll
    for (int j = 0; j < 8; ++j) { const f32x4 x = xr[64 * j]; s += (x.x * x.x + x.y * x.y) + (x.z * x.z + x.w * x.w); xv[j] = x; }
    const float rstd = 1.0f / sqrtf(wave_sum(s) * (1.f / DM) + 1e-6f);
#pragma unroll
    for (int j = 0; j < 8; ++j) { const f32x4 g = gr[64 * j]; const float n[4] = {xv[j].x * rstd * g.x, xv[j].y * rstd * g.y, xv[j].z * rstd * g.z, xv[j].w * rstd * g.w};
        o8[64 * j] = pg8::pk4_fp8(n[0] * pg8::F8_SX, n[1] * pg8::F8_SX, n[2] * pg8::F8_SX, n[3] * pg8::F8_SX);
        const int c0 = 4 * (lane + 64 * j);
#pragma unroll
        for (int q = 0; q < 4; ++q) { const f32x4 w0 = *(const GAS f32x4*)(rw + (size_t)(c0 + q) * 8), w1 = *(const GAS f32x4*)(rw + (size_t)(c0 + q) * 8 + 4);
            lg[0] += n[q] * w0.x; lg[1] += n[q] * w0.y; lg[2] += n[q] * w0.z; lg[3] += n[q] * w0.w; lg[4] += n[q] * w1.x; lg[5] += n[q] * w1.y; lg[6] += n[q] * w1.z; lg[7] += n[q] * w1.w; } }
#pragma unroll
    for (int e = 0; e < 8; ++e) lg[e] = wave_sum(lg[e]) + I.p[28][e];
    int e0 = 0; float v0 = lg[0];
#pragma unroll
    for (int e = 1; e < 8; ++e) if (lg[e] > v0) { v0 = lg[e]; e0 = e; }
    int e1 = -1; float v1 = -3.0e38f;
#pragma unroll
    for (int e = 0; e < 8; ++e) if (e != e0 && lg[e] > v1) { v1 = lg[e]; e1 = e; }
    const float p1 = 1.0f / (1.0f + __expf(v0 - v1)), p0 = 1.0f - p1;
    if (lane == 0) {
        unsigned* cnt = (unsigned*)(F.ws + WS_CTL) + CW_CNT;
        const unsigned s0 = __hip_atomic_fetch_add(cnt + e0, 1u, RLX_AGENT), s1 = __hip_atomic_fetch_add(cnt + e1, 1u, RLX_AGENT);
        int* tab = (int*)(F.ws + WS_TAB) + (size_t)m * 8;
        tab[0] = e0; tab[1] = e1; tab[2] = (int)s0; tab[3] = (int)s1; ((float*)tab)[4] = p0; ((float*)tab)[5] = p1;
    }
}
__device__ __forceinline__ void moe_offsets(Frame& F, int (&off)[8], int (&ts)[8], int& nrt) {
    const unsigned* cnt = (const unsigned*)(F.ws + WS_CTL) + CW_CNT; int acc = 0;
#pragma unroll
    for (int e = 0; e < 8; ++e) { const int c = (int)__builtin_amdgcn_readfirstlane((int)__hip_atomic_load(cnt + e, RLX_AGENT)); ts[e] = acc; off[e] = acc * 256; acc += (c + 255) >> 8; }
    nrt = acc;
}
__device__ __forceinline__ void gather_phase(Frame& F) {
    const unsigned* cnt = (const unsigned*)(F.ws + WS_CTL) + CW_CNT;
    const int cj = (F.lane < 8) ? (int)__hip_atomic_load(cnt + (F.lane & 7), RLX_AGENT) : 0;
    const int tiles = (cj + 255) >> 8; int incl = tiles;
#pragma unroll
    for (int d = 1; d < 8; d <<= 1) { const int t = __shfl_up(incl, d); if (F.lane >= d) incl += t; }
    const int offv = (incl - tiles) * 256;
    const unsigned char* XN = (const unsigned char*)(F.ws + WS_XN); unsigned char* XG = (unsigned char*)(F.ws + WS_XG);
    for (int m = F.gw; m < M; m += F.ngw) {
        int* tab = (int*)(F.ws + WS_TAB) + (size_t)m * 8;
        const int e0 = tab[0], e1 = tab[1], s0 = __shfl(offv, e0) + tab[2], s1 = __shfl(offv, e1) + tab[3];
        const GAS v4u* src = (const GAS v4u*)(XN + (size_t)m * DM) + F.lane; GAS v4u* d0 = (GAS v4u*)(XG + (size_t)s0 * DM) + F.lane; GAS v4u* d1 = (GAS v4u*)(XG + (size_t)s1 * DM) + F.lane;
#pragma unroll
        for (int j = 0; j < 2; ++j) { const v4u x = src[64 * j]; d0[64 * j] = x; d1[64 * j] = x; }
        if (F.lane == 0) { tab[6] = s0; tab[7] = s1; }
    }
}
__device__ __forceinline__ void final_row(Frame& F, const In& I, int m, float* hbuf) {
    const int lane = F.lane;
    const int* tab = (const int*)(F.ws + WS_TAB) + (size_t)m * 8;
    const float p0 = ((const float*)tab)[4], p1 = ((const float*)tab)[5]; const int s0 = tab[6], s1 = tab[7];
    const bf16* Y2 = (const bf16*)(F.ws + WS_Y2);
    GAS f32x4* xr = (GAS f32x4*)(hbuf + (size_t)m * DM) + lane; const GAS f32x4* gr = (const GAS f32x4*)I.p[32] + lane;
    const GAS v2u* ya = (const GAS v2u*)(Y2 + (size_t)s0 * DM) + lane; const GAS v2u* yb = (const GAS v2u*)(Y2 + (size_t)s1 * DM) + lane;
    f32x4 v[8]; float s = 0.f;
#pragma unroll
    for (int j = 0; j < 8; ++j) { f32x4 x = xr[64 * j]; const v2u a = ya[64 * j], b = yb[64 * j];
        x.x += p0 * bfl(a.x) + p1 * bfl(b.x); x.y += p0 * bfh(a.x) + p1 * bfh(b.x); x.z += p0 * bfl(a.y) + p1 * bfl(b.y); x.w += p0 * bfh(a.y) + p1 * bfh(b.y);
        v[j] = x; s += (x.x * x.x + x.y * x.y) + (x.z * x.z + x.w * x.w); }
    const float rstd = 1.0f / sqrtf(wave_sum(s) * (1.f / DM) + 1e-6f);
#pragma unroll
    for (int j = 0; j < 8; ++j) { const f32x4 g = gr[64 * j]; xr[64 * j] = (f32x4){v[j].x * rstd * g.x, v[j].y * rstd * g.y, v[j].z * rstd * g.z, v[j].w * rstd * g.w}; }
}
#ifndef RPT_MASK
#define RPT_MASK 0
#endif

#ifndef PH_MASK
#define PH_MASK 0xFFFFFF
#endif
#define PK(kind) (((PH_MASK) >> (kind)) & 1)
#define IN(k) (lo <= (k) && (k) < hi)
#ifdef PROBE_A0
#define STAMP(p) do { if (blockIdx.x == 0 && F.tid == 0) ((LAS unsigned long long*)(F.lds + LDSCTL_OFF + 600))[(p)] = __builtin_amdgcn_s_memrealtime(); } while (0)
#else
#define STAMP(p) do { } while (0)
#endif
#define SEAM(k) do { if (IN(k) && IN((k) + 1)) xcd_barrier(bar); STAMP((k) + 1); } while (0)
template <int l> __device__ __forceinline__ void layer_body(Frame& F, const In& I, unsigned char* ws, float* hout, const XcdBarrier& bar, int lo, int hi) {
    LAS unsigned char* ring = F.lds;
    bf16* const XN = (bf16*)(ws + WS_XN); bf16* const PROJ = (bf16*)(ws + WS_PROJ); bf16* const RWT = (bf16*)(ws + WS_RWT);
        const int base = 1 + 11 * l;
        const float* hin = (l == 0) ? I.p[0] : (const float*)hout;
        if (PK(1) && IN(base + 0)) {
            pg8::Gemm g{XN, (const bf16*)(ws + WS_WIN) + (size_t)l * NIN * 2048, 2048, 2048, 2048}; pg8::StaticOrder S; S.init(M, NIN, F.G, (int)blockIdx.x);
            pg8::EpiInProj E{PROJ, I.p[3] + l * 3 * DM};
            pg8::gemm_phase<pg8::EpiInProj, pg8::StaticOrder, PG8_ALIGN, PG8_SP2>(ring, g, S, E);
            if (RPT_MASK & 8) { xcd_barrier(bar); pg8::gemm_phase<pg8::EpiInProj, pg8::StaticOrder, PG8_ALIGN, PG8_SP2>(ring, g, S, E); }
        } SEAM(base + 0);
        if (PK(2) && IN(base + 1)) { c1_phase(F, I, l); if (RPT_MASK & 4) { xcd_barrier(bar); attn_dummy_phase(F); } } SEAM(base + 1);
        if (PK(3) && IN(base + 2)) {
            int kl = 256; asm volatile("" : "+s"(kl));
            pg8::Gemm g{RWT + RWT_LA, (const bf16*)(ws + WS_LORA) + (size_t)l * 1536 * 256, kl, 256, 256}; pg8::StaticOrder S; S.init(M, 1536, F.G, (int)blockIdx.x);
            pg8::EpiLora E{PROJ, RWT + RWT_KK, RWT + RWT_K, RWT + RWT_G, I.p[9] + l * 512, I.p[11] + l * 512, I.p[15] + l * 512};
            pg8::gemm_phase<pg8::EpiLora, pg8::StaticOrder, PG8_ALIGN, PG8_SP2>(ring, g, S, E);
        } SEAM(base + 2);
        if (PK(4) && IN(base + 3)) { scan_phase(F, I, l == 0 ? JOBS_PRO : JOBS_BG0, l == 0 ? JOBS_BG0 : NJOBS); } SEAM(base + 3);
        if (PK(5) && IN(base + 4)) { c4_phase(F, I, l); } SEAM(base + 4);
        if (PK(6) && IN(base + 5)) {
            pg8::Gemm g{PROJ, (const bf16*)(ws + WS_PC) + (size_t)l * 2048 * 2048, 512, NIN, 2048}; pg8::MergeOrder S; S.so.init(M, DM, F.G, (int)blockIdx.x);
            pg8::EpiMerge E{PROJ, XN};
            pg8::gemm_phase<pg8::EpiMerge, pg8::MergeOrder, PG8_ALIGN, PG8_SP2>(ring, g, S, E);
        } SEAM(base + 5);
        if (PK(7) && IN(base + 6)) {
            pg8::Gemm g{XN, (const bf16*)(ws + WS_WO) + (size_t)l * 2048 * 2048, 2048, 2048, 2048}; pg8::StaticOrder S; S.init(M, DM, F.G, (int)blockIdx.x);
            pg8::EpiResid E{hin, hout};
            pg8::gemm_phase<pg8::EpiResid, pg8::StaticOrder, PG8_ALIGN, PG8_SP2>(ring, g, S, E);
        } SEAM(base + 6);
        if (l == 0) {
            if (PK(8) && IN(base + 7)) { for (int m = F.gw; m < M; m += F.ngw) rms_row_to_bf16(hout + (size_t)m * DM, I.p[23], XN + (size_t)m * DM, F.lane); } SEAM(base + 7);
            if (PK(9) && IN(base + 8)) {
                pg8::Gemm g{XN, (const bf16*)(ws + WS_W13), 2048, 2048, 2048}; pg8::StaticOrder S; S.init(M, 2 * DFF, F.G, (int)blockIdx.x);
                pg8::EpiSwiGLU E{(bf16*)(ws + WS_H), DFF, 2 * DFF / 256};
                pg8::gemm_phase<pg8::EpiSwiGLU, pg8::StaticOrder, PG8_ALIGN, PG8_SP2>(ring, g, S, E);
                if (RPT_MASK & 16) { xcd_barrier(bar); pg8::gemm_phase<pg8::EpiSwiGLU, pg8::StaticOrder, PG8_ALIGN, PG8_SP2>(ring, g, S, E); }
            } SEAM(base + 8);
            if (PK(10) && IN(base + 9)) {
                pg8::Gemm g{(const bf16*)(ws + WS_H), (const bf16*)(ws + WS_W2), DFF, DFF, DFF}; pg8::StaticOrder S; S.init(M, DM, F.G, (int)blockIdx.x);
                pg8::EpiResid E{hout, hout};
                pg8::gemm_phase<pg8::EpiResid, pg8::StaticOrder, PG8_ALIGN, PG8_SP2>(ring, g, S, E);
            } SEAM(base + 9);
            if (PK(8) && IN(base + 10)) { for (int m = F.gw; m < M; m += F.ngw) rms_row_to_bf16(hout + (size_t)m * DM, I.p[1] + DM, XN + (size_t)m * DM, F.lane); } SEAM(base + 10);
        } else {
            if (PK(11) && IN(base + 7)) { for (int m = F.gw; m < M; m += F.ngw) router_row(F, I, m, hout); } SEAM(base + 7);
            if (PK(12) && IN(base + 8)) { gather_phase(F); } SEAM(base + 8);
            if (PK(13) && IN(base + 9)) {
                pg8::MoeOrder S; int off[8]; moe_offsets(F, off, S.ts, S.nrt); S.nt = 2 * DFE / 256; S.G = F.G; S.c = (int)blockIdx.x;
                pg8::Gemm g{(const bf16*)(ws + WS_XG), (const bf16*)(ws + WS_W13E), 1024, 1024, 1024};
                pg8::EpiSwiGLU8 E{(unsigned char*)(ws + WS_HX), DFE, 2 * DFE / 256, 1.0f / (pg8::F8_SX * pg8::F8_SW)};
                pg8::gemm_phase<pg8::EpiSwiGLU8, pg8::MoeOrder, PG8_ALIGN, PG8_SP2, true>(ring, g, S, E);
            } SEAM(base + 9);
            if (PK(14) && IN(base + 10)) {
                pg8::MoeOrder S; int off[8]; moe_offsets(F, off, S.ts, S.nrt); S.nt = DM / 256; S.G = F.G; S.c = (int)blockIdx.x;
                pg8::Gemm g{(const bf16*)(ws + WS_HX), (const bf16*)(ws + WS_W2E), DFE / 2, DFE / 2, DFE / 2};
                pg8::EpiPlain E{(bf16*)(ws + WS_Y2), DM, DM / 256, 1.0f / (pg8::F8_SH * pg8::F8_SW)};
                pg8::gemm_phase<pg8::EpiPlain, pg8::MoeOrder, PG8_ALIGN, PG8_SP2, true>(ring, g, S, E);
            } SEAM(base + 10);
            if (PK(15) && IN(base + 11)) { for (int m = F.gw; m < M; m += F.ngw) final_row(F, I, m, hout); }
        }
    }
struct Args { In in; float* out; unsigned char* ws; int ph_lo, ph_hi; };
__global__ void __launch_bounds__(NWAVES * 64, 2) trunk_fwd(Args args) {
    extern __shared__ __attribute__((aligned(16))) unsigned char lds_raw[];
    Frame F;
    F.lds = (LAS unsigned char*)lds_raw; F.ws = args.ws; F.in = nullptr;
    F.tid = threadIdx.x; F.lane = F.tid & 63; F.wave = __builtin_amdgcn_readfirstlane(F.tid >> 6);
    F.G = gridDim.x; F.gw = blockIdx.x * NWAVES + F.wave; F.ngw = F.G * NWAVES;
    const In& I = args.in;
    unsigned char* ws = args.ws;
    for (int u = F.tid; u < (LDS_BYTES - LDSCTL_OFF) / 4; u += NWAVES * 64) ((LAS unsigned*)(F.lds + LDSCTL_OFF))[u] = 0u;
    __syncthreads();
    if (F.tid == 0) {
#pragma unroll
        for (int k = 0; k < 33; ++k) ((LAS unsigned long long*)(F.lds + LDSCTL_OFF + 256))[k] = (unsigned long long)I.p[k];
    }
    __syncthreads();
    const int lo = args.ph_lo, hi = args.ph_hi;
    XcdBarrier bar; bar.bar = (unsigned*)(ws + WS_CTL) + CW_BAR; bar.x = 0; bar.st = nullptr;
    if (hi - lo > 1) bar = xcd_barrier_post((unsigned*)(ws + WS_CTL) + CW_BAR, (volatile LAS unsigned*)(F.lds + LDSCTL_OFF) + 8);
    LAS unsigned char* ring = F.lds;
    bf16* const XN = (bf16*)(ws + WS_XN); bf16* const PROJ = (bf16*)(ws + WS_PROJ); bf16* const RWT = (bf16*)(ws + WS_RWT);
    float* const hout = args.out;

    STAMP(0);
    if (PK(0) && IN(0)) { p0_prologue(F, I); if (RPT_MASK & 1) { xcd_barrier(bar); p0_prologue(F, I); } } SEAM(0);

    layer_body<0>(F, I, ws, hout, bar, lo, hi);
    layer_body<1>(F, I, ws, hout, bar, lo, hi);
#ifdef PROBE_A0
    xcd_barrier(bar); STAMP(N_PHASES);
    if (blockIdx.x == 0) {
        const LAS unsigned long long* ts = (const LAS unsigned long long*)(F.lds + LDSCTL_OFF + 600);
        __syncthreads();
        const float x1 = (float)(ts[PROBE_A1 + 1] - ts[PROBE_A0]) * 0.01f, x2 = (float)(ts[PROBE_B1 + 1] - ts[PROBE_B0]) * 0.01f;
        if (F.tid == 0) hout[0] = x1;
        for (int i = F.tid; i < 100000; i += 512) hout[4096 + i] = x2 * 0.01f;
    }
#endif
#undef IN
#undef SEAM
}

#ifndef MK_SPLIT
#define MK_SPLIT 0
#endif
extern "C" void kernel_launch(void* const* d_in, const int* in_sizes, int n_in, void* d_out, int out_size, void* d_ws, size_t ws_size, hipStream_t stream) {
    static int grid = 0;
    if (grid == 0) {
        if (n_in != 33 || in_sizes[0] != M * DM || out_size != M * DM || ws_size < WS_END) { fprintf(stderr, "kernel_launch: unexpected shapes (n_in %d, ws %zu); nothing launched\n", n_in, ws_size); grid = -1; return; }
        int dev = 0, cus = 0, per_cu = 0;
        if (hipGetDevice(&dev) != hipSuccess || hipDeviceGetAttribute(&cus, hipDeviceAttributeMultiprocessorCount, dev) != hipSuccess) { grid = -1; return; }
        if (hipFuncSetAttribute((const void*)trunk_fwd, hipFuncAttributeMaxDynamicSharedMemorySize, LDS_BYTES) != hipSuccess) { fprintf(stderr, "kernel_launch: hipFuncSetAttribute failed\n"); grid = -1; return; }
        if (hipOccupancyMaxActiveBlocksPerMultiprocessor(&per_cu, (const void*)trunk_fwd, NWAVES * 64, LDS_BYTES) != hipSuccess || per_cu < 1) { fprintf(stderr, "kernel_launch: occupancy query says %d\n", per_cu); }
        (void)hipGetLastError();
        grid = cus;
    }
    if (grid < 0) return;
    if (hipMemsetAsync((char*)d_ws, 0, ZERO_BYTES, stream) != hipSuccess) return;
    Args a{};
    for (int i = 0; i < 33; ++i) a.in.p[i] = (const float*)d_in[i];
    a.out = (float*)d_out; a.ws = (unsigned char*)d_ws;
#if MK_SPLIT
    for (int p = 0; p < N_PHASES; ++p) { a.ph_lo = p; a.ph_hi = p + 1; hipLaunchKernelGGL(trunk_fwd, dim3(grid), dim3(NWAVES * 64), LDS_BYTES, stream, a); }
#else
    a.ph_lo = 0; a.ph_hi = N_PHASES;
    hipLaunchKernelGGL(trunk_fwd, dim3(grid), dim3(NWAVES * 64), LDS_BYTES, stream, a);
#endif
    const hipError_t le = hipPeekAtLastError();
    if (le != hipSuccess) fprintf(stderr, "kernel_launch: launch failed: %s\n", hipGetErrorName(le));
}
```

```cpp
#include <hip/hip_runtime.h>
#include <cstdio>
#include <cstdint>
#define GATE_RAW 1
namespace pg8 {
#define PG8_LAS __attribute__((address_space(3)))
typedef unsigned short bf16_t;
typedef short bf16x8 __attribute__((ext_vector_type(8)));
typedef float f32x4 __attribute__((ext_vector_type(4)));
typedef unsigned u32x4 __attribute__((ext_vector_type(4)));
typedef int i32x4 __attribute__((ext_vector_type(4)));
typedef int i32x8 __attribute__((ext_vector_type(8)));
constexpr int BM = 256, BK = 64, HALF = 128, HTB = HALF * BK * 2  , STAGE_BYTES = 8 * HTB, NXCD = 8, WGM = 8;

__host__ __device__ __forceinline__ int lds_byte(int r, int c) { const int st = (r >> 4) * 2 + (c >> 5), rr = r & 15, cc = c & 31, ob = rr * 64 + cc * 2; return st * 1024 + (ob ^ (((ob >> 9) & 1) << 5)); }
__host__ __device__ __forceinline__ void stage_rc(int b, int& R, int& C) { const int st = b / 1024, sb = b % 1024, swz = sb ^ (((sb >> 9) & 1) << 5); R = (st >> 1) * 16 + swz / 64; C = (st & 1) * 32 + (swz % 64) / 2; }
__host__ __device__ __forceinline__ int perm32(int rho) { const int n = rho >> 4, i = rho & 15; return 8 * (i >> 2) + 4 * n + (i & 3); }

struct Unit { int pm, pn, aoff, boff; };
struct Gemm { const bf16_t* A; const bf16_t* Bt; int K, lda, ldb; };

struct StaticOrder {
    int nM, nN, nwg, G, c;
    __host__ __device__ void init(int M, int N, int G_, int c_) { nM = M / BM; nN = N / BM; nwg = nM * nN; G = G_; c = c_; }
    __host__ __device__ bool next(int i, Unit& u) const {
        const long L = (long)i * G + c; if (L >= nwg) return false;
        int wgid = (int)L; { const int q = nwg / NXCD, r = nwg % NXCD, xcd = wgid % NXCD, off = wgid / NXCD; wgid = (xcd < r ? xcd * (q + 1) : r * (q + 1) + (xcd - r) * q) + off; }
        const int nig = WGM * nN, gid = wgid / nig, fm = gid * WGM, gsz = (nM - fm) < WGM ? (nM - fm) : WGM;
        u.pm = fm + ((wgid % nig) % gsz); u.pn = (wgid % nig) / gsz; u.aoff = 0; u.boff = 0; return true;
    }
    __device__ __forceinline__ void a_ready(const Unit&) const {}
    __device__ __forceinline__ void done(const Unit&) const {}
};

__device__ __forceinline__ unsigned cvt_pk_bf16(float lo, float hi) { unsigned r; asm volatile("v_cvt_pk_bf16_f32 %0, %1, %2" : "=v"(r) : "v"(lo), "v"(hi)); return r; }
typedef float f32x2 __attribute__((ext_vector_type(2)));
__device__ __forceinline__ f32x2 gelu_pk(f32x2 v) {
    const f32x2 av = __builtin_elementwise_abs(v), d = av * 0.2316418882f + 1.0f;
    f32x2 t; t.x = __builtin_amdgcn_rcpf(d.x); t.y = __builtin_amdgcn_rcpf(d.y);
    f32x2 q = t * 0.5307027145f + (-0.7265760135f); q = q * t + 0.7107068705f; q = q * t + (-0.142248368f); q = q * t + 0.127414796f; q = q * t;
    const f32x2 s = (v * v) * (-0.72134752044f);
    f32x2 e; e.x = __builtin_amdgcn_exp2f(s.x); e.y = __builtin_amdgcn_exp2f(s.y);
    const f32x2 m = v * (q * e), r = v - m;
    f32x2 o; o.x = v.x < 0.f ? m.x : r.x; o.y = v.y < 0.f ? m.y : r.y; return o;
}

template <int ACT  > struct EpiBf16 {
    static constexpr bool PERM = true, AFTER_DRAIN = false; static_assert(ACT == 0 || ACT == 1, "EpiBf16: ACT is 0 (none) or 1 (gelu_pk)");
    bf16_t* O; int ldc; const float* bias; int split_cols; size_t split_stride; float scale0;
    __device__ __forceinline__ void operator()(const f32x4 (&acc)[2][2][4][2], const Unit& u, int wr, int wc, int fr, int fq) const {
        const int row0 = u.pm * BM + wr * 64 + fr; int colt = u.pn * BM; bf16_t* base = O;
        float sc = 1.f; if (split_cols) { const int t = colt / split_cols; base += (size_t)t * split_stride; colt -= t * split_cols; if (t == 0) sc = scale0; }
        const int col0 = colt + wc * 32 + 8 * fq, bcol0 = u.pn * BM + wc * 32 + 8 * fq;
        f32x4 bv[2][2];
#pragma unroll
        for (int bj = 0; bj < 2; ++bj)
#pragma unroll
            for (int n = 0; n < 2; ++n) bv[bj][n] = bias ? *(const f32x4*)(bias + bcol0 + bj * HALF + 4 * n) : (f32x4){0.f, 0.f, 0.f, 0.f};
#pragma unroll
        for (int ai = 0; ai < 2; ++ai)
#pragma unroll
            for (int m = 0; m < 4; ++m) { bf16_t* rowp = base + (size_t)(row0 + ai * HALF + m * 16) * ldc + col0;
#pragma unroll
                for (int bj = 0; bj < 2; ++bj) { f32x4 v0 = acc[ai][bj][m][0] + bv[bj][0], v1 = acc[ai][bj][m][1] + bv[bj][1];
                    if (ACT == 1) { f32x2 a = gelu_pk((f32x2){v0[0], v0[1]}), b = gelu_pk((f32x2){v0[2], v0[3]}), c = gelu_pk((f32x2){v1[0], v1[1]}), d = gelu_pk((f32x2){v1[2], v1[3]});
                        v0 = (f32x4){a.x, a.y, b.x, b.y}; v1 = (f32x4){c.x, c.y, d.x, d.y}; }
                    v0 = v0 * sc; v1 = v1 * sc; u32x4 w; w.x = cvt_pk_bf16(v0[0], v0[1]); w.y = cvt_pk_bf16(v0[2], v0[3]); w.z = cvt_pk_bf16(v1[0], v1[1]); w.w = cvt_pk_bf16(v1[2], v1[3]);
                    *(u32x4*)(rowp + bj * HALF) = w; } }
    }
};

template <class Epi, class Sched, bool ALIGN_EPI = false, bool SP2 = false, bool FP8 = false>
__device__ __forceinline__ void gemm_phase(PG8_LAS unsigned char* lds, const Gemm g, const Sched& S, const Epi& E) {
    const int tid = threadIdx.x, wid = __builtin_amdgcn_readfirstlane(tid >> 6), lane = tid & 63, wr = wid >> 2, wc = wid & 3, fr = lane & 15, fq = lane >> 4;
    const int K = g.K, nt = K / BK;
    unsigned voffA[2], voffB[2];
#pragma unroll
    for (int i = 0; i < 2; ++i) { int R, C; stage_rc(tid * 16 + i * 8192, R, C); const int Rb = Epi::PERM ? ((R & ~31) + perm32(R & 31)) : R;
        voffA[i] = (unsigned)(R * g.lda + C) * 2u; voffB[i] = (unsigned)(Rb * g.ldb + C) * 2u; }
    const size_t kstep = (size_t)(BK * 2);
    const size_t hstepA = (size_t)HALF * g.lda * 2, hstepB = (size_t)HALF * g.ldb * 2;
    const size_t tstepA = 2 * hstepA, tstepB = 2 * hstepB;
    const unsigned ldsw = (unsigned)wid * 1024u;
    const int aoff = lds_byte(wr * 64 + fr, fq * 8), boff = lds_byte(wc * 32 + fr, fq * 8);
#define PG8_SA(b, h) (((b) * 2 + (h)) * HTB)
#define PG8_SB(b, h) ((4 + (b) * 2 + (h)) * HTB)
#define PG8_STAGE(bufoff, gbase, voff) do { _Pragma("unroll") for (int _i = 0; _i < 2; ++_i) \
        __builtin_amdgcn_global_load_lds((const unsigned*)((const char*)(gbase) + (voff)[_i]), (PG8_LAS unsigned*)(lds + (bufoff) + ldsw + _i * 8192), 16, 0, 0); } while (0)
#define PG8_CAT2(lo, hi) __builtin_shufflevector(__builtin_bit_cast(i32x4, lo), __builtin_bit_cast(i32x4, hi), 0, 1, 2, 3, 4, 5, 6, 7)
#define PG8_LDA(dst, b, h) do { _Pragma("unroll") for (int m = 0; m < 4; ++m) { const bf16x8 lo_ = *(const PG8_LAS bf16x8*)(lds + PG8_SA(b, h) + aoff + m * 2048), hi_ = *(const PG8_LAS bf16x8*)(lds + PG8_SA(b, h) + aoff + m * 2048 + 1024); \
        if constexpr (FP8) dst##8[m] = PG8_CAT2(lo_, hi_); else { dst[m][0] = lo_; dst[m][1] = hi_; } } } while (0)
#define PG8_LDB(dst, b, h) do { _Pragma("unroll") for (int n = 0; n < 2; ++n) { const bf16x8 lo_ = *(const PG8_LAS bf16x8*)(lds + PG8_SB(b, h) + boff + n * 2048), hi_ = *(const PG8_LAS bf16x8*)(lds + PG8_SB(b, h) + boff + n * 2048 + 1024); \
        if constexpr (FP8) dst##8[n] = PG8_CAT2(lo_, hi_); else { dst[n][0] = lo_; dst[n][1] = hi_; } } } while (0)
#define PG8_MMA(ai, bj, At, Bt) do { __builtin_amdgcn_s_setprio(1); \
        if constexpr (FP8) { _Pragma("unroll") for (int m = 0; m < 4; ++m) _Pragma("unroll") for (int n = 0; n < 2; ++n) \
            asm volatile("v_mfma_scale_f32_16x16x128_f8f6f4 %0, %1, %2, %0, %3, %3 op_sel_hi:[0,0,0]" : "+v"(acc[ai][bj][m][n]) : "v"(Bt##8[n]), "v"(At##8[m]), "v"(f8scale)); } \
        else { _Pragma("unroll") for (int m = 0; m < 4; ++m) _Pragma("unroll") for (int n = 0; n < 2; ++n) _Pragma("unroll") for (int k = 0; k < 2; ++k) \
            acc[ai][bj][m][n] = __builtin_amdgcn_mfma_f32_16x16x32_bf16(Bt[n][k], At[m][k], acc[ai][bj][m][n], 0, 0, 0); } \
        __builtin_amdgcn_s_setprio(0); } while (0)
#define PG8_WAIT_V(n) asm volatile("s_waitcnt vmcnt(" #n ")" ::: "memory")
#define PG8_WAIT_L(n) asm volatile("s_waitcnt lgkmcnt(" #n ")" ::: "memory")
#define PG8_BAR __builtin_amdgcn_s_barrier()
#define PG8_SCHED __builtin_amdgcn_sched_barrier(0)
    Unit cur, nxt; int ui = 0;
    if (!S.next(0, cur)) return;
    f32x4 acc[2][2][4][2];
#pragma unroll
    for (int a = 0; a < 2; ++a)
#pragma unroll
        for (int b = 0; b < 2; ++b)
#pragma unroll
            for (int m = 0; m < 4; ++m)
#pragma unroll
                for (int n = 0; n < 2; ++n) acc[a][b][m][n] = (f32x4){0.f, 0.f, 0.f, 0.f};
    bf16x8 At[4][2], B0[2][2], B1[2][2];
    i32x8 At8[4], B08[2], B18[2];
    int f8scale = 0x7f7f7f7f; asm volatile("" : "+v"(f8scale));
    const char* cA = (const char*)g.A + (size_t)cur.pm * tstepA + (size_t)cur.aoff * 2; const char* cB = (const char*)g.Bt + (size_t)cur.pn * tstepB + (size_t)cur.boff * 2;
    S.a_ready(cur);
    if constexpr (SP2) {
        PG8_STAGE(PG8_SB(0, 0), cB, voffB); PG8_STAGE(PG8_SB(0, 1), cB + hstepB, voffB); PG8_STAGE(PG8_SA(0, 0), cA, voffA); PG8_STAGE(PG8_SA(0, 1), cA + hstepA, voffA);
        if (wr == 1) PG8_BAR;
        PG8_WAIT_V(2); PG8_BAR;
        PG8_STAGE(PG8_SB(1, 0), cB + kstep, voffB); PG8_STAGE(PG8_SA(1, 0), cA + kstep, voffA); PG8_STAGE(PG8_SB(1, 1), cB + hstepB + kstep, voffB);
        PG8_WAIT_V(6); PG8_BAR;
    } else {
        PG8_STAGE(PG8_SB(0, 0), cB, voffB); PG8_STAGE(PG8_SA(0, 0), cA, voffA); PG8_STAGE(PG8_SB(0, 1), cB + hstepB, voffB); PG8_STAGE(PG8_SA(0, 1), cA + hstepA, voffA);
        if (wr == 1) PG8_BAR;
        PG8_WAIT_V(4); PG8_BAR;
        PG8_STAGE(PG8_SB(1, 0), cB + kstep, voffB); PG8_STAGE(PG8_SA(1, 0), cA + kstep, voffA); PG8_STAGE(PG8_SB(1, 1), cB + hstepB + kstep, voffB);
        PG8_WAIT_V(6); PG8_BAR;
    }
    for (;;) {
        const bool has_next = S.next(ui + 1, nxt);
        const char* nA = has_next ? (const char*)g.A + (size_t)nxt.pm * tstepA + (size_t)nxt.aoff * 2 : cA; const char* nB = has_next ? (const char*)g.Bt + (size_t)nxt.pn * tstepB + (size_t)nxt.boff * 2 : cB;
        for (int t = 0; t < nt; t += 2) {
            const bool last = (t == nt - 2);
            const char* a1 = cA + (size_t)(t + 1) * kstep;
            const char* a2 = last ? nA : cA + (size_t)(t + 2) * kstep; const char* b2 = last ? nB : cB + (size_t)(t + 2) * kstep;
            const char* a3 = a2 + kstep; const char* b3 = b2 + kstep;
            if (last && has_next) S.a_ready(nxt);
            if constexpr (SP2) {
            PG8_LDB(B0, 0, 0); PG8_LDB(B1, 0, 1); PG8_SCHED; PG8_LDA(At, 0, 0); PG8_STAGE(PG8_SA(1, 1), a1 + hstepA, voffA);
            PG8_WAIT_V(8); PG8_WAIT_L(0); PG8_BAR; PG8_MMA(0, 0, At, B0); PG8_MMA(0, 1, At, B1); PG8_BAR; PG8_SCHED;
            PG8_LDA(At, 0, 1); PG8_STAGE(PG8_SB(0, 0), b2, voffB); PG8_STAGE(PG8_SB(0, 1), b2 + hstepB, voffB); PG8_STAGE(PG8_SA(0, 0), a2, voffA);
            PG8_WAIT_V(8); PG8_WAIT_L(0); PG8_BAR; PG8_MMA(1, 0, At, B0); PG8_MMA(1, 1, At, B1); PG8_BAR; PG8_SCHED;
            PG8_LDB(B0, 1, 0); PG8_LDB(B1, 1, 1); PG8_SCHED; PG8_LDA(At, 1, 0); PG8_STAGE(PG8_SA(0, 1), a2 + hstepA, voffA);
            PG8_WAIT_V(8); PG8_WAIT_L(0); PG8_BAR; PG8_MMA(0, 0, At, B0); PG8_MMA(0, 1, At, B1); PG8_BAR; PG8_SCHED;
            PG8_LDA(At, 1, 1); PG8_STAGE(PG8_SB(1, 0), b3, voffB); PG8_STAGE(PG8_SB(1, 1), b3 + hstepB, voffB); PG8_STAGE(PG8_SA(1, 0), a3, voffA);
            PG8_WAIT_V(8); PG8_WAIT_L(0); PG8_BAR; PG8_MMA(1, 0, At, B0); PG8_MMA(1, 1, At, B1); PG8_BAR; PG8_SCHED;
            } else {
            PG8_LDB(B0, 0, 0); PG8_SCHED; PG8_LDA(At, 0, 0); PG8_STAGE(PG8_SA(1, 1), a1 + hstepA, voffA);
            PG8_WAIT_L(8); PG8_BAR; PG8_WAIT_L(0); PG8_MMA(0, 0, At, B0); PG8_BAR; PG8_SCHED;
            PG8_LDB(B1, 0, 1); PG8_STAGE(PG8_SB(0, 0), b2, voffB);
            PG8_BAR; PG8_WAIT_L(0); PG8_MMA(0, 1, At, B1); PG8_BAR;
            PG8_LDA(At, 0, 1); PG8_STAGE(PG8_SA(0, 0), a2, voffA);
            PG8_BAR; PG8_WAIT_L(0); PG8_MMA(1, 0, At, B0); PG8_BAR; PG8_SCHED;
            PG8_STAGE(PG8_SB(0, 1), b2 + hstepB, voffB);
            PG8_WAIT_V(6); PG8_BAR; PG8_MMA(1, 1, At, B1); PG8_BAR;
            PG8_LDB(B0, 1, 0); PG8_SCHED; PG8_LDA(At, 1, 0); PG8_STAGE(PG8_SA(0, 1), a2 + hstepA, voffA);
            PG8_WAIT_L(8); PG8_BAR; PG8_WAIT_L(0); PG8_MMA(0, 0, At, B0); PG8_BAR; PG8_SCHED;
            PG8_LDB(B1, 1, 1); PG8_STAGE(PG8_SB(1, 0), b3, voffB);
            PG8_BAR; PG8_WAIT_L(0); PG8_MMA(0, 1, At, B1); PG8_BAR;
            PG8_LDA(At, 1, 1); PG8_STAGE(PG8_SA(1, 0), a3, voffA);
            PG8_BAR; PG8_WAIT_L(0); PG8_MMA(1, 0, At, B0); PG8_BAR; PG8_SCHED;
            PG8_STAGE(PG8_SB(1, 1), b3 + hstepB, voffB);
            PG8_WAIT_V(6); PG8_BAR; PG8_MMA(1, 1, At, B1); PG8_BAR;
            }
        }
        if constexpr (FP8) {
            asm volatile("s_nop 15\n\ts_nop 15" ::: "memory");
#pragma unroll
            for (int a_ = 0; a_ < 2; ++a_)
#pragma unroll
                for (int b_ = 0; b_ < 2; ++b_)
                    asm volatile("; acc fence" : "+v"(acc[a_][b_][0][0]), "+v"(acc[a_][b_][0][1]), "+v"(acc[a_][b_][1][0]), "+v"(acc[a_][b_][1][1]), "+v"(acc[a_][b_][2][0]), "+v"(acc[a_][b_][2][1]), "+v"(acc[a_][b_][3][0]), "+v"(acc[a_][b_][3][1]));
        }
        if constexpr (ALIGN_EPI) { if (wr == 0) PG8_BAR; }
        if constexpr (!Epi::AFTER_DRAIN) { E(acc, cur, wr, wc, fr, fq); S.done(cur); }
        if (!has_next) break;
#pragma unroll
        for (int a = 0; a < 2; ++a)
#pragma unroll
            for (int b = 0; b < 2; ++b)
#pragma unroll
                for (int m = 0; m < 4; ++m)
#pragma unroll
                    for (int n = 0; n < 2; ++n) acc[a][b][m][n] = (f32x4){0.f, 0.f, 0.f, 0.f};
        cur = nxt; cA = nA; cB = nB; ++ui;
        if constexpr (ALIGN_EPI) { if (wr == 1) PG8_BAR; }
    }
    PG8_WAIT_V(0);
    if constexpr (!ALIGN_EPI) { if (wr == 0) PG8_BAR; }
    PG8_BAR;
    if constexpr (Epi::AFTER_DRAIN) { E.fused(acc, cur, wr, wc, fr, fq, lds, wid, lane); S.done(cur); }
#undef PG8_SA
#undef PG8_SB
#undef PG8_STAGE
#undef PG8_LDA
#undef PG8_LDB
#undef PG8_MMA
#undef PG8_CAT2
#undef PG8_WAIT_V
#undef PG8_WAIT_L
#undef PG8_BAR
#undef PG8_SCHED
}
}
namespace pg8 {
__device__ __forceinline__ float fsigmoid(float x) { return __builtin_amdgcn_rcpf(1.0f + __builtin_amdgcn_exp2f(-1.4426950408889634f * x)); }
__device__ __forceinline__ float gelu_tanh(float x) { const float y = 1.5957691216057308f * (x + 0.044715f * x * x * x); return x * fsigmoid(y); }
__device__ __forceinline__ float bf_lo(unsigned w) { return __uint_as_float(w << 16); }
__device__ __forceinline__ float bf_hi(unsigned w) { return __uint_as_float(w & 0xffff0000u); }
__device__ __forceinline__ u32x4 pack8(const f32x4 v0, const f32x4 v1) { u32x4 w; w.x = cvt_pk_bf16(v0[0], v0[1]); w.y = cvt_pk_bf16(v0[2], v0[3]); w.z = cvt_pk_bf16(v1[0], v1[1]); w.w = cvt_pk_bf16(v1[2], v1[3]); return w; }
__device__ __forceinline__ void unpack8(const u32x4 w, f32x4& v0, f32x4& v1) { v0 = (f32x4){bf_lo(w.x), bf_hi(w.x), bf_lo(w.y), bf_hi(w.y)}; v1 = (f32x4){bf_lo(w.z), bf_hi(w.z), bf_lo(w.w), bf_hi(w.w)}; }

typedef unsigned u32x2 __attribute__((ext_vector_type(2)));
__device__ __forceinline__ float clamp448(float x) { return __builtin_fminf(__builtin_fmaxf(x, -448.0f), 448.0f); }
__device__ __forceinline__ unsigned pk4_fp8(float a, float b, float c, float d) {
    int w = 0; w = __builtin_amdgcn_cvt_pk_fp8_f32(clamp448(a), clamp448(b), w, false); w = __builtin_amdgcn_cvt_pk_fp8_f32(clamp448(c), clamp448(d), w, true); return (unsigned)w; }
constexpr float F8_SW = 256.0f, F8_SX = 16.0f, F8_SH = 8.0f;

struct EpiInProj {
    static constexpr bool PERM = true, AFTER_DRAIN = false;
    bf16_t* O; const float* gate_b; int pn0;
    __device__ __forceinline__ void operator()(const f32x4 (&acc)[2][2][4][2], const Unit& u, int wr, int wc, int fr, int fq) const {
        asm volatile("" : "+v"(fr), "+v"(fq));
        const int pn = u.pn + pn0; const int row0 = u.pm * BM + wr * 64 + fr, col0 = pn * BM + wc * 32 + 8 * fq;
        const int mode = pn < 4 ? 1 : (pn >= 23 ? 2 : 0);
        f32x4 bv[2][2];
#pragma unroll
        for (int bj = 0; bj < 2; ++bj)
#pragma unroll
            for (int n = 0; n < 2; ++n) bv[bj][n] = (mode == 2) ? *(const f32x4*)(gate_b + (col0 - 5888) + bj * HALF + 4 * n) : (f32x4){0.f, 0.f, 0.f, 0.f};
#pragma unroll
        for (int ai = 0; ai < 2; ++ai)
#pragma unroll
            for (int m = 0; m < 4; ++m) { bf16_t* rowp = O + (size_t)(row0 + ai * HALF + m * 16) * 12032 + col0;
#pragma unroll
                for (int bj = 0; bj < 2; ++bj) { f32x4 v0 = acc[ai][bj][m][0] + bv[bj][0], v1 = acc[ai][bj][m][1] + bv[bj][1];
                    if (mode == 1) {
#pragma unroll
                        for (int e = 0; e < 4; ++e) { v0[e] = gelu_tanh(v0[e]); v1[e] = gelu_tanh(v1[e]); } }
                    else if (mode == 2) {
#pragma unroll
                        for (int e = 0; e < 4; ++e) { v0[e] = fsigmoid(v0[e]); v1[e] = fsigmoid(v1[e]); } }
                    *(u32x4*)(rowp + bj * HALF) = pack8(v0, v1); } }
    }
};

struct EpiGate8 {
    static constexpr bool PERM = true, AFTER_DRAIN = false;
    bf16_t* O; const float* gate_b; float inv;
    __device__ __forceinline__ void operator()(const f32x4 (&acc)[2][2][4][2], const Unit& u, int wr, int wc, int fr, int fq) const {
        asm volatile("" : "+v"(fr), "+v"(fq));
        const int row0 = u.pm * BM + wr * 64 + fr, col0 = u.pn * BM + wc * 32 + 8 * fq;
#ifndef GATE_RAW
        f32x4 bv[2][2];
#pragma unroll
        for (int bj = 0; bj < 2; ++bj)
#pragma unroll
            for (int n = 0; n < 2; ++n) bv[bj][n] = *(const f32x4*)(gate_b + col0 + bj * HALF + 4 * n);
#endif
#pragma unroll
        for (int ai = 0; ai < 2; ++ai)
#pragma unroll
            for (int m = 0; m < 4; ++m) { bf16_t* rowp = O + (size_t)(row0 + ai * HALF + m * 16) * 12032 + 5888 + col0;
#pragma unroll
                for (int bj = 0; bj < 2; ++bj) {
#ifdef GATE_RAW
                    *(u32x4*)(rowp + bj * HALF) = pack8(acc[ai][bj][m][0] * inv, acc[ai][bj][m][1] * inv);
#else
                    f32x4 v0 = acc[ai][bj][m][0] * inv + bv[bj][0], v1 = acc[ai][bj][m][1] * inv + bv[bj][1];
#pragma unroll
                    for (int e = 0; e < 4; ++e) { v0[e] = fsigmoid(v0[e]); v1[e] = fsigmoid(v1[e]); }
                    *(u32x4*)(rowp + bj * HALF) = pack8(v0, v1);
#endif
                } }
    }
};

struct EpiLora {
    static constexpr bool PERM = true, AFTER_DRAIN = false;
    bf16_t* PROJ; const bf16_t* KK; const bf16_t* RSK; bf16_t* G; const float* w0; const float* a0; const float* ka;
    __device__ __forceinline__ void operator()(const f32x4 (&acc)[2][2][4][2], const Unit& u, int wr, int wc, int fr, int fq) const {
        asm volatile("" : "+v"(fr), "+v"(fq));
        const int row0 = u.pm * BM + wr * 64 + fr, ch0 = (u.pn & 1) * BM + wc * 32 + 8 * fq, kind = u.pn >> 1;
        if (kind == 0) {
#pragma unroll
            for (int bj = 0; bj < 2; ++bj) { const int ch = ch0 + bj * HALF; const f32x4 b0 = *(const f32x4*)(w0 + ch), b1 = *(const f32x4*)(w0 + ch + 4);
#pragma unroll
                for (int ai = 0; ai < 2; ++ai)
#pragma unroll
                    for (int m = 0; m < 4; ++m) { const size_t row = (size_t)(row0 + ai * HALF + m * 16);
                        f32x4 v0 = acc[ai][bj][m][0] + b0, v1 = acc[ai][bj][m][1] + b1;
#pragma unroll
                        for (int e = 0; e < 4; ++e) { v0[e] = -0.6065306597126334f * fsigmoid(v0[e]); v1[e] = -0.6065306597126334f * fsigmoid(v1[e]); }
                        *(u32x4*)(PROJ + row * 12032 + 3840 + ch) = pack8(v0, v1); } }
        } else if (kind == 1) {
            f32x4 b0[2], b1[2], c0[2], c1[2];
#pragma unroll
            for (int bj = 0; bj < 2; ++bj) { const int ch = ch0 + bj * HALF; b0[bj] = *(const f32x4*)(a0 + ch); b1[bj] = *(const f32x4*)(a0 + ch + 4); c0[bj] = *(const f32x4*)(ka + ch); c1[bj] = *(const f32x4*)(ka + ch + 4); }
#pragma unroll
            for (int ai = 0; ai < 2; ++ai)
#pragma unroll
                for (int m = 0; m < 4; ++m) { size_t row = (size_t)(row0 + ai * HALF + m * 16); asm volatile("" : "+v"(row));
                    const bf16_t* kr = RSK + row * 512 + ch0; const bf16_t* qr = KK + row * 512 + ch0; bf16_t* pr = PROJ + row * 12032 + ch0;
#pragma unroll
                    for (int bj = 0; bj < 2; ++bj) {
                        const u32x4 kw = *(const u32x4*)(kr + bj * HALF), qw = *(const u32x4*)(qr + bj * HALF);
                        f32x4 k0, k1, q0, q1; unpack8(kw, k0, k1); unpack8(qw, q0, q1);
                        f32x4 p0, p1;
#pragma unroll
                        for (int e = 0; e < 4; ++e) { const float a_0 = fsigmoid(acc[ai][bj][m][0][e] + b0[bj][e]), a_1 = fsigmoid(acc[ai][bj][m][1][e] + b1[bj][e]);
                            p0[e] = k0[e] * (1.0f + (a_0 - 1.0f) * c0[bj][e]); p1[e] = k1[e] * (1.0f + (a_1 - 1.0f) * c1[bj][e]); q0[e] *= a_0; q1[e] *= a_1; }
                        *(u32x4*)(pr + 4352 + bj * HALF) = pack8(q0, q1);
                        *(u32x4*)(pr + 4864 + bj * HALF) = pack8(p0, p1); }
                    asm volatile("" ::: "memory"); }
        } else {
#pragma unroll
            for (int bj = 0; bj < 2; ++bj) { const int ch = ch0 + bj * HALF;
#pragma unroll
                for (int ai = 0; ai < 2; ++ai)
#pragma unroll
                    for (int m = 0; m < 4; ++m) { const size_t row = (size_t)(row0 + ai * HALF + m * 16); *(u32x4*)(G + row * 512 + ch) = pack8(acc[ai][bj][m][0], acc[ai][bj][m][1]); } }
        }
    }
};

struct EpiMerge {
    static constexpr bool PERM = true, AFTER_DRAIN = false;
    const bf16_t* PROJ; bf16_t* MG; const float* gate_b;
    __device__ __forceinline__ void operator()(const f32x4 (&acc)[2][2][4][2], const Unit& u, int wr, int wc, int fr, int fq) const {
        asm volatile("" : "+v"(fr), "+v"(fq));
        const int row0 = u.pm * BM + wr * 64 + fr, col0 = u.pn * BM + wc * 32 + 8 * fq, ks = u.boff >> 9, gi = ks > 2 ? 2 : ks;
#pragma unroll
        for (int ai = 0; ai < 2; ++ai)
#pragma unroll
            for (int m = 0; m < 4; ++m) { const size_t row = (size_t)(row0 + ai * HALF + m * 16);
#pragma unroll
                for (int bj = 0; bj < 2; ++bj) { const int col = col0 + bj * HALF;
                    f32x4 g0, g1, p0 = (f32x4){0.f, 0.f, 0.f, 0.f}, p1 = p0;
                    unpack8(*(const u32x4*)(PROJ + row * 12032 + 5888 + gi * 2048 + col), g0, g1);
#ifdef GATE_RAW
                    { const f32x4 b0 = *(const f32x4*)(gate_b + gi * 2048 + col), b1 = *(const f32x4*)(gate_b + gi * 2048 + col + 4);
#pragma unroll
                      for (int e = 0; e < 4; ++e) { g0[e] = fsigmoid(g0[e] + b0[e]); g1[e] = fsigmoid(g1[e] + b1[e]); } }
#endif
                    if (ks != 0) unpack8(*(const u32x4*)(MG + row * 2048 + col), p0, p1);
                    p0 = p0 + g0 * acc[ai][bj][m][0]; p1 = p1 + g1 * acc[ai][bj][m][1];
                    *(u32x4*)(MG + row * 2048 + col) = pack8(p0, p1); } }
    }
};

struct EpiResid {
    static constexpr bool PERM = false, AFTER_DRAIN = false;
    const float* hin; float* out;
    __device__ __forceinline__ void operator()(const f32x4 (&acc)[2][2][4][2], const Unit& u, int wr, int wc, int fr, int fq) const {
        asm volatile("" : "+v"(fr), "+v"(fq));
        const int row0 = u.pm * BM + wr * 64 + fr, col0 = u.pn * BM + wc * 32 + 4 * fq;
#pragma unroll
        for (int ai = 0; ai < 2; ++ai)
#pragma unroll
            for (int m = 0; m < 4; ++m) { const size_t off = (size_t)(row0 + ai * HALF + m * 16) * 2048 + col0;
#pragma unroll
                for (int bj = 0; bj < 2; ++bj)
#pragma unroll
                    for (int n = 0; n < 2; ++n) { const f32x4 bs = *(const f32x4*)(hin + off + bj * HALF + n * 16); *(f32x4*)(out + off + bj * HALF + n * 16) = bs + acc[ai][bj][m][n]; } }
    }
};

struct EpiSwiGLU {
    static constexpr bool PERM = true, AFTER_DRAIN = false;
    bf16_t* O; int ldc, nt;
    __device__ __forceinline__ void operator()(const f32x4 (&acc)[2][2][4][2], const Unit& u, int wr, int wc, int fr, int fq) const {
        asm volatile("" : "+v"(fr), "+v"(fq));
        const int row0 = u.pm * BM + wr * 64 + fr, col0 = (u.pn % nt) * HALF + wc * 32 + 8 * fq;
#pragma unroll
        for (int ai = 0; ai < 2; ++ai)
#pragma unroll
            for (int m = 0; m < 4; ++m) { bf16_t* rowp = O + (size_t)(row0 + ai * HALF + m * 16) * ldc + col0;
                f32x4 v0, v1;
#pragma unroll
                for (int e = 0; e < 4; ++e) { const float a_0 = acc[ai][0][m][0][e], a_1 = acc[ai][0][m][1][e];
                    v0[e] = a_0 * fsigmoid(a_0) * acc[ai][1][m][0][e]; v1[e] = a_1 * fsigmoid(a_1) * acc[ai][1][m][1][e]; }
                *(u32x4*)rowp = pack8(v0, v1); }
    }
};

struct EpiSwiGLU8 {
    static constexpr bool PERM = true, AFTER_DRAIN = false;
    unsigned char* O; int ldc, nt; float inv_sin;
    __device__ __forceinline__ void operator()(const f32x4 (&acc)[2][2][4][2], const Unit& u, int wr, int wc, int fr, int fq) const {
        asm volatile("" : "+v"(fr), "+v"(fq));
        const int row0 = u.pm * BM + wr * 64 + fr, col0 = (u.pn % nt) * HALF + wc * 32 + 8 * fq;
#pragma unroll
        for (int ai = 0; ai < 2; ++ai)
#pragma unroll
            for (int m = 0; m < 4; ++m) { unsigned char* rowp = O + (size_t)(row0 + ai * HALF + m * 16) * ldc + col0;
                f32x4 v0, v1;
#pragma unroll
                for (int e = 0; e < 4; ++e) { const float a_0 = acc[ai][0][m][0][e] * inv_sin, a_1 = acc[ai][0][m][1][e] * inv_sin;
                    v0[e] = a_0 * fsigmoid(a_0) * (acc[ai][1][m][0][e] * inv_sin) * F8_SH; v1[e] = a_1 * fsigmoid(a_1) * (acc[ai][1][m][1][e] * inv_sin) * F8_SH; }
                u32x2 w; w.x = pk4_fp8(v0[0], v0[1], v0[2], v0[3]); w.y = pk4_fp8(v1[0], v1[1], v1[2], v1[3]);
                *(u32x2*)rowp = w; }
    }
};

struct EpiPlain {
    static constexpr bool PERM = true, AFTER_DRAIN = false;
    bf16_t* O; int ldc, nt; float scale;
    __device__ __forceinline__ void operator()(const f32x4 (&acc)[2][2][4][2], const Unit& u, int wr, int wc, int fr, int fq) const {
        asm volatile("" : "+v"(fr), "+v"(fq));
        const int row0 = u.pm * BM + wr * 64 + fr, col0 = (u.pn % nt) * BM + wc * 32 + 8 * fq;
#pragma unroll
        for (int ai = 0; ai < 2; ++ai)
#pragma unroll
            for (int m = 0; m < 4; ++m) { bf16_t* rowp = O + (size_t)(row0 + ai * HALF + m * 16) * ldc + col0;
#pragma unroll
                for (int bj = 0; bj < 2; ++bj) *(u32x4*)(rowp + bj * HALF) = pack8(acc[ai][bj][m][0] * scale, acc[ai][bj][m][1] * scale); }
    }
};

struct MergeOrder {
    StaticOrder so;
    __device__ __forceinline__ bool next(int i, Unit& u) const {
        if (!so.next(i >> 2, u)) return false;
        const int ks = i & 3; u.boff = ks * 512; u.aoff = ks == 0 ? 0 : (ks == 1 ? 1024 : (ks == 2 ? 2816 : 3328)); return true;
    }
    __device__ __forceinline__ void a_ready(const Unit&) const {}
    __device__ __forceinline__ void done(const Unit&) const {}
};

struct MoeOrder {
    int ts[8]; int nrt, nt, G, c;
    __device__ __forceinline__ bool next(int i, Unit& u) const {
        const long L = (long)i * G + c; if (L >= (long)nrt * nt) return false;
        const int rt = (int)(L / nt), pnl = (int)(L % nt); int e = 0;
#pragma unroll
        for (int j = 1; j < 8; ++j) e += (rt >= ts[j]) ? 1 : 0;
        u.pm = rt; u.pn = e * nt + pnl; u.aoff = 0; u.boff = 0; return true;
    }
    __device__ __forceinline__ void a_ready(const Unit&) const {}
    __device__ __forceinline__ void done(const Unit&) const {}
};
}

#ifndef PG8_SP2
#define PG8_SP2 true
#endif
#ifndef PG8_ALIGN
#define PG8_ALIGN true
#endif
constexpr int NWAVES = 8;
constexpr int BATCH = 8, SEQ = 2048, DM = 2048, M = BATCH * SEQ;
constexpr int NIN = 12032, GM_OFF = 0, RW_OFF = 1024, SB_OFF = 2816, GATE_OFF = 5888;
constexpr int C_LW = 3840, C_KKA = 4352, C_KP = 4864;
constexpr int YRAW_BYTE = 3072;
constexpr int DFF = 5632, DFE = 2816, NEXP = 8;
constexpr int XG_ROWS = 2 * M + NEXP * 256;
constexpr int N_PHASES = 24;
constexpr size_t MiB = 1u << 20;
constexpr size_t WS_CTL = 0, WS_LORA = 1 * MiB, ZERO_BYTES = 3 * MiB;
constexpr size_t WS_TAB = 3 * MiB, WS_GMW = 4 * MiB;
constexpr size_t WS_WIN = 5 * MiB, WS_PC = 99 * MiB, WS_WO = 115 * MiB, WS_W13 = 131 * MiB, WS_W2 = 175 * MiB, WS_W13E = 197 * MiB, WS_W2E = 373 * MiB;
constexpr size_t WS_XN = 461 * MiB, WS_PROJ = 525 * MiB, WS_RWT = 901 * MiB, WS_XN8 = 989 * MiB, WS_END = 1021 * MiB;
constexpr size_t WS_H = WS_PROJ;
constexpr size_t WS_XG = 525 * MiB, WS_HX = 661 * MiB, WS_Y2 = 848 * MiB;
static_assert(WS_Y2 + (size_t)XG_ROWS * DM * 2 <= WS_XN8 && WS_HX + (size_t)XG_ROWS * DFE * 2 <= WS_Y2 && WS_XG + (size_t)XG_ROWS * DM * 2 <= WS_HX, "moe overlay");
static_assert(WS_PROJ + (size_t)M * NIN * 2 <= WS_RWT && WS_H + (size_t)M * DFF * 2 <= WS_RWT && WS_RWT + (size_t)M * (5 * 512 + 256) * 2 <= WS_XN8 && WS_XN8 + (size_t)M * DM <= WS_END, "ws map");
constexpr size_t RWT_R = 0, RWT_K = (size_t)M * 512, RWT_V = 2 * (size_t)M * 512, RWT_KK = 3 * (size_t)M * 512, RWT_G = 4 * (size_t)M * 512, RWT_LA = 5 * (size_t)M * 512;
constexpr int CW_BAR = 4096, CW_CNT = 1024;
constexpr int LDS_BYTES = 147456, LDSCTL_OFF = LDS_BYTES - 1024;

#define GAS __attribute__((address_space(1)))
#define LAS __attribute__((address_space(3)))
typedef unsigned short bf16;
typedef unsigned v4u __attribute__((ext_vector_type(4)));
typedef unsigned v2u __attribute__((ext_vector_type(2)));
typedef float f32x4 __attribute__((ext_vector_type(4)));
typedef float f32x16 __attribute__((ext_vector_type(16)));
typedef short bf16x8 __attribute__((ext_vector_type(8)));
typedef GAS unsigned gu32;
#define RLX_AGENT __ATOMIC_RELAXED, __HIP_MEMORY_SCOPE_AGENT
#define LDS_WAIT() asm volatile("s_waitcnt lgkmcnt(0)" ::: "memory")
#define VM_WAIT() asm volatile("s_waitcnt vmcnt(0)" ::: "memory")
__device__ __forceinline__ unsigned f2bf(float f) { unsigned u = __builtin_bit_cast(unsigned, f); return (u + 0x7fffu + ((u >> 16) & 1u)) >> 16; }
typedef float f32x2_t __attribute__((ext_vector_type(2))); typedef __bf16 bf16x2_t __attribute__((ext_vector_type(2)));
__device__ __forceinline__ unsigned pk2(float lo, float hi) { f32x2_t v = {lo, hi}; bf16x2_t b = __builtin_convertvector(v, bf16x2_t); return __builtin_bit_cast(unsigned, b); }
__device__ __forceinline__ float bfl(unsigned w) { return __uint_as_float(w << 16); }
__device__ __forceinline__ float bfh(unsigned w) { return __uint_as_float(w & 0xffff0000u); }
__device__ __forceinline__ float bf1(bf16 h) { return __uint_as_float((unsigned)h << 16); }
__device__ __forceinline__ float fsig(float x) { return __builtin_amdgcn_rcpf(1.0f + __builtin_amdgcn_exp2f(-1.4426950408889634f * x)); }
__device__ __forceinline__ void unpk8(const v4u w, float (&v)[8]) { v[0] = bfl(w.x); v[1] = bfh(w.x); v[2] = bfl(w.y); v[3] = bfh(w.y); v[4] = bfl(w.z); v[5] = bfh(w.z); v[6] = bfl(w.w); v[7] = bfh(w.w); }
__device__ __forceinline__ v4u pk8(const float (&v)[8]) { v4u w; w.x = pk2(v[0], v[1]); w.y = pk2(v[2], v[3]); w.z = pk2(v[4], v[5]); w.w = pk2(v[6], v[7]); return w; }

#define XB_TMO      128
#define XB_XCNT(j)  (256  + 64 * (j))
#define XB_XSUB(j)  (1280 + 64 * (j))
#define XB_XGEN(j)  (2304 + 64 * (j))
#define XB_TOP      3328
#define XB_TOPGEN   3392
#define XCD_BAR_WORDS 3456
#define XB_SPIN_CAP (1u << 18)
__device__ __forceinline__ unsigned xb_ld(unsigned* p)              { return __hip_atomic_load(p, __ATOMIC_RELAXED, __HIP_MEMORY_SCOPE_AGENT); }
__device__ __forceinline__ unsigned xb_add(unsigned* p, unsigned v) { return __hip_atomic_fetch_add(p, v, __ATOMIC_RELAXED, __HIP_MEMORY_SCOPE_AGENT); }
__device__ __forceinline__ unsigned xb_xcc_id() { return (unsigned)__builtin_amdgcn_s_getreg((3 << 11) | 20) & 0xFu; }
#define XB_SPIN(cond, bar) do { unsigned _sp = 0; while (cond) { __builtin_amdgcn_s_sleep(1); \
    if ((++_sp & 255u) == 0u) { if (xb_ld(&(bar)[XB_TMO])) break; if (_sp > XB_SPIN_CAP) { atomicAdd(&(bar)[XB_TMO], 1u); break; } } } } while (0)
struct XcdBarrier { unsigned* bar; unsigned x; volatile LAS unsigned* st; };
__device__ __forceinline__ XcdBarrier xcd_barrier_post(unsigned* bar, volatile LAS unsigned* st) {
    XcdBarrier b; b.bar = bar; b.x = xb_xcc_id(); b.st = st;
    if (threadIdx.x == 0) (void)xb_add(&bar[XB_XCNT(b.x)], 1u);
    return b;
}
__device__ __forceinline__ void xcd_barrier_complete(unsigned* bar, unsigned x, unsigned& nloc, unsigned& nx) {
    const unsigned G = gridDim.x * gridDim.y * gridDim.z;
    unsigned sum, cnt, mine, sp = 0u;
    for (;;) {
        sum = 0u; cnt = 0u; mine = 0u;
#pragma unroll
        for (unsigned j = 0; j < 16; ++j) { const unsigned c = xb_ld(&bar[XB_XCNT(j)]); sum += c; cnt += (c > 0u) ? 1u : 0u; mine = (j == x) ? c : mine; }
        if (sum == G) break;
        __builtin_amdgcn_s_sleep(1);
        if ((++sp & 255u) == 0u) { if (xb_ld(&bar[XB_TMO])) break; if (sp > XB_SPIN_CAP) { atomicAdd(&bar[XB_TMO], 1u); break; } }
    }
    nloc = mine > 0u ? mine : 1u; nx = cnt > 0u ? cnt : 1u;
}
__device__ __forceinline__ void xcd_barrier(const XcdBarrier& b) {
    asm volatile("s_waitcnt vmcnt(0)" ::: "memory");
    __syncthreads();
    if (threadIdx.x == 0) {
        unsigned* bar = b.bar;
        __builtin_amdgcn_s_waitcnt(0);
        unsigned nloc = b.st[0], nx = b.st[1];
        if (nloc == 0u) { xcd_barrier_complete(bar, b.x, nloc, nx); b.st[0] = nloc; b.st[1] = nx; }
        const unsigned old = xb_add(&bar[XB_XSUB(b.x)], 1u);
        const unsigned gen = old / nloc;
        if (old + 1u == (gen + 1u) * nloc) {
            __builtin_amdgcn_fence(__ATOMIC_RELEASE, "agent");
            asm volatile("s_waitcnt vmcnt(0)" ::: "memory");
            const unsigned og = xb_add(&bar[XB_TOP], 1u);
            const unsigned tg = og / nx;
            if (og + 1u == (tg + 1u) * nx) xb_add(&bar[XB_TOPGEN], 1u);
            else XB_SPIN(xb_ld(&bar[XB_TOPGEN]) == tg, bar);
            __builtin_amdgcn_fence(__ATOMIC_ACQUIRE, "agent");
            xb_add(&bar[XB_XGEN(b.x)], 1u);
            asm volatile("s_waitcnt vmcnt(0)" ::: "memory");
        } else {
            XB_SPIN(xb_ld(&bar[XB_XGEN(b.x)]) == gen, bar);
            __builtin_amdgcn_fence(__ATOMIC_ACQUIRE, "agent");
            asm volatile("s_waitcnt vmcnt(0)" ::: "memory");
        }
    }
    __syncthreads();
}

struct Frame {
    LAS unsigned char* lds;
    unsigned char* ws;
    const float* const* in;
    int tid, lane, wave, G, gw, ngw;
};
__device__ __forceinline__ float wave_sum(float v) {
#pragma unroll
    for (int o = 1; o < 64; o <<= 1) v += __shfl_xor(v, o);
    return v;
}
__device__ __forceinline__ float sum8(float v) { v += __shfl_xor(v, 1); v += __shfl_xor(v, 2); v += __shfl_xor(v, 4); return v; }

__device__ __forceinline__ void tr_item(const float* W, int N, bf16* WT, int ldo, int koff, int rowbase, int mode, float sc, LAS float* scr, int k0, int n0, int lane) {
    const int lq = lane & 15, lr = lane >> 4;
#pragma unroll 4
    for (int i = 0; i < 16; ++i) { const int kk = 4 * i + lr; const f32x4 v = *(const GAS f32x4*)(W + (size_t)(k0 + kk) * N + n0 + 4 * lq);
        LAS float* s = scr + kk * 65 + 4 * lq; s[0] = v.x * sc; s[1] = v.y * sc; s[2] = v.z * sc; s[3] = v.w * sc; }
    LDS_WAIT(); asm volatile("" ::: "memory");
    const int c = lane & 7, ns = lane >> 3;
#pragma unroll
    for (int j = 0; j < 8; ++j) { const int n = n0 + ns + 8 * j; const int row = rowbase + (mode ? ((n >> 7) * 256 + (n & 127) + (mode == 2 ? 128 : 0)) : n);
        const LAS float* s = scr + (8 * c) * 65 + ns + 8 * j;
        v4u o; o.x = pk2(s[0 * 65], s[1 * 65]); o.y = pk2(s[2 * 65], s[3 * 65]); o.z = pk2(s[4 * 65], s[5 * 65]); o.w = pk2(s[6 * 65], s[7 * 65]);
        *(GAS v4u*)(WT + (size_t)row * ldo + koff + k0 + 8 * c) = o; }
    LDS_WAIT(); asm volatile("" ::: "memory");
}

__device__ __forceinline__ void rms_row_to_bf16(const float* xrow, const float* gain, bf16* orow, int lane, unsigned char* o8row) {
    const GAS f32x4* xr = (const GAS f32x4*)xrow + lane; const GAS f32x4* gr = (const GAS f32x4*)gain + lane;
    f32x4 v[8]; float s = 0.f;
#pragma unroll
    for (int j = 0; j < 8; ++j) { v[j] = xr[64 * j]; s += (v[j].x * v[j].x + v[j].y * v[j].y) + (v[j].z * v[j].z + v[j].w * v[j].w); }
    const float rstd = 1.0f / sqrtf(wave_sum(s) * (1.f / DM) + 1e-6f);
    GAS v2u* o8 = (GAS v2u*)orow + lane;
#pragma unroll
    for (int j = 0; j < 8; ++j) { const f32x4 g = gr[64 * j]; const float n0 = v[j].x * rstd * g.x, n1 = v[j].y * rstd * g.y, n2 = v[j].z * rstd * g.z, n3 = v[j].w * rstd * g.w;
        v2u o; o.x = pk2(n0, n1); o.y = pk2(n2, n3); o8[64 * j] = o;
        ((GAS unsigned*)o8row)[lane + 64 * j] = pg8::pk4_fp8(n0 * pg8::F8_SX, n1 * pg8::F8_SX, n2 * pg8::F8_SX, n3 * pg8::F8_SX); }
}
#ifdef EXP_BF16SPLIT
#define CONV_F8_LAYER(j) false
#elif defined(EXP_L)
#define CONV_F8_LAYER(j) (((j) == 0 ? 0 : 1) == EXP_L)
#else
#define CONV_F8_LAYER(j) true
#endif

struct In { const float* p[33]; };
constexpr int NJOBS = 43, JOBS_PRO = 4, JOBS_BG0 = 27;
__device__ __forceinline__ void tr_load32(f32x4 (&v)[8], const float* W, int N, int k0, int n0, int lane) {
    const int lq = lane & 15, lr = lane >> 4;
#pragma unroll
    for (int i = 0; i < 8; ++i) v[i] = *(const GAS f32x4*)(W + (size_t)(k0 + 4 * i + lr) * N + n0 + 4 * lq);
}
__device__ __forceinline__ void tr_store32(const f32x4 (&v)[8], bf16* WT, int ldo, int koff, int rowbase, int mode, float sc, LAS float* scr, int k0, int n0, int lane) {
    const int lq = lane & 15, lr = lane >> 4;
#pragma unroll
    for (int i = 0; i < 8; ++i) { LAS float* s = scr + (4 * i + lr) * 65 + 4 * lq; s[0] = v[i].x; s[1] = v[i].y; s[2] = v[i].z; s[3] = v[i].w; }
    LDS_WAIT(); asm volatile("" ::: "memory");
    const int c = lane & 3, ns = lane >> 2;
#pragma unroll
    for (int j = 0; j < 4; ++j) { const int n = n0 + ns + 16 * j; const int row = rowbase + (mode ? ((n >> 7) * 256 + (n & 127) + (mode == 2 ? 128 : 0)) : n);
        const LAS float* s = scr + (8 * c) * 65 + ns + 16 * j;
        v4u o; o.x = pk2(s[0 * 65] * sc, s[1 * 65] * sc); o.y = pk2(s[2 * 65] * sc, s[3 * 65] * sc); o.z = pk2(s[4 * 65] * sc, s[5 * 65] * sc); o.w = pk2(s[6 * 65] * sc, s[7 * 65] * sc);
        *(GAS v4u*)(WT + (size_t)row * ldo + koff + k0 + 8 * c) = o; }
    LDS_WAIT(); asm volatile("" ::: "memory");
}
__device__ __forceinline__ void tr_store32_f8(const f32x4 (&v)[8], unsigned char* WT, int ldo, int koff, int rowbase, int mode, float sc, LAS float* scr, int k0, int n0, int lane) {
    const int lq = lane & 15, lr = lane >> 4;
#pragma unroll
    for (int i = 0; i < 8; ++i) { LAS float* s = scr + (4 * i + lr) * 65 + 4 * lq; s[0] = v[i].x; s[1] = v[i].y; s[2] = v[i].z; s[3] = v[i].w; }
    LDS_WAIT(); asm volatile("" ::: "memory");
    const int c = lane & 1, ns = lane >> 1;
#pragma unroll
    for (int j = 0; j < 2; ++j) { const int n = n0 + ns + 32 * j; const int row = rowbase + (mode ? ((n >> 7) * 256 + (n & 127) + (mode == 2 ? 128 : 0)) : n);
        const LAS float* s = scr + (16 * c) * 65 + ns + 32 * j;
        v4u o;
        o.x = pg8::pk4_fp8(s[0 * 65] * sc, s[1 * 65] * sc, s[2 * 65] * sc, s[3 * 65] * sc);   o.y = pg8::pk4_fp8(s[4 * 65] * sc, s[5 * 65] * sc, s[6 * 65] * sc, s[7 * 65] * sc);
        o.z = pg8::pk4_fp8(s[8 * 65] * sc, s[9 * 65] * sc, s[10 * 65] * sc, s[11 * 65] * sc); o.w = pg8::pk4_fp8(s[12 * 65] * sc, s[13 * 65] * sc, s[14 * 65] * sc, s[15 * 65] * sc);
        *(GAS v4u*)(WT + (size_t)row * ldo + koff + k0 + 16 * c) = o; }
    LDS_WAIT(); asm volatile("" ::: "memory");
}
__device__ __forceinline__ void conv_jobs(const LAS unsigned long long* ptab, unsigned char* ws, int jlo, int jhi, int wid, int nw, LAS float* scr, int lane) {
    int rot = 0;
    for (int j = jlo; j < jhi; ++j) {
        int pi; size_t wo = 0, wso; size_t wto = 0; int Kd, N, ldo, koff = 0, rowbase = 0, mode = 0, slo = 0, shi = 0;
        if (j == 0 || j == 11) { const int l = j == 0 ? 0 : 1; pi = 2; wo = (size_t)l * 2048 * NIN; Kd = 2048; N = NIN; wso = WS_WIN; wto = (size_t)l * NIN * 2048; ldo = 2048; slo = SB_OFF; shi = SB_OFF + 1024; }
        else if ((j >= 1 && j < 4) || (j >= 12 && j < 15)) { const int l = j < 4 ? 0 : 1, q = j < 4 ? j - 1 : j - 12;
            pi = q == 0 ? 10 : (q == 1 ? 12 : 13); wo = (size_t)l * (q == 2 ? 128 : 64) * 512; Kd = q == 2 ? 128 : 64; N = 512;
            wso = WS_LORA; wto = (size_t)l * 1536 * 256; ldo = 256; koff = 64 * q; rowbase = 512 * q; }
        else if ((j >= 4 && j < 7) || (j >= 15 && j < 18)) { const int l = j < 7 ? 0 : 1, q = j < 7 ? j - 4 : j - 15;
            pi = 19 + q; wo = (size_t)l * (q == 2 ? 1024 : 512) * 2048; Kd = q == 2 ? 1024 : 512; N = 2048;
            wso = WS_PC; wto = (size_t)l * 2048 * 2048; ldo = 2048; koff = 512 * q; }
        else if (j == 7 || j == 18) { const int l = j == 7 ? 0 : 1; pi = 22; wo = (size_t)l * 2048 * 2048; Kd = 2048; N = 2048; wso = WS_WO; wto = (size_t)l * 2048 * 2048; ldo = 2048; }
        else if (j == 8)  { pi = 24; Kd = 2048; N = DFF; wso = WS_W13; ldo = 2048; mode = 1; }
        else if (j == 9)  { pi = 25; Kd = 2048; N = DFF; wso = WS_W13; ldo = 2048; mode = 2; }
        else if (j == 10) { pi = 26; Kd = DFF; N = 2048; wso = WS_W2; ldo = DFF; }
        else if (j < 27) { const int e = j - 19; pi = 29; wo = (size_t)e * 2048 * DFE; Kd = 2048; N = DFE; wso = WS_W13E; ldo = 2048; rowbase = e * 2 * DFE; mode = 1; }
        else if (j < 35) { const int e = j - 27; pi = 30; wo = (size_t)e * 2048 * DFE; Kd = 2048; N = DFE; wso = WS_W13E; ldo = 2048; rowbase = e * 2 * DFE; mode = 2; }
        else             { const int e = j - 35; pi = 31; wo = (size_t)e * DFE * 2048; Kd = DFE; N = 2048; wso = WS_W2E; ldo = DFE; rowbase = e * 2048; }
        const float* W = (const float*)ptab[pi] + wo; bf16* WT = (bf16*)(ws + wso) + wto;
        const int nnb = N / 64, nitems = (Kd / 32) * nnb;
        int start = wid - rot; if (start < 0) start += nw;
#define CV_LOAD(V, it_) do { const int kb_ = (it_) / nnb, nb_ = (it_) - kb_ * nnb; tr_load32(V, W, N, 32 * kb_, 64 * nb_, lane); } while (0)
#define CV_STORE(V, it_) do { const int kb_ = (it_) / nnb, nb_ = (it_) - kb_ * nnb, n0_ = 64 * nb_; \
            if (j >= 19) tr_store32_f8(V, (unsigned char*)WT, ldo, koff, rowbase, mode, pg8::F8_SW, scr, 32 * kb_, n0_, lane);     \
            else if ((j == 0 || j == 11) && n0_ >= GATE_OFF && CONV_F8_LAYER(j)) tr_store32_f8(V, (unsigned char*)WT + (size_t)GATE_OFF * 4096, 2048, 0, -GATE_OFF, 0, pg8::F8_SW, scr, 32 * kb_, n0_, lane);     \
            else tr_store32(V, WT, ldo, koff, rowbase, mode, (n0_ >= slo && n0_ < shi) ? 0.125f : 1.0f, scr, 32 * kb_, n0_, lane); } while (0)
        f32x4 va[8], vb[8];
        if (start < nitems) CV_LOAD(va, start);
        for (int it = start; it < nitems; it += 2 * nw) {
            { const int i1 = it + nw < nitems ? it + nw : it; CV_LOAD(vb, i1); }
            CV_STORE(va, it);
            if (it + nw >= nitems) break;
            { const int i2 = it + 2 * nw < nitems ? it + 2 * nw : it + nw; CV_LOAD(va, i2); }
            CV_STORE(vb, it + nw);
        }
#undef CV_LOAD
#undef CV_STORE
        rot = (rot + nitems) % nw;
    }
}
__device__ __forceinline__ void p0_prologue(Frame& F, const In& I) {
    unsigned char* ws = F.ws;
    conv_jobs((const LAS unsigned long long*)(F.lds + LDSCTL_OFF + 256), ws, 0, JOBS_PRO, F.gw, F.ngw, (LAS float*)(F.lds + F.wave * 8320), F.lane);
    { const float* gw = I.p[6]; bf16* o = (bf16*)(ws + WS_GMW);
      for (int g = blockIdx.x * 512 + F.tid; g < 2 * 8 * 128 * 128 / 8; g += F.G * 512) { const int s0 = (g & 15) * 8, t = (g >> 4) & 127;
          const f32x4 a = *(const GAS f32x4*)(gw + (size_t)g * 8), b = *(const GAS f32x4*)(gw + (size_t)g * 8 + 4);
          float v[8] = {a.x, a.y, a.z, a.w, b.x, b.y, b.z, b.w};
#pragma unroll
          for (int e = 0; e < 8; ++e) if (s0 + e > t) v[e] = 0.f;
          *(GAS v4u*)(o + (size_t)g * 8) = pk8(v); } }
    for (int m = F.gw; m < M; m += F.ngw) rms_row_to_bf16(I.p[0] + (size_t)m * DM, I.p[1], (bf16*)(ws + WS_XN) + (size_t)m * DM, F.lane, ws + WS_XN8 + (size_t)m * DM);
}

__device__ __forceinline__ void rw_elem_row(Frame& F, const In& I, int l, int m) {
    bf16* PROJ = (bf16*)(F.ws + WS_PROJ); bf16* RWT = (bf16*)(F.ws + WS_RWT);
    const bool has_prev = (m % SEQ) != 0;
    const bf16* cur = PROJ + (size_t)m * NIN + RW_OFF; const bf16* prv = cur - NIN;
    const float* mu = I.p[8] + l * 1792; const float* kkw = I.p[14] + l * 512;
#pragma unroll
    for (int i = 0; i < 4; ++i) {
        const int c = F.lane + 64 * i;
        if (c < 224) {
            float x[8], p[8];
            unpk8(*(const GAS v4u*)(cur + 8 * c), x);
            if (has_prev) unpk8(*(const GAS v4u*)(prv + 8 * c), p); else {
#pragma unroll
                for (int e = 0; e < 8; ++e) p[e] = 0.f; }
            const f32x4 m0 = *(const GAS f32x4*)(mu + 8 * c), m1 = *(const GAS f32x4*)(mu + 8 * c + 4);
            const float mm[8] = {m0.x, m0.y, m0.z, m0.w, m1.x, m1.y, m1.z, m1.w};
#pragma unroll
            for (int e = 0; e < 8; ++e) x[e] = x[e] + (p[e] - x[e]) * mm[e];
            if (i == 0) { *(GAS v4u*)(RWT + RWT_R + (size_t)m * 512 + 8 * c) = pk8(x); }
            else if (i == 1) { const int ch = 8 * (c - 64);
                *(GAS v4u*)(RWT + RWT_K + (size_t)m * 512 + ch) = pk8(x);
                const f32x4 k0 = *(const GAS f32x4*)(kkw + ch), k1 = *(const GAS f32x4*)(kkw + ch + 4);
                const float kw[8] = {k0.x, k0.y, k0.z, k0.w, k1.x, k1.y, k1.z, k1.w};
                float q[8], ss = 0.f;
#pragma unroll
                for (int e = 0; e < 8; ++e) { q[e] = x[e] * kw[e]; ss += q[e] * q[e]; }
                ss = sum8(ss);
                const float inv = 1.0f / fmaxf(sqrtf(ss), 1e-12f);
#pragma unroll
                for (int e = 0; e < 8; ++e) q[e] *= inv;
                *(GAS v4u*)(RWT + RWT_KK + (size_t)m * 512 + ch) = pk8(q); }
            else if (i == 2) { *(GAS v4u*)(RWT + RWT_V + (size_t)m * 512 + 8 * (c - 128)) = pk8(x); }
            else { const int cc = c - 192;
#pragma unroll
                for (int e = 0; e < 8; ++e) { if (cc < 8) x[e] = 1.0f - 2.0f * __builtin_amdgcn_rcpf(1.0f + __builtin_amdgcn_exp2f(2.885390081777927f * x[e])); else if (cc >= 16) x[e] = fsig(x[e]); }
                *(GAS v4u*)(RWT + RWT_LA + (size_t)m * 256 + 8 * cc) = pk8(x); }
        }
    }
}
__device__ __forceinline__ void gm_ln_row(Frame& F, const In& I, int l, int m) {
    bf16* vp = (bf16*)(F.ws + WS_PROJ) + (size_t)m * NIN + 512 + 8 * F.lane;
    float x[8]; unpk8(*(const GAS v4u*)vp, x);
    float s = 0.f;
#pragma unroll
    for (int e = 0; e < 8; ++e) s += x[e];
    const float mean = wave_sum(s) * (1.f / 512.f); float q = 0.f;
#pragma unroll
    for (int e = 0; e < 8; ++e) { x[e] -= mean; q += x[e] * x[e]; }
    const float rstd = 1.0f / sqrtf(wave_sum(q) * (1.f / 512.f) + 1e-5f);
    const float* g = I.p[4] + l * 512 + 8 * F.lane; const float* b = I.p[5] + l * 512 + 8 * F.lane;
    const f32x4 g0 = *(const GAS f32x4*)g, g1 = *(const GAS f32x4*)(g + 4), b0 = *(const GAS f32x4*)b, b1 = *(const GAS f32x4*)(b + 4);
    const float gg[8] = {g0.x, g0.y, g0.z, g0.w, g1.x, g1.y, g1.z, g1.w}, bb[8] = {b0.x, b0.y, b0.z, b0.w, b1.x, b1.y, b1.z, b1.w};
#pragma unroll
    for (int e = 0; e < 8; ++e) x[e] = x[e] * rstd * gg[e] + bb[e];
    *(GAS v4u*)vp = pk8(x);
}
#define MFMA32(a, b, c) __builtin_amdgcn_mfma_f32_32x32x16_bf16((a), (b), (c), 0, 0, 0)
__device__ __forceinline__ int crow(int r, int hi) { return (r & 3) + 8 * (r >> 2) + 4 * hi; }
__device__ __forceinline__ void sb_attn_unit(bf16* PROJ, int b, int h, int qt, int lane, int ocol = SB_OFF) {
    const int r32 = lane & 31, hi = lane >> 5;
    const size_t rowb = (size_t)b * SEQ;
    const bf16* Qp = PROJ + (rowb + qt * 32 + r32) * NIN + SB_OFF + h * 64 + hi * 8;
    bf16x8 qf[4];
#pragma unroll
    for (int ds = 0; ds < 4; ++ds) qf[ds] = *(const GAS bf16x8*)(Qp + ds * 16);
    f32x16 o0, o1;
#pragma unroll
    for (int r = 0; r < 16; ++r) { o0[r] = 0.f; o1[r] = 0.f; }
    float R = 0.f;
    const int tq = qt * 32 + r32;
    for (int kt = qt; kt >= 0; --kt) {
        const bf16* Kp = PROJ + (rowb + kt * 32 + r32) * NIN + SB_OFF + 1024 + h * 64 + hi * 8;
        bf16x8 kf[4];
#pragma unroll
        for (int ds = 0; ds < 4; ++ds) kf[ds] = *(const GAS bf16x8*)(Kp + ds * 16);
        const bf16* Vp = PROJ + (rowb + kt * 32) * NIN + SB_OFF + 2048 + h * 64 + r32;
        bf16x8 vf[2][2];
#pragma unroll
        for (int j = 0; j < 2; ++j)
#pragma unroll
            for (int dt = 0; dt < 2; ++dt)
#pragma unroll
                for (int e = 0; e < 8; ++e) vf[j][dt][e] = (short)*(const GAS bf16*)(Vp + (size_t)crow(8 * j + e, hi) * NIN + dt * 32);
        f32x16 st;
#pragma unroll
        for (int r = 0; r < 16; ++r) st[r] = 0.f;
#pragma unroll
        for (int ds = 0; ds < 4; ++ds) st = MFMA32(kf[ds], qf[ds], st);
        float sp[16]; const bool diag = (kt == qt);
#pragma unroll
        for (int r = 0; r < 16; ++r) { const float z = st[r]; const int s = kt * 32 + crow(r, hi);
            float v = (z > 20.f) ? z : 0.6931471805599453f * __builtin_amdgcn_logf(1.0f + __builtin_amdgcn_exp2f(1.4426950408889634f * z));
            if (diag && s >= tq) v = 0.f;
            sp[r] = v; }
        float rs[4], prs[4];
#pragma unroll
        for (int g = 0; g < 4; ++g) { rs[g] = (sp[4 * g] + sp[4 * g + 1]) + (sp[4 * g + 2] + sp[4 * g + 3]); prs[g] = __shfl_xor(rs[g], 32); }
        float carry = R; float att[16];
#pragma unroll
        for (int g = 3; g >= 0; --g) { float c = carry + (hi == 0 ? prs[g] : 0.f);
#pragma unroll
            for (int i = 3; i >= 0; --i) { const int r = 4 * g + i; c += sp[r]; const int s = kt * 32 + crow(r, hi);
                float a = __builtin_amdgcn_exp2f(1.4426950408889634f * (st[r] - c));
                if (diag && s >= tq) a = 0.f;
                att[r] = a; }
            carry += rs[g] + prs[g]; }
        R = carry;
        bf16x8 pa[2];
#pragma unroll
        for (int j = 0; j < 2; ++j) { v4u w; w.x = pk2(att[8 * j], att[8 * j + 1]); w.y = pk2(att[8 * j + 2], att[8 * j + 3]); w.z = pk2(att[8 * j + 4], att[8 * j + 5]); w.w = pk2(att[8 * j + 6], att[8 * j + 7]); pa[j] = __builtin_bit_cast(bf16x8, w); }
#pragma unroll
        for (int j = 0; j < 2; ++j) { o0 = MFMA32(pa[j], vf[j][0], o0); o1 = MFMA32(pa[j], vf[j][1], o1); }
        if (__all(R > 110.f)) break;
    }
    bf16* Op = PROJ + (rowb + qt * 32) * NIN + ocol + h * 64 + r32;
#pragma unroll
    for (int r = 0; r < 16; ++r) { const size_t ro = (size_t)crow(r, hi) * NIN; *(GAS bf16*)(Op + ro) = (bf16)f2bf(o0[r]); *(GAS bf16*)(Op + ro + 32) = (bf16)f2bf(o1[r]); }
}
__device__ __forceinline__ void c1_phase(Frame& F, const In& I, int l) {
    for (int m = F.gw; m < M; m += F.ngw) { rw_elem_row(F, I, l, m); gm_ln_row(F, I, l, m); }
    bf16* PROJ = (bf16*)(F.ws + WS_PROJ);
    for (int u = F.gw; u < BATCH * 16 * 64; u += F.ngw) { const int qt = 63 - (u >> 7), bh = u & 127; sb_attn_unit(PROJ, bh >> 4, bh & 15, qt, F.lane); }
}

__device__ __forceinline__ void attn_dummy_phase(Frame& F) {
    bf16* PROJ = (bf16*)(F.ws + WS_PROJ);
    for (int u = F.gw; u < BATCH * 16 * 64; u += F.ngw) { const int qt = 63 - (u >> 7), bh = u & 127; sb_attn_unit(PROJ, bh >> 4, bh & 15, qt, F.lane, 1536); }
}

template <int CTRL> __device__ __forceinline__ float dppf(float v) { return __builtin_bit_cast(float, __builtin_amdgcn_update_dpp(0, __builtin_bit_cast(int, v), CTRL, 0xf, 0xf, true)); }
__device__ __forceinline__ float rowsum16(float x) { x += dppf<0xB1>(x); x += dppf<0x4E>(x); x += dppf<0x141>(x); x += dppf<0x140>(x); return x; }
__device__ __forceinline__ void lds_wait_ge(volatile LAS unsigned* w, unsigned target) {
    for (unsigned sp = 0; sp < (1u << 22); ++sp) { if ((unsigned)__builtin_amdgcn_readfirstlane((int)w[0]) >= target) break; __builtin_amdgcn_s_sleep(1); }
}
__device__ __forceinline__ void lds_wait4_ge(volatile LAS unsigned* w, unsigned target) {
    for (unsigned sp = 0; sp < (1u << 22); ++sp) { const unsigned a = w[0], b = w[1], c = w[2], d = w[3]; const unsigned m = min(min(a, b), min(c, d));
        if ((unsigned)__builtin_amdgcn_readfirstlane((int)m) >= target) break; __builtin_amdgcn_s_sleep(1); }
}
__device__ __forceinline__ void scan_phase(Frame& F, const In& I, int jlo, int jhi) {
    typedef float f32x2 __attribute__((ext_vector_type(2)));
    constexpr int TC = 32, NC = SEQ / TC, VEC_B = TC * 5 * 64 * 4, VV_B = TC * 16 * 4, YP_B = TC * 16 * 4 * 4, BUF_B = VEC_B + VV_B + YP_B, CV_OFF = 2 * BUF_B;
    static_assert(CV_OFF + 3 * 8320 <= LDSCTL_OFF, "scan LDS map");
    const bf16* PROJ = (const bf16*)(F.ws + WS_PROJ); const bf16* RWT = (const bf16*)(F.ws + WS_RWT);
    const int lane = F.lane;
    volatile LAS unsigned* f_ready = (volatile LAS unsigned*)(F.lds + LDSCTL_OFF + 64);
    volatile LAS unsigned* f_done = (volatile LAS unsigned*)(F.lds + LDSCTL_OFF + 80);
    bool bg_done = false;
    for (int u = blockIdx.x; u < BATCH * 8 * 4; u += F.G) {
        const int rb = u & 3, bh = u >> 2, h = bh & 7, b = bh >> 3;
        const size_t m0 = (size_t)b * SEQ;
        __syncthreads();
        if (F.tid < 8) f_ready[F.tid] = 0u;
        LDS_WAIT(); __syncthreads();
        if (F.wave >= 5) {
            if (!bg_done) conv_jobs((const LAS unsigned long long*)(F.lds + LDSCTL_OFF + 256), F.ws, jlo, jhi, blockIdx.x * 3 + (F.wave - 5), F.G * 3, (LAS float*)(F.lds + CV_OFF + (F.wave - 5) * 8320), lane);
            bg_done = true;
        } else if (F.wave == 4) {
            const int st8 = lane >> 3, ch = h * 64 + 8 * (lane & 7);
            v4u rgA[4][5], rvA, rgB[4][5], rvB;
#define SCAN_LOAD(rg, rv, c) do { _Pragma("unroll") for (int q = 0; q < 4; ++q) { const size_t mr = m0 + (size_t)(c) * TC + 8 * q + st8; \
                rg[q][0] = *(const GAS v4u*)(RWT + RWT_KK + mr * 512 + ch); rg[q][1] = *(const GAS v4u*)(PROJ + mr * NIN + C_KKA + ch); rg[q][2] = *(const GAS v4u*)(PROJ + mr * NIN + C_KP + ch); \
                rg[q][3] = *(const GAS v4u*)(PROJ + mr * NIN + C_LW + ch); rg[q][4] = *(const GAS v4u*)(RWT + RWT_R + mr * 512 + ch); } \
                rv = *(const GAS v4u*)(RWT + RWT_V + (m0 + (size_t)(c) * TC + (lane >> 1)) * 512 + h * 64 + rb * 16 + 8 * (lane & 1)); } while (0)
#define SCAN_STORE(rg, rv, c) do { LAS unsigned char* bb = F.lds + ((c) & 1) * BUF_B; \
                _Pragma("unroll") for (int q = 0; q < 4; ++q) { _Pragma("unroll") for (int a = 0; a < 5; ++a) { float x[8]; unpk8(rg[q][a], x); \
                    if (a == 3) { _Pragma("unroll") for (int e = 0; e < 8; ++e) x[e] = __builtin_amdgcn_exp2f(1.4426950408889634f * x[e]); } \
                    LAS f32x4* d = (LAS f32x4*)(bb + (((8 * q + st8) * 5 + a) * 64 + 8 * (lane & 7)) * 4); d[0] = (f32x4){x[0], x[1], x[2], x[3]}; d[1] = (f32x4){x[4], x[5], x[6], x[7]}; } } \
                { float x[8]; unpk8(rv, x); LAS f32x4* d = (LAS f32x4*)(bb + VEC_B + ((lane >> 1) * 16 + 8 * (lane & 1)) * 4); d[0] = (f32x4){x[0], x[1], x[2], x[3]}; d[1] = (f32x4){x[4], x[5], x[6], x[7]}; } } while (0)
#define SCAN_FLUSH(c) do { const LAS f32x4* yp = (const LAS f32x4*)(F.lds + ((c) & 1) * BUF_B + VEC_B + VV_B); \
                _Pragma("unroll") for (int k = 0; k < 4; ++k) { const int idx = k * 128 + lane * 2, t = idx >> 4, ri = idx & 15; \
                const f32x4 q0 = yp[idx], q1 = yp[idx + 1]; const float y0 = (q0.x + q0.y) + (q0.z + q0.w), y1 = (q1.x + q1.y) + (q1.z + q1.w); \
                float* dst = (float*)((unsigned char*)F.ws + WS_PROJ + (m0 + (size_t)(c) * TC + t) * (size_t)(NIN * 2) + YRAW_BYTE) + h * 64 + rb * 16 + ri; \
                *(GAS f32x2*)dst = (f32x2){y0, y1}; } } while (0)
#define SCAN_STEP(rg, rv, c) do { if ((c) >= 2) { lds_wait4_ge(f_done, (unsigned)((c) - 1)); SCAN_FLUSH((c) - 2); } \
                SCAN_STORE(rg, rv, (c)); LDS_WAIT(); asm volatile("" ::: "memory"); if (lane == 0) f_ready[0] = (unsigned)((c) + 1); \
                { const int cn = (c) + 2 < NC ? (c) + 2 : (c); SCAN_LOAD(rg, rv, cn); } } while (0)
            __builtin_amdgcn_s_setprio(2);
            SCAN_LOAD(rgA, rvA, 0); SCAN_LOAD(rgB, rvB, 1);
            for (int c = 0; c < NC; c += 2) { SCAN_STEP(rgA, rvA, c); SCAN_STEP(rgB, rvB, c + 1); }
            lds_wait4_ge(f_done, (unsigned)NC);
            SCAN_FLUSH(NC - 2); SCAN_FLUSH(NC - 1);
            __builtin_amdgcn_s_setprio(0);
#undef SCAN_STEP
#undef SCAN_LOAD
#undef SCAN_STORE
#undef SCAN_FLUSH
        } else {
            const int cw = F.wave, rl = lane >> 4, kq = lane & 15, row = 4 * cw + rl;
            f32x2 Sa = (f32x2){0.f, 0.f}, Sb = Sa;
            __builtin_amdgcn_s_setprio(3);
            for (int c = 0; c < NC; ++c) {
                lds_wait_ge(f_ready, (unsigned)(c + 1));
                const LAS unsigned char* bb = F.lds + (c & 1) * BUF_B;
                const LAS f32x4* vp = (const LAS f32x4*)bb + kq;
                const LAS float* vvp = (const LAS float*)(bb + VEC_B) + row;
                LAS float* yp = (LAS float*)(bb + VEC_B + VV_B) + row * 4 + (kq >> 2);
                f32x4 kk = vp[0], kka = vp[16], kp = vp[32], w = vp[48], r = vp[64]; float vv = vvp[0];
#pragma unroll 2
                for (int t = 0; t < TC; ++t) {
                    const LAS f32x4* np = vp + (t + 1) * 80;
                    const f32x4 nkk = np[0], nkka = np[16], nkp = np[32], nw = np[48], nr = np[64]; const float nvv = vvp[(t + 1) * 16];
                    f32x2 P = Sa * (f32x2){kk.x, kk.y}; P = Sb * (f32x2){kk.z, kk.w} + P;
                    float p = P.x + P.y;
                    p = rowsum16(p);
                    const float sa = -p;
                    Sa = Sa * (f32x2){w.x, w.y} + (f32x2){kka.x, kka.y} * sa; Sb = Sb * (f32x2){w.z, w.w} + (f32x2){kka.z, kka.w} * sa;
                    Sa = (f32x2){kp.x, kp.y} * vv + Sa; Sb = (f32x2){kp.z, kp.w} * vv + Sb;
                    f32x2 Y = Sa * (f32x2){r.x, r.y}; Y = Sb * (f32x2){r.z, r.w} + Y;
                    float y = Y.x + Y.y;
                    y += dppf<0xB1>(y); y += dppf<0x4E>(y);
                    yp[t * 64] = y;
                    kk = nkk; kka = nkka; kp = nkp; w = nw; r = nr; vv = nvv;
                }
                LDS_WAIT(); asm volatile("" ::: "memory");
                if (lane == 0) f_done[cw] = (unsigned)(c + 1);
            }
            __builtin_amdgcn_s_setprio(0);
        }
    }
    if (F.wave >= 5 && !bg_done) conv_jobs((const LAS unsigned long long*)(F.lds + LDSCTL_OFF + 256), F.ws, jlo, jhi, blockIdx.x * 3 + (F.wave - 5), F.G * 3, (LAS float*)(F.lds + CV_OFF + (F.wave - 5) * 8320), lane);
}

__device__ __forceinline__ void rw_post_row(Frame& F, const In& I, int l, int m) {
    bf16* PROJ = (bf16*)(F.ws + WS_PROJ); const bf16* RWT = (const bf16*)(F.ws + WS_RWT);
    const int ch = 8 * F.lane;
    const float* yr = (const float*)((const unsigned char*)F.ws + WS_PROJ + (size_t)m * (NIN * 2) + YRAW_BYTE) + ch;
    const f32x4 y0 = *(const GAS f32x4*)yr, y1 = *(const GAS f32x4*)(yr + 4);
    float y[8] = {y0.x, y0.y, y0.z, y0.w, y1.x, y1.y, y1.z, y1.w};
    float r[8], kp[8], v[8], g[8];
    unpk8(*(const GAS v4u*)(RWT + RWT_R + (size_t)m * 512 + ch), r); unpk8(*(const GAS v4u*)(PROJ + (size_t)m * NIN + C_KP + ch), kp);
    unpk8(*(const GAS v4u*)(RWT + RWT_V + (size_t)m * 512 + ch), v); unpk8(*(const GAS v4u*)(RWT + RWT_G + (size_t)m * 512 + ch), g);
    const float* rk = I.p[16] + l * 512 + ch; const float* lg = I.p[17] + l * 512 + ch; const float* lb = I.p[18] + l * 512 + ch;
    const f32x4 a0 = *(const GAS f32x4*)rk, a1 = *(const GAS f32x4*)(rk + 4), b0 = *(const GAS f32x4*)lg, b1 = *(const GAS f32x4*)(lg + 4), c0 = *(const GAS f32x4*)lb, c1 = *(const GAS f32x4*)(lb + 4);
    const float rkk[8] = {a0.x, a0.y, a0.z, a0.w, a1.x, a1.y, a1.z, a1.w}, lgg[8] = {b0.x, b0.y, b0.z, b0.w, b1.x, b1.y, b1.z, b1.w}, lbb[8] = {c0.x, c0.y, c0.z, c0.w, c1.x, c1.y, c1.z, c1.w};
    float s = 0.f, bs = 0.f;
#pragma unroll
    for (int e = 0; e < 8; ++e) { s += y[e]; bs += r[e] * kp[e] * rkk[e]; }
    const float mean = sum8(s) * (1.f / 64.f); bs = sum8(bs);
    float q = 0.f;
#pragma unroll
    for (int e = 0; e < 8; ++e) { y[e] -= mean; q += y[e] * y[e]; }
    const float rstd = 1.0f / sqrtf(sum8(q) * (1.f / 64.f) + 64e-5f);
    float o[8];
#pragma unroll
    for (int e = 0; e < 8; ++e) o[e] = (y[e] * rstd * lgg[e] + lbb[e] + bs * v[e]) * g[e];
    *(GAS v4u*)(PROJ + (size_t)m * NIN + RW_OFF + ch) = pk8(o);
}
__device__ __forceinline__ void gmlp_unit(Frame& F, const In& I, int l, int b, int c, int h) {
    bf16* PROJ = (bf16*)(F.ws + WS_PROJ); const bf16* GW = (const bf16*)(F.ws + WS_GMW) + ((size_t)l * 8 + h) * 128 * 128;
    const int lane = F.lane, r32 = lane & 31, hi = lane >> 5;
    const size_t mrow0 = (size_t)b * SEQ + (size_t)c * 128;
    f32x16 acc[4][2];
#pragma unroll
    for (int i = 0; i < 4; ++i)
#pragma unroll
        for (int j = 0; j < 2; ++j)
#pragma unroll
            for (int r = 0; r < 16; ++r) acc[i][j][r] = 0.f;
    const bf16* Vp = PROJ + mrow0 * NIN + 512 + h * 64 + r32;
#pragma unroll
    for (int ks = 0; ks < 8; ++ks) {
        bf16x8 bf0, bf1_;
        const bf16* Vk = Vp + (size_t)(16 * ks + 8 * hi) * NIN; asm volatile("" : "+v"(Vk));
#pragma unroll
        for (int e = 0; e < 8; ++e) { const size_t ro = (size_t)e * NIN; bf0[e] = (short)*(const GAS bf16*)(Vk + ro); bf1_[e] = (short)*(const GAS bf16*)(Vk + ro + 32); }
#pragma unroll
        for (int i = 0; i < 4; ++i) if (ks <= 2 * i + 1) {
            const bf16x8 a = *(const GAS bf16x8*)(GW + (size_t)(32 * i + r32) * 128 + 16 * ks + 8 * hi);
            acc[i][0] = MFMA32(a, bf0, acc[i][0]); acc[i][1] = MFMA32(a, bf1_, acc[i][1]); }
        asm volatile("" ::: "memory");
    }
    const float* bs = I.p[7] + ((size_t)l * 8 + h) * 128;
#pragma unroll
    for (int i = 0; i < 4; ++i) {
        bf16* Ui = PROJ + (mrow0 + 32 * i + 4 * hi) * NIN + h * 64 + r32; asm volatile("" : "+v"(Ui));
        const float* bsi = bs + 32 * i + 4 * hi; asm volatile("" : "+v"(bsi));
#pragma unroll
        for (int r = 0; r < 16; ++r) { const int tl = (r & 3) + 8 * (r >> 2); const float bsv = bsi[tl];
            bf16* up = Ui + (size_t)tl * NIN;
            const float u0 = bf1(*(const GAS bf16*)up), u1 = bf1(*(const GAS bf16*)(up + 32));
            *(GAS bf16*)up = (bf16)f2bf(u0 * (acc[i][0][r] + bsv)); *(GAS bf16*)(up + 32) = (bf16)f2bf(u1 * (acc[i][1][r] + bsv));
            if ((r & 3) == 3) asm volatile("" ::: "memory"); }
    }
}
__device__ __forceinline__ void c4_phase(Frame& F, const In& I, int l) {
    for (int m = F.gw; m < M; m += F.ngw) rw_post_row(F, I, l, m);
    for (int u = F.gw; u < BATCH * 16 * 8; u += F.ngw) gmlp_unit(F, I, l, u >> 7, (u >> 3) & 15, u & 7);
}

__device__ __forceinline__ void router_row(Frame& F, const In& I, int m, const float* hbuf) {
    const int lane = F.lane;
    const GAS f32x4* xr = (const GAS f32x4*)(hbuf + (size_t)m * DM) + lane; const GAS f32x4* gr = (const GAS f32x4*)(I.p[23] + DM) + lane;
    const float* rw = I.p[27];
    float lg[8]; float s = 0.f;
#pragma unroll
    for (int e = 0; e < 8; ++e) lg[e] = 0.f;
    GAS unsigned* o8 = (GAS unsigned*)((unsigned char*)(F.ws + WS_XN) + (size_t)m * DM) + lane;
    f32x4 xv[8];
#pragma unroll
    for (int j = 0; j < 8; ++j) { const f32x4 x = xr[64 * j]; s += (x.x * x.x + x.y * x.y) + (x.z * x.z + x.w * x.w); xv[j] = x; }
    const float rstd = 1.0f / sqrtf(wave_sum(s) * (1.f / DM) + 1e-6f);
#pragma unroll
    for (int j = 0; j < 8; ++j) { const f32x4 g = gr[64 * j]; const float n[4] = {xv[j].x * rstd * g.x, xv[j].y * rstd * g.y, xv[j].z * rstd * g.z, xv[j].w * rstd * g.w};
        o8[64 * j] = pg8::pk4_fp8(n[0] * pg8::F8_SX, n[1] * pg8::F8_SX, n[2] * pg8::F8_SX, n[3] * pg8::F8_SX);
        const int c0 = 4 * (lane + 64 * j);
#pragma unroll
        for (int q = 0; q < 4; ++q) { const f32x4 w0 = *(const GAS f32x4*)(rw + (size_t)(c0 + q) * 8), w1 = *(const GAS f32x4*)(rw + (size_t)(c0 + q) * 8 + 4);
            lg[0] += n[q] * w0.x; lg[1] += n[q] * w0.y; lg[2] += n[q] * w0.z; lg[3] += n[q] * w0.w; lg[4] += n[q] * w1.x; lg[5] += n[q] * w1.y; lg[6] += n[q] * w1.z; lg[7] += n[q] * w1.w; } }
#pragma unroll
    for (int e = 0; e < 8; ++e) lg[e] = wave_sum(lg[e]) + I.p[28][e];
    int e0 = 0; float v0 = lg[0];
#pragma unroll
    for (int e = 1; e < 8; ++e) if (lg[e] > v0) { v0 = lg[e]; e0 = e; }
    int e1 = -1; float v1 = -3.0e38f;
#pragma unroll
    for (int e = 0; e < 8; ++e) if (e != e0 && lg[e] > v1) { v1 = lg[e]; e1 = e; }
    const float p1 = 1.0f / (1.0f + __expf(v0 - v1)), p0 = 1.0f - p1;
    if (lane == 0) {
        unsigned* cnt = (unsigned*)(F.ws + WS_CTL) + CW_CNT;
        const unsigned s0 = __hip_atomic_fetch_add(cnt + e0, 1u, RLX_AGENT), s1 = __hip_atomic_fetch_add(cnt + e1, 1u, RLX_AGENT);
        int* tab = (int*)(F.ws + WS_TAB) + (size_t)m * 8;
        tab[0] = e0; tab[1] = e1; tab[2] = (int)s0; tab[3] = (int)s1; ((float*)tab)[4] = p0; ((float*)tab)[5] = p1;
    }
}
__device__ __forceinline__ void moe_offsets(Frame& F, int (&off)[8], int (&ts)[8], int& nrt) {
    const unsigned* cnt = (const unsigned*)(F.ws + WS_CTL) + CW_CNT; int acc = 0;
#pragma unroll
    for (int e = 0; e < 8; ++e) { const int c = (int)__builtin_amdgcn_readfirstlane((int)__hip_atomic_load(cnt + e, RLX_AGENT)); ts[e] = acc; off[e] = acc * 256; acc += (c + 255) >> 8; }
    nrt = acc;
}
__device__ __forceinline__ void gather_phase(Frame& F) {
    const unsigned* cnt = (const unsigned*)(F.ws + WS_CTL) + CW_CNT;
    const int cj = (F.lane < 8) ? (int)__hip_atomic_load(cnt + (F.lane & 7), RLX_AGENT) : 0;
    const int tiles = (cj + 255) >> 8; int incl = tiles;
#pragma unroll
    for (int d = 1; d < 8; d <<= 1) { const int t = __shfl_up(incl, d); if (F.lane >= d) incl += t; }
    const int offv = (incl - tiles) * 256;
    const unsigned char* XN = (const unsigned char*)(F.ws + WS_XN); unsigned char* XG = (unsigned char*)(F.ws + WS_XG);
    for (int m = F.gw; m < M; m += F.ngw) {
        int* tab = (int*)(F.ws + WS_TAB) + (size_t)m * 8;
        const int e0 = tab[0], e1 = tab[1], s0 = __shfl(offv, e0) + tab[2], s1 = __shfl(offv, e1) + tab[3];
        const GAS v4u* src = (const GAS v4u*)(XN + (size_t)m * DM) + F.lane; GAS v4u* d0 = (GAS v4u*)(XG + (size_t)s0 * DM) + F.lane; GAS v4u* d1 = (GAS v4u*)(XG + (size_t)s1 * DM) + F.lane;
#pragma unroll
        for (int j = 0; j < 2; ++j) { const v4u x = src[64 * j]; d0[64 * j] = x; d1[64 * j] = x; }
        if (F.lane == 0) { tab[6] = s0; tab[7] = s1; }
    }
}
__device__ __forceinline__ void final_row(Frame& F, const In& I, int m, float* hbuf) {
    const int lane = F.lane;
    const int* tab = (const int*)(F.ws + WS_TAB) + (size_t)m * 8;
    const float p0 = ((const float*)tab)[4], p1 = ((const float*)tab)[5]; const int s0 = tab[6], s1 = tab[7];
    const bf16* Y2 = (const bf16*)(F.ws + WS_Y2);
    GAS f32x4* xr = (GAS f32x4*)(hbuf + (size_t)m * DM) + lane; const GAS f32x4* gr = (const GAS f32x4*)I.p[32] + lane;
    const GAS v2u* ya = (const GAS v2u*)(Y2 + (size_t)s0 * DM) + lane; const GAS v2u* yb = (const GAS v2u*)(Y2 + (size_t)s1 * DM) + lane;
    f32x4 v[8]; float s = 0.f;
#pragma unroll
    for (int j = 0; j < 8; ++j) { f32x4 x = xr[64 * j]; const v2u a = ya[64 * j], b = yb[64 * j];
        x.x += p0 * bfl(a.x) + p1 * bfl(b.x); x.y += p0 * bfh(a.x) + p1 * bfh(b.x); x.z += p0 * bfl(a.y) + p1 * bfl(b.y); x.w += p0 * bfh(a.y) + p1 * bfh(b.y);
        v[j] = x; s += (x.x * x.x + x.y * x.y) + (x.z * x.z + x.w * x.w); }
    const float rstd = 1.0f / sqrtf(wave_sum(s) * (1.f / DM) + 1e-6f);
#pragma unroll
    for (int j = 0; j < 8; ++j) { const f32x4 g = gr[64 * j]; xr[64 * j] = (f32x4){v[j].x * rstd * g.x, v[j].y * rstd * g.y, v[j].z * rstd * g.z, v[j].w * rstd * g.w}; }
}
#ifndef RPT_MASK
#define RPT_MASK 0
#endif

#ifndef PH_MASK
#define PH_MASK 0xFFFFFF
#endif
#define PK(kind) (((PH_MASK) >> (kind)) & 1)
#define IN(k) (lo <= (k) && (k) < hi)
#ifdef PROBE_A0
#define STAMP(p) do { if (blockIdx.x == 0 && F.tid == 0) ((LAS unsigned long long*)(F.lds + LDSCTL_OFF + 600))[(p)] = __builtin_amdgcn_s_memrealtime(); } while (0)
#else
#define STAMP(p) do { } while (0)
#endif
#define SEAM(k) do { if (IN(k) && IN((k) + 1)) xcd_barrier(bar); STAMP((k) + 1); } while (0)
template <int l> __device__ __forceinline__ void layer_body(Frame& F, const In& I, unsigned char* ws, float* hout, const XcdBarrier& bar, int lo, int hi) {
    LAS unsigned char* ring = F.lds;
    bf16* const XN = (bf16*)(ws + WS_XN); bf16* const PROJ = (bf16*)(ws + WS_PROJ); bf16* const RWT = (bf16*)(ws + WS_RWT);
        const int base = 1 + 11 * l;
        const float* hin = (l == 0) ? I.p[0] : (const float*)hout;
        if (PK(1) && IN(base + 0)) {
#ifdef EXP_L
            if (l != EXP_L) {
                pg8::Gemm g{XN, (const bf16*)(ws + WS_WIN) + (size_t)l * NIN * 2048, 2048, 2048, 2048}; pg8::StaticOrder S; S.init(M, NIN, F.G, (int)blockIdx.x);
                pg8::EpiInProj E{PROJ, I.p[3] + l * 3 * DM, 0};
                pg8::gemm_phase<pg8::EpiInProj, pg8::StaticOrder, PG8_ALIGN, PG8_SP2>(ring, g, S, E);
            } else
#endif
            {
            { pg8::Gemm g{XN, (const bf16*)(ws + WS_WIN) + (size_t)l * NIN * 2048, 2048, 2048, 2048}; pg8::StaticOrder S; S.init(M, GATE_OFF, F.G, (int)blockIdx.x);
              pg8::EpiInProj E{PROJ, I.p[3] + l * 3 * DM, 0};
              pg8::gemm_phase<pg8::EpiInProj, pg8::StaticOrder, PG8_ALIGN, PG8_SP2>(ring, g, S, E); }
#ifdef EXP_BAR
            xcd_barrier(bar);
#endif
#ifdef EXP_BF16SPLIT
            { pg8::Gemm g{XN, (const bf16*)(ws + WS_WIN) + (size_t)l * NIN * 2048 + (size_t)GATE_OFF * 2048, 2048, 2048, 2048}; pg8::StaticOrder S; S.init(M, 3 * DM, F.G, (int)blockIdx.x);
              pg8::EpiInProj E{PROJ, I.p[3] + l * 3 * DM, 23};
              pg8::gemm_phase<pg8::EpiInProj, pg8::StaticOrder, PG8_ALIGN, PG8_SP2>(ring, g, S, E); }
#else
            { pg8::Gemm g{(const bf16*)(ws + WS_XN8), (const bf16*)(ws + WS_WIN) + (size_t)l * NIN * 2048 + (size_t)GATE_OFF * 2048, 1024, 1024, 1024}; pg8::StaticOrder S; S.init(M, 3 * DM, F.G, (int)blockIdx.x);
              pg8::EpiGate8 E{PROJ, I.p[3] + l * 3 * DM, 1.0f / (pg8::F8_SX * pg8::F8_SW)};
              pg8::gemm_phase<pg8::EpiGate8, pg8::StaticOrder, PG8_ALIGN, PG8_SP2, true>(ring, g, S, E);
#ifdef EXP_TWICE
              xcd_barrier(bar); pg8::gemm_phase<pg8::EpiGate8, pg8::StaticOrder, PG8_ALIGN, PG8_SP2, true>(ring, g, S, E);
#endif
            }
#endif
            }
        } SEAM(base + 0);
        if (PK(2) && IN(base + 1)) { c1_phase(F, I, l); if (RPT_MASK & 4) { xcd_barrier(bar); attn_dummy_phase(F); } } SEAM(base + 1);
        if (PK(3) && IN(base + 2)) {
            int kl = 256; asm volatile("" : "+s"(kl));
            pg8::Gemm g{RWT + RWT_LA, (const bf16*)(ws + WS_LORA) + (size_t)l * 1536 * 256, kl, 256, 256}; pg8::StaticOrder S; S.init(M, 1536, F.G, (int)blockIdx.x);
            pg8::EpiLora E{PROJ, RWT + RWT_KK, RWT + RWT_K, RWT + RWT_G, I.p[9] + l * 512, I.p[11] + l * 512, I.p[15] + l * 512};
            pg8::gemm_phase<pg8::EpiLora, pg8::StaticOrder, PG8_ALIGN, PG8_SP2>(ring, g, S, E);
        } SEAM(base + 2);
        if (PK(4) && IN(base + 3)) { scan_phase(F, I, l == 0 ? JOBS_PRO : JOBS_BG0, l == 0 ? JOBS_BG0 : NJOBS); } SEAM(base + 3);
        if (PK(5) && IN(base + 4)) { c4_phase(F, I, l); } SEAM(base + 4);
        if (PK(6) && IN(base + 5)) {
            pg8::Gemm g{PROJ, (const bf16*)(ws + WS_PC) + (size_t)l * 2048 * 2048, 512, NIN, 2048}; pg8::MergeOrder S; S.so.init(M, DM, F.G, (int)blockIdx.x);
            pg8::EpiMerge E{PROJ, XN, I.p[3] + l * 3 * DM};
            pg8::gemm_phase<pg8::EpiMerge, pg8::MergeOrder, PG8_ALIGN, PG8_SP2>(ring, g, S, E);
        } SEAM(base + 5);
        if (PK(7) && IN(base + 6)) {
            pg8::Gemm g{XN, (const bf16*)(ws + WS_WO) + (size_t)l * 2048 * 2048, 2048, 2048, 2048}; pg8::StaticOrder S; S.init(M, DM, F.G, (int)blockIdx.x);
            pg8::EpiResid E{hin, hout};
            pg8::gemm_phase<pg8::EpiResid, pg8::StaticOrder, PG8_ALIGN, PG8_SP2>(ring, g, S, E);
        } SEAM(base + 6);
        if (l == 0) {
            if (PK(8) && IN(base + 7)) { for (int m = F.gw; m < M; m += F.ngw) rms_row_to_bf16(hout + (size_t)m * DM, I.p[23], XN + (size_t)m * DM, F.lane, ws + WS_XN8 + (size_t)m * DM); } SEAM(base + 7);
            if (PK(9) && IN(base + 8)) {
                pg8::Gemm g{XN, (const bf16*)(ws + WS_W13), 2048, 2048, 2048}; pg8::StaticOrder S; S.init(M, 2 * DFF, F.G, (int)blockIdx.x);
                pg8::EpiSwiGLU E{(bf16*)(ws + WS_H), DFF, 2 * DFF / 256};
                pg8::gemm_phase<pg8::EpiSwiGLU, pg8::StaticOrder, PG8_ALIGN, PG8_SP2>(ring, g, S, E);
                if (RPT_MASK & 16) { xcd_barrier(bar); pg8::gemm_phase<pg8::EpiSwiGLU, pg8::StaticOrder, PG8_ALIGN, PG8_SP2>(ring, g, S, E); }
            } SEAM(base + 8);
            if (PK(10) && IN(base + 9)) {
                pg8::Gemm g{(const bf16*)(ws + WS_H), (const bf16*)(ws + WS_W2), DFF, DFF, DFF}; pg8::StaticOrder S; S.init(M, DM, F.G, (int)blockIdx.x);
                pg8::EpiResid E{hout, hout};
                pg8::gemm_phase<pg8::EpiResid, pg8::StaticOrder, PG8_ALIGN, PG8_SP2>(ring, g, S, E);
            } SEAM(base + 9);
            if (PK(8) && IN(base + 10)) { for (int m = F.gw; m < M; m += F.ngw) rms_row_to_bf16(hout + (size_t)m * DM, I.p[1] + DM, XN + (size_t)m * DM, F.lane, ws + WS_XN8 + (size_t)m * DM); } SEAM(base + 10);
        } else {
            if (PK(11) && IN(base + 7)) { for (int m = F.gw; m < M; m += F.ngw) router_row(F, I, m, hout); } SEAM(base + 7);
            if (PK(12) && IN(base + 8)) { gather_phase(F); } SEAM(base + 8);
            if (PK(13) && IN(base + 9)) {
                pg8::MoeOrder S; int off[8]; moe_offsets(F, off, S.ts, S.nrt); S.nt = 2 * DFE / 256; S.G = F.G; S.c = (int)blockIdx.x;
                pg8::Gemm g{(const bf16*)(ws + WS_XG), (const bf16*)(ws + WS_W13E), 1024, 1024, 1024};
                pg8::EpiSwiGLU8 E{(unsigned char*)(ws + WS_HX), DFE, 2 * DFE / 256, 1.0f / (pg8::F8_SX * pg8::F8_SW)};
                pg8::gemm_phase<pg8::EpiSwiGLU8, pg8::MoeOrder, PG8_ALIGN, PG8_SP2, true>(ring, g, S, E);
            } SEAM(base + 9);
            if (PK(14) && IN(base + 10)) {
                pg8::MoeOrder S; int off[8]; moe_offsets(F, off, S.ts, S.nrt); S.nt = DM / 256; S.G = F.G; S.c = (int)blockIdx.x;
                pg8::Gemm g{(const bf16*)(ws + WS_HX), (const bf16*)(ws + WS_W2E), DFE / 2, DFE / 2, DFE / 2};
                pg8::EpiPlain E{(bf16*)(ws + WS_Y2), DM, DM / 256, 1.0f / (pg8::F8_SH * pg8::F8_SW)};
                pg8::gemm_phase<pg8::EpiPlain, pg8::MoeOrder, PG8_ALIGN, PG8_SP2, true>(ring, g, S, E);
            } SEAM(base + 10);
            if (PK(15) && IN(base + 11)) { for (int m = F.gw; m < M; m += F.ngw) final_row(F, I, m, hout); }
        }
    }
struct Args { In in; float* out; unsigned char* ws; int ph_lo, ph_hi; };
__global__ void __launch_bounds__(NWAVES * 64, 2) trunk_fwd(Args args) {
    extern __shared__ __attribute__((aligned(16))) unsigned char lds_raw[];
    Frame F;
    F.lds = (LAS unsigned char*)lds_raw; F.ws = args.ws; F.in = nullptr;
    F.tid = threadIdx.x; F.lane = F.tid & 63; F.wave = __builtin_amdgcn_readfirstlane(F.tid >> 6);
    F.G = gridDim.x; F.gw = blockIdx.x * NWAVES + F.wave; F.ngw = F.G * NWAVES;
    const In& I = args.in;
    unsigned char* ws = args.ws;
    for (int u = F.tid; u < (LDS_BYTES - LDSCTL_OFF) / 4; u += NWAVES * 64) ((LAS unsigned*)(F.lds + LDSCTL_OFF))[u] = 0u;
    __syncthreads();
    if (F.tid == 0) {
#pragma unroll
        for (int k = 0; k < 33; ++k) ((LAS unsigned long long*)(F.lds + LDSCTL_OFF + 256))[k] = (unsigned long long)I.p[k];
    }
    __syncthreads();
    const int lo = args.ph_lo, hi = args.ph_hi;
    XcdBarrier bar; bar.bar = (unsigned*)(ws + WS_CTL) + CW_BAR; bar.x = 0; bar.st = nullptr;
    if (hi - lo > 1) bar = xcd_barrier_post((unsigned*)(ws + WS_CTL) + CW_BAR, (volatile LAS unsigned*)(F.lds + LDSCTL_OFF) + 8);
    LAS unsigned char* ring = F.lds;
    bf16* const XN = (bf16*)(ws + WS_XN); bf16* const PROJ = (bf16*)(ws + WS_PROJ); bf16* const RWT = (bf16*)(ws + WS_RWT);
    float* const hout = args.out;

    STAMP(0);
    if (PK(0) && IN(0)) { p0_prologue(F, I); if (RPT_MASK & 1) { xcd_barrier(bar); p0_prologue(F, I); } } SEAM(0);

    layer_body<0>(F, I, ws, hout, bar, lo, hi);
    layer_body<1>(F, I, ws, hout, bar, lo, hi);
#ifdef PROBE_A0
    xcd_barrier(bar); STAMP(N_PHASES);
    if (blockIdx.x == 0) {
        const LAS unsigned long long* ts = (const LAS unsigned long long*)(F.lds + LDSCTL_OFF + 600);
        __syncthreads();
        const float x1 = (float)(ts[PROBE_A1 + 1] - ts[PROBE_A0]) * 0.01f, x2 = (float)(ts[PROBE_B1 + 1] - ts[PROBE_B0]) * 0.01f;
        if (F.tid == 0) hout[0] = x1;
        for (int i = F.tid; i < 100000; i += 512) hout[4096 + i] = x2 * 0.01f;
    }
#endif
#undef IN
#undef SEAM
}

#ifndef MK_SPLIT
#define MK_SPLIT 0
#endif
extern "C" void kernel_launch(void* const* d_in, const int* in_sizes, int n_in, void* d_out, int out_size, void* d_ws, size_t ws_size, hipStream_t stream) {
    static int grid = 0;
    if (grid == 0) {
        if (n_in != 33 || in_sizes[0] != M * DM || out_size != M * DM || ws_size < WS_END) { fprintf(stderr, "kernel_launch: unexpected shapes (n_in %d, ws %zu); nothing launched\n", n_in, ws_size); grid = -1; return; }
        int dev = 0, cus = 0, per_cu = 0;
        if (hipGetDevice(&dev) != hipSuccess || hipDeviceGetAttribute(&cus, hipDeviceAttributeMultiprocessorCount, dev) != hipSuccess) { grid = -1; return; }
        if (hipFuncSetAttribute((const void*)trunk_fwd, hipFuncAttributeMaxDynamicSharedMemorySize, LDS_BYTES) != hipSuccess) { fprintf(stderr, "kernel_launch: hipFuncSetAttribute failed\n"); grid = -1; return; }
        if (hipOccupancyMaxActiveBlocksPerMultiprocessor(&per_cu, (const void*)trunk_fwd, NWAVES * 64, LDS_BYTES) != hipSuccess || per_cu < 1) { fprintf(stderr, "kernel_launch: occupancy query says %d\n", per_cu); }
        (void)hipGetLastError();
        grid = cus;
    }
    if (grid < 0) return;
    if (hipMemsetAsync((char*)d_ws, 0, ZERO_BYTES, stream) != hipSuccess) return;
    Args a{};
    for (int i = 0; i < 33; ++i) a.in.p[i] = (const float*)d_in[i];
    a.out = (float*)d_out; a.ws = (unsigned char*)d_ws;
#if MK_SPLIT
    for (int p = 0; p < N_PHASES; ++p) { a.ph_lo = p; a.ph_hi = p + 1; hipLaunchKernelGGL(trunk_fwd, dim3(grid), dim3(NWAVES * 64), LDS_BYTES, stream, a); }
#else
    a.ph_lo = 0; a.ph_hi = N_PHASES;
    hipLaunchKernelGGL(trunk_fwd, dim3(grid), dim3(NWAVES * 64), LDS_BYTES, stream, a);
#endif
    const hipError_t le = hipPeekAtLastError();
    if (le != hipSuccess) fprintf(stderr, "kernel_launch: launch failed: %s\n", hipGetErrorName(le));
}
```
